# Optimizing an MI355X kernel written in HIP

```python
import jax, jax.numpy as jnp
from jax import lax
import numpy as np

D_MODEL = 2048
BATCH = 4
SEQ = 8192
DEPTH = 1

HEAD_DIM = 128
N_HEADS_MOBA = 8
N_HEADS_DIL = 8
W_MOBA = N_HEADS_MOBA * HEAD_DIM
W_DIL = N_HEADS_DIL * HEAD_DIM
MOBA_BLOCK = 256
MOBA_TOPK = 3
MOBA_Q_CHUNK = 32
DIL_PATTERNS = ((128, 1), (512, 4), (2048, 16))
N_GROUPS = 4
EXPERTS_PER_GROUP = 8
N_EXPERTS = N_GROUPS * EXPERTS_PER_GROUP
EXPERT_TOPK = 2
D_EXPERT = D_MODEL // 4
MOE_BLOCK = 128
RMS_EPS = 1e-6
IN_COLS = 3 * W_MOBA + 3 * W_DIL + 2 * D_MODEL

kernel_name = "hybrid_moba_dilated_hmoe_block"


def rms_norm(x, g):
    xf = x.astype(jnp.float32)
    y = xf * lax.rsqrt(jnp.mean(xf * xf, axis=-1, keepdims=True) + RMS_EPS)
    return (y * g.astype(jnp.float32)).astype(x.dtype)


def alibi_slopes():
    n = N_HEADS_MOBA + N_HEADS_DIL
    s = 2.0 ** (-8.0 * np.arange(1, n + 1) / n)
    return jnp.asarray(s[0::2], jnp.float32), jnp.asarray(s[1::2], jnp.float32)


def masked_softmax_lse(s, mask):
    s = jnp.where(mask, s, -jnp.inf)
    m = jnp.max(s, axis=-1, keepdims=True)
    m = jnp.where(jnp.isfinite(m), m, 0.0)
    p = jnp.exp(s - m)
    l = jnp.sum(p, axis=-1, keepdims=True)
    lse = (jnp.log(l) + m)[..., 0]
    p = p / jnp.where(l > 0, l, 1.0)
    return p, lse


def merge_by_lse(outs, lses):
    w = jax.nn.softmax(lses, axis=0)
    return jnp.sum(w[..., None] * outs.astype(jnp.float32), axis=0).astype(outs.dtype)


def moba_attention(q, k, v, slopes):
    Bsz, H, S, HD = q.shape
    nb = -(-S // MOBA_BLOCK)
    sp = nb * MOBA_BLOCK
    pad = ((0, 0), (0, 0), (0, sp - S), (0, 0))
    q, k, v = (jnp.pad(a, pad) for a in (q, k, v))
    scale = HD ** -0.5
    qb = q.reshape(Bsz, H, nb, MOBA_BLOCK, HD)
    kb = k.reshape(Bsz, H, nb, MOBA_BLOCK, HD)
    vb = v.reshape(Bsz, H, nb, MOBA_BLOCK, HD)

    i = jnp.arange(MOBA_BLOCK)
    diff = (i[:, None] - i[None, :])
    s_own = (jnp.einsum('bhnqd,bhnkd->bhnqk', qb, kb).astype(jnp.float32) * scale
             - slopes[None, :, None, None, None] * diff.astype(jnp.float32))
    p_own, lse_own = masked_softmax_lse(s_own, diff >= 0)
    o_own = jnp.einsum('bhnqk,bhnkd->bhnqd', p_own.astype(v.dtype), vb).reshape(Bsz, H, sp, HD)
    lse_own = lse_own.reshape(Bsz, H, sp)

    k_mean = jnp.mean(kb.astype(jnp.float32), axis=3)
    pos = jnp.arange(sp)
    qblk = pos // MOBA_BLOCK
    gate = jnp.einsum('bhsd,bhnd->bhsn', q.astype(jnp.float32), k_mean)
    past = jnp.arange(nb)[None, :] < qblk[:, None]
    gate = jnp.where(past, gate, -jnp.inf)
    n_sel = min(MOBA_TOPK, nb)
    _, sel = lax.top_k(gate, n_sel)
    sel_valid = sel < qblk[:, None]

    nc = sp // MOBA_Q_CHUNK

    def to_chunks(a):
        a = a.reshape((Bsz, H, nc, MOBA_Q_CHUNK) + a.shape[3:])
        return jnp.moveaxis(a, 2, 0)

    b_idx = jnp.arange(Bsz)[:, None, None, None]
    h_idx = jnp.arange(H)[None, :, None, None]
    offs = jnp.arange(MOBA_BLOCK)

    def chunk_attend(args):
        q_c, sel_c, valid_c, t_c = args
        k_g = kb[b_idx, h_idx, sel_c]
        v_g = vb[b_idx, h_idx, sel_c]
        s = jnp.einsum('bhcd,bhcnjd->bhcnj', q_c, k_g).astype(jnp.float32) * scale
        key_pos = sel_c[..., None] * MOBA_BLOCK + offs
        dist = (t_c[None, None, :, None, None] - key_pos).astype(jnp.float32)
        s = s - slopes[None, :, None, None, None] * dist
        mask = jnp.broadcast_to(valid_c[..., None], s.shape)
        C = q_c.shape[2]
        s = s.reshape(Bsz, H, C, n_sel * MOBA_BLOCK)
        mask = mask.reshape(Bsz, H, C, n_sel * MOBA_BLOCK)
        p, lse = masked_softmax_lse(s, mask)
        o = jnp.einsum('bhcm,bhcmd->bhcd', p.astype(v_g.dtype),
                       v_g.reshape(Bsz, H, C, n_sel * MOBA_BLOCK, HD))
        return o, lse

    o_sel, lse_sel = lax.map(chunk_attend, (to_chunks(q), to_chunks(sel), to_chunks(sel_valid),
                                            pos.reshape(nc, MOBA_Q_CHUNK)))
    o_sel = jnp.moveaxis(o_sel, 0, 2).reshape(Bsz, H, sp, HD)
    lse_sel = jnp.moveaxis(lse_sel, 0, 2).reshape(Bsz, H, sp)
    o = merge_by_lse(jnp.stack([o_own, o_sel]), jnp.stack([lse_own, lse_sel]))
    return o[:, :, :S]


def dilated_attention_one(q, k, v, slopes, window, dilation):
    Bsz, H, S, HD = q.shape
    w = window // dilation
    span = dilation * w
    sp = -(-S // span) * span
    L = sp // dilation
    nb = L // w
    scale = HD ** -0.5
    pad = ((0, 0), (0, 0), (0, sp - S), (0, 0))

    def to_blocks(a):
        a = jnp.pad(a, pad).reshape(Bsz, H, L, dilation, HD)
        a = jnp.swapaxes(a, 2, 3)
        return a.reshape(Bsz, H, dilation, nb, w, HD)

    def with_prev(a):
        prev = jnp.pad(a, ((0, 0), (0, 0), (0, 0), (1, 0), (0, 0), (0, 0)))[:, :, :, :-1]
        return jnp.concatenate([prev, a], axis=4)

    qb = to_blocks(q)
    kk = with_prev(to_blocks(k))
    vv = with_prev(to_blocks(v))
    i = jnp.arange(w)[:, None]
    j = jnp.arange(2 * w)[None, :]
    diff = i + w - j
    blk = jnp.arange(nb)[:, None, None]
    mask = ((diff >= 0) & (diff <= w))[None] & ((blk > 0) | (j >= w)[None])
    s = (jnp.einsum('bhrnqd,bhrnkd->bhrnqk', qb, kk).astype(jnp.float32) * scale
         - slopes[None, :, None, None, None, None] * (dilation * diff).astype(jnp.float32))
    p, lse = masked_softmax_lse(s, mask)
    o = jnp.einsum('bhrnqk,bhrnkd->bhrnqd', p.astype(vv.dtype), vv)
    o = jnp.swapaxes(o.reshape(Bsz, H, dilation, L, HD), 2, 3).reshape(Bsz, H, sp, HD)
    lse = jnp.swapaxes(lse.reshape(Bsz, H, dilation, L), 2, 3).reshape(Bsz, H, sp)
    return o[:, :, :S], lse[:, :, :S]


def dilated_mixture(q, k, v, slopes):
    outs, lses = [], []
    for window, dilation in DIL_PATTERNS:
        o, lse = dilated_attention_one(q, k, v, slopes, window, dilation)
        outs.append(o)
        lses.append(lse)
    return merge_by_lse(jnp.stack(outs), jnp.stack(lses))


def hier_moe(h, w_group, b_group, w_expert, b_expert, w_gate, w_up, w_down):
    Bsz, S, D = h.shape
    N = Bsz * S
    hf = h.reshape(N, D)
    g_prob = jax.nn.softmax((hf @ w_group + b_group).astype(jnp.float32), axis=-1)
    g_top_p, g_top = lax.top_k(g_prob, 1)
    e_logits = (hf @ w_expert + b_expert).astype(jnp.float32).reshape(N, N_GROUPS, EXPERTS_PER_GROUP)
    e_logits = jnp.take_along_axis(e_logits, g_top[:, :, None], axis=1)[:, 0]
    e_prob = jax.nn.softmax(e_logits, axis=-1)
    e_top_p, e_top = lax.top_k(e_prob, EXPERT_TOPK)
    weights = g_top_p * e_top_p / jnp.sum(e_top_p, axis=-1, keepdims=True)
    expert_id = g_top * EXPERTS_PER_GROUP + e_top

    A = N * EXPERT_TOPK
    e_flat = expert_id.reshape(A).astype(jnp.int32)
    w_flat = weights.reshape(A).astype(h.dtype)
    tok_flat = jnp.repeat(jnp.arange(N, dtype=jnp.int32), EXPERT_TOPK)
    order = jnp.argsort(e_flat)
    e_sorted = e_flat[order]
    counts = jnp.bincount(e_flat, length=N_EXPERTS)
    padded = ((counts + MOE_BLOCK - 1) // MOE_BLOCK) * MOE_BLOCK
    start = jnp.cumsum(counts) - counts
    pend = jnp.cumsum(padded)
    pstart = pend - padded
    dest = pstart[e_sorted] + (jnp.arange(A) - start[e_sorted])
    R = -(-(A + N_EXPERTS * MOE_BLOCK) // MOE_BLOCK) * MOE_BLOCK
    n_blk = R // MOE_BLOCK
    buf_tok = jnp.zeros((R,), jnp.int32).at[dest].set(tok_flat[order])
    buf_w = jnp.zeros((R,), h.dtype).at[dest].set(w_flat[order])
    blk_start = jnp.arange(n_blk) * MOE_BLOCK
    blk_e = jnp.clip(jnp.sum(pend[None, :] <= blk_start[:, None], axis=1), 0, N_EXPERTS - 1)
    xb = hf[buf_tok].reshape(n_blk, MOE_BLOCK, D)

    def expert_block(args):
        xblk, e = args
        return (jax.nn.silu(xblk @ w_gate[e]) * (xblk @ w_up[e])) @ w_down[e]

    yb = lax.map(expert_block, (xb, blk_e)).reshape(R, D)
    out = jnp.zeros((N, D), h.dtype).at[buf_tok].add(yb * buf_w[:, None])
    return out.reshape(Bsz, S, D)


def setup_inputs(seed: int = 0) -> dict:
    key = jax.random.key(seed)
    ks = jax.random.split(key, 16)
    D = D_MODEL
    L = DEPTH

    def nrm(k, shape, scale):
        return jax.random.normal(k, shape, jnp.float32) * scale

    return {
        "x": nrm(ks[0], (BATCH, SEQ, D), 1.0),
        "norm1_g": 1.0 + nrm(ks[1], (L, D), 0.02),
        "w_in": nrm(ks[2], (L, D, IN_COLS), D ** -0.5),
        "b_gates": nrm(ks[3], (L, 2 * D), 0.01),
        "w_out_moba": nrm(ks[4], (L, W_MOBA, D), W_MOBA ** -0.5),
        "w_out_dil": nrm(ks[5], (L, W_DIL, D), W_DIL ** -0.5),
        "w_o": nrm(ks[6], (L, D, D), D ** -0.5),
        "norm2_g": 1.0 + nrm(ks[7], (L, D), 0.02),
        "w_group": nrm(ks[8], (L, D, N_GROUPS), D ** -0.5),
        "b_group": nrm(ks[9], (L, N_GROUPS), 0.01),
        "w_expert": nrm(ks[10], (L, D, N_EXPERTS), D ** -0.5),
        "b_expert": nrm(ks[11], (L, N_EXPERTS), 0.01),
        "w_gate": nrm(ks[12], (L, N_EXPERTS, D, D_EXPERT), D ** -0.5),
        "w_up": nrm(ks[13], (L, N_EXPERTS, D, D_EXPERT), D ** -0.5),
        "w_down": nrm(ks[14], (L, N_EXPERTS, D_EXPERT, D), D_EXPERT ** -0.5),
        "norm_f_g": 1.0 + nrm(ks[15], (D,), 0.02),
    }


def reference(x, norm1_g, w_in, b_gates, w_out_moba, w_out_dil, w_o, norm2_g, w_group, b_group,
              w_expert, b_expert, w_gate, w_up, w_down, norm_f_g):
    slopes_moba, slopes_dil = alibi_slopes()
    Bsz, S, D = x.shape
    cuts = list(np.cumsum([W_MOBA, W_MOBA, W_MOBA, W_DIL, W_DIL, W_DIL, D_MODEL]))

    def heads(a, n):
        return a.reshape(Bsz, S, n, HEAD_DIM).transpose(0, 2, 1, 3)

    def merge_heads(a):
        return a.transpose(0, 2, 1, 3).reshape(Bsz, S, -1)

    for l in range(DEPTH):
        h = rms_norm(x, norm1_g[l])
        proj = h @ w_in[l]
        q_m, k_m, v_m, q_d, k_d, v_d, g_m, g_d = jnp.split(proj, cuts, axis=-1)
        o_m = moba_attention(heads(q_m, N_HEADS_MOBA), heads(k_m, N_HEADS_MOBA),
                             heads(v_m, N_HEADS_MOBA), slopes_moba)
        o_d = dilated_mixture(heads(q_d, N_HEADS_DIL), heads(k_d, N_HEADS_DIL),
                              heads(v_d, N_HEADS_DIL), slopes_dil)
        y_m = merge_heads(o_m) @ w_out_moba[l]
        y_d = merge_heads(o_d) @ w_out_dil[l]
        gates = jax.nn.sigmoid(jnp.concatenate([g_m, g_d], axis=-1) + b_gates[l])
        gate_m, gate_d = jnp.split(gates, 2, axis=-1)
        x = x + (gate_m * y_m + gate_d * y_d) @ w_o[l]
        x = x + hier_moe(rms_norm(x, norm2_g[l]), w_group[l], b_group[l], w_expert[l], b_expert[l],
                         w_gate[l], w_up[l], w_down[l])
    return rms_norm(x, norm_f_g)
```

```cpp
#include <hip/hip_runtime.h>
#include <cstdio>
#include <cstdint>

#ifndef MK_N_LAUNCHES
#define MK_N_LAUNCHES 1
#endif

#ifndef MK_REP_MASK
#define MK_REP_MASK 0
#endif
#ifndef MK_DRY4
#define RT_ABL 0
#define MK_DRY4 0
#endif
#ifndef MK_DEBUG
#define MK_DEBUG 0
#endif
#define LAS __attribute__((address_space(3)))
#define GAS __attribute__((address_space(1)))
typedef unsigned short bf16;
typedef short bf16x8 __attribute__((ext_vector_type(8)));
typedef short s16x4 __attribute__((ext_vector_type(4)));
typedef float f32x2 __attribute__((ext_vector_type(2)));
typedef float f32x4 __attribute__((ext_vector_type(4)));
typedef float f32x16 __attribute__((ext_vector_type(16)));
typedef unsigned u32x2 __attribute__((ext_vector_type(2)));
typedef unsigned u32x4 __attribute__((ext_vector_type(4)));
typedef int i32x4 __attribute__((ext_vector_type(4)));
typedef int i32x8 __attribute__((ext_vector_type(8)));
typedef GAS unsigned gu32;

constexpr int DM = 2048, NB = 4, SEQ = 8192, NTOK = NB * SEQ, HD = 128, NH = 8, WQ = 1024;
constexpr int NQKV = 6144, NGATE = 4096, NEXP = 32, DEXP = 512;
constexpr int NBF = 0;
constexpr int QIN = 2;
constexpr int RMAX = 73728;
constexpr float RMS_EPS = 1e-6f;
constexpr float LOG2E = 1.4426950408889634f;
constexpr float SM_C2 = 0.08838834764831845f * LOG2E;

constexpr size_t MiB = 1u << 20;
constexpr size_t WS_CTL = 0, CTL_ZERO_BYTES = 1 * MiB;
constexpr size_t WS_WOM = 1 * MiB, WS_WOD = 5 * MiB, WS_WO = 9 * MiB, WS_WIN = 17 * MiB;
constexpr size_t WS_WIN8 = 25 * MiB;
constexpr size_t WS_H8 = 912 * MiB;
constexpr size_t WS_BUCK = 57 * MiB;
constexpr size_t WS_CS8 = 73 * MiB;
constexpr size_t WS_RS8 = 73 * MiB + 64 * 1024;
constexpr size_t WS_KMEAN = 74 * MiB;
constexpr size_t WS_WR = 74 * MiB + 512 * 1024;
constexpr size_t WS_H = 75 * MiB;
constexpr size_t WS_QM = 203 * MiB, WS_KM = 267 * MiB, WS_VM = 331 * MiB, WS_QD = 395 * MiB, WS_KD = 459 * MiB, WS_VD = 523 * MiB;
constexpr size_t WS_PM = 587 * MiB;
constexpr size_t WS_PD = 779 * MiB;
constexpr size_t WS_LM = 907 * MiB, WS_LD = 910 * MiB;
constexpr size_t WS_SM = 976 * MiB, WS_SD = 980 * MiB;
constexpr size_t WS_GATES = 587 * MiB;
constexpr size_t WS_GINV = 75 * MiB;
constexpr size_t WS_MIX = 267 * MiB;
constexpr size_t WS_X1 = 768 * MiB;
constexpr size_t WS_WGU = 203 * MiB, WS_WDN = 331 * MiB;
constexpr size_t WS_HMOE = 395 * MiB;
constexpr size_t WS_YMOE = 467 * MiB;
constexpr size_t WS_END = 1024 * MiB;
constexpr size_t WS_RSM = WS_BUCK + 2560 * 1024, WS_CSWO = 73 * MiB + 48 * 1024;
constexpr size_t WS_MIX8 = 75 * MiB;
constexpr size_t WS_RSU = WS_BUCK + 2048 * 1024, WS_CSGU = WS_BUCK + 2304 * 1024;
constexpr size_t WS_EID = WS_BUCK, WS_EW = WS_BUCK + 256 * 1024, WS_RMS = WS_BUCK + 512 * 1024, WS_POS = WS_BUCK + 768 * 1024, WS_ROWTOK = WS_BUCK + 1024 * 1024, WS_ROWW = WS_BUCK + 1536 * 1024;
static_assert(WS_YMOE + (size_t)RMAX * 2048 * 2 <= WS_X1 && WS_HMOE + (size_t)RMAX * 512 * 2 <= WS_YMOE && WS_LD + 2 * (size_t)NTOK * 8 * 4 <= WS_END, "ws map");

constexpr int CW_TMO = 0;
constexpr int CW_BAR = 4096;
constexpr int CW_BCNT = 8192;
constexpr int CW_ECNT = 8192 + 65536;
constexpr int CW_EFILL = CW_ECNT + 64 * 32;
constexpr int CW_MMAX = 163840;
constexpr int CW_UMAX = 131072;
constexpr int CW_CMAX = 81920;
static_assert(CW_EFILL + 64 * 32 <= CW_CMAX && CW_CMAX + 8192 <= CW_UMAX && CW_UMAX + NTOK <= CW_MMAX && (CW_MMAX + NTOK) * 4 <= (int)CTL_ZERO_BYTES, "ctl");

constexpr int BUCK_PER_BH = 256 * 496;
__host__ __device__ __forceinline__ int buck_off(int j) { return 256 * (31 * j - (j * (j - 1)) / 2); }

constexpr int RING_BYTES = 131072, LDS_BYTES = 163840, MISC_OFF = LDS_BYTES - 512;
constexpr int NWAVES = 8;

#define LDS_WAIT() asm volatile("s_waitcnt lgkmcnt(0)" ::: "memory")
#define VM_WAIT() asm volatile("s_waitcnt vmcnt(0)" ::: "memory")
#define RLX_AGENT __ATOMIC_RELAXED, __HIP_MEMORY_SCOPE_AGENT

__device__ __forceinline__ unsigned cvt_pk_bf16(float lo, float hi) { unsigned r; asm volatile("v_cvt_pk_bf16_f32 %0, %1, %2" : "=v"(r) : "v"(lo), "v"(hi)); return r; }
__device__ __forceinline__ float bf_lo(unsigned w) { return __uint_as_float(w << 16); }
__device__ __forceinline__ float bf_hi(unsigned w) { return __uint_as_float(w & 0xffff0000u); }
__device__ __forceinline__ unsigned pk_fp8x4(float a, float b, float c, float d) {
    a = fminf(fmaxf(a, -448.f), 448.f); b = fminf(fmaxf(b, -448.f), 448.f); c = fminf(fmaxf(c, -448.f), 448.f); d = fminf(fmaxf(d, -448.f), 448.f);
    unsigned w = 0; w = __builtin_amdgcn_cvt_pk_fp8_f32(a, b, w, false); w = __builtin_amdgcn_cvt_pk_fp8_f32(c, d, w, true); return w; }
constexpr float H8_SCALE = 8.f, WD8_SCALE = 256.f;
__device__ __forceinline__ int lane_fresh() { int l = (int)__builtin_amdgcn_mbcnt_hi(~0u, __builtin_amdgcn_mbcnt_lo(~0u, 0u)); asm volatile("" : "+v"(l)); return l; }
__device__ __forceinline__ unsigned pk_i8x4(float a, float b, float c, float d) {
    const int ia = (int)fminf(fmaxf(__builtin_rintf(a), -127.f), 127.f), ib = (int)fminf(fmaxf(__builtin_rintf(b), -127.f), 127.f);
    const int ic = (int)fminf(fmaxf(__builtin_rintf(c), -127.f), 127.f), id = (int)fminf(fmaxf(__builtin_rintf(d), -127.f), 127.f);
    return (unsigned)(ia & 255) | ((unsigned)(ib & 255) << 8) | ((unsigned)(ic & 255) << 16) | ((unsigned)(id & 255) << 24); }
__device__ __forceinline__ unsigned pk_i8x4_magic(float a, float b, float c, float d, float qs) {
    const float M = 12582912.f;
    const unsigned ua = __float_as_uint(fmaf(a, qs, M)), ub = __float_as_uint(fmaf(b, qs, M)), uc = __float_as_uint(fmaf(c, qs, M)), ud = __float_as_uint(fmaf(d, qs, M));
    return (ua & 255u) | ((ub & 255u) << 8) | ((uc & 255u) << 16) | (ud << 24); }
__device__ __forceinline__ float wave_sum(float v) {
#pragma unroll
    for (int o = 1; o < 64; o <<= 1) v += __shfl_xor(v, o);
    return v;
}

#define XB_TMO      128
#define XB_XCNT(j)  (256  + 64 * (j))
#define XB_XSUB(j)  (1280 + 64 * (j))
#define XB_XGEN(j)  (2304 + 64 * (j))
#define XB_TOP      3328
#define XB_TOPGEN   3392
#define XCD_BAR_WORDS 3456
#define XB_SPIN_CAP (1u << 22)
__device__ __forceinline__ unsigned xb_ld(unsigned* p)              { return __hip_atomic_load(p, __ATOMIC_RELAXED, __HIP_MEMORY_SCOPE_AGENT); }
__device__ __forceinline__ unsigned xb_add(unsigned* p, unsigned v) { return __hip_atomic_fetch_add(p, v, __ATOMIC_RELAXED, __HIP_MEMORY_SCOPE_AGENT); }
__device__ __forceinline__ unsigned xb_xcc_id() { return (unsigned)__builtin_amdgcn_s_getreg((3 << 11) | 20) & 0xFu; }
#define XB_SPIN(cond, bar) do { unsigned _sp = 0; while (cond) { __builtin_amdgcn_s_sleep(1); \
    if ((++_sp & 255u) == 0u) { if (xb_ld(&(bar)[XB_TMO])) break; if (_sp > XB_SPIN_CAP) { atomicAdd(&(bar)[XB_TMO], 1u); break; } } } } while (0)
struct XcdBarrier { unsigned* bar; unsigned x; volatile LAS unsigned* st; };
__device__ __forceinline__ XcdBarrier xcd_barrier_post(unsigned* bar, volatile LAS unsigned* st) {
    XcdBarrier b; b.bar = bar; b.x = xb_xcc_id(); b.st = st;
    if (threadIdx.x == 0) (void)xb_add(&bar[XB_XCNT(b.x)], 1u);
    return b;
}
__device__ __forceinline__ void xcd_barrier_complete(unsigned* bar, unsigned x, unsigned& nloc, unsigned& nx) {
    const unsigned G = gridDim.x * gridDim.y * gridDim.z;
    unsigned sum, cnt, mine, sp = 0u;
    for (;;) {
        sum = 0u; cnt = 0u; mine = 0u;
#pragma unroll
        for (unsigned j = 0; j < 16; ++j) { const unsigned c = xb_ld(&bar[XB_XCNT(j)]); sum += c; cnt += (c > 0u) ? 1u : 0u; mine = (j == x) ? c : mine; }
        if (sum == G) break;
        __builtin_amdgcn_s_sleep(1);
        if ((++sp & 255u) == 0u) { if (xb_ld(&bar[XB_TMO])) break; if (sp > XB_SPIN_CAP) { atomicAdd(&bar[XB_TMO], 1u); break; } }
    }
    nloc = mine > 0u ? mine : 1u; nx = cnt > 0u ? cnt : 1u;
}
__device__ __forceinline__ void xcd_barrier(const XcdBarrier& b) {
    asm volatile("s_waitcnt vmcnt(0)" ::: "memory");
    __syncthreads();
    if (threadIdx.x == 0) {
        unsigned* bar = b.bar;
        __builtin_amdgcn_s_waitcnt(0);
        unsigned nloc = b.st[0], nx = b.st[1];
        if (nloc == 0u) { xcd_barrier_complete(bar, b.x, nloc, nx); b.st[0] = nloc; b.st[1] = nx; }
        const unsigned old = xb_add(&bar[XB_XSUB(b.x)], 1u);
        const unsigned gen = old / nloc;
        if (old + 1u == (gen + 1u) * nloc) {
            __builtin_amdgcn_fence(__ATOMIC_RELEASE, "agent");
            asm volatile("s_waitcnt vmcnt(0)" ::: "memory");
            const unsigned og = xb_add(&bar[XB_TOP], 1u);
            const unsigned tg = og / nx;
            if (og + 1u == (tg + 1u) * nx) xb_add(&bar[XB_TOPGEN], 1u);
            else XB_SPIN(xb_ld(&bar[XB_TOPGEN]) == tg, bar);
            __builtin_amdgcn_fence(__ATOMIC_ACQUIRE, "agent");
            xb_add(&bar[XB_XGEN(b.x)], 1u);
            asm volatile("s_waitcnt vmcnt(0)" ::: "memory");
        } else {
            XB_SPIN(xb_ld(&bar[XB_XGEN(b.x)]) == gen, bar);
            __builtin_amdgcn_fence(__ATOMIC_ACQUIRE, "agent");
            asm volatile("s_waitcnt vmcnt(0)" ::: "memory");
        }
    }
    __syncthreads();
}

namespace pg8 {
constexpr int BM = 256, BK = 64, HALF = 128, HTB = HALF * BK * 2, NXCD = 8, WGM = 8;
__host__ __device__ __forceinline__ int lds_byte(int r, int c) { const int st = (r >> 4) * 2 + (c >> 5), rr = r & 15, cc = c & 31, ob = rr * 64 + cc * 2; return st * 1024 + (ob ^ (((ob >> 9) & 1) << 5)); }
__host__ __device__ __forceinline__ void stage_rc(int b, int& R, int& C) { const int st = b / 1024, sb = b % 1024, swz = sb ^ (((sb >> 9) & 1) << 5); R = (st >> 1) * 16 + swz / 64; C = (st & 1) * 32 + (swz % 64) / 2; }
__host__ __device__ __forceinline__ int perm32(int rho) { const int n = rho >> 4, i = rho & 15; return 8 * (i >> 2) + 4 * n + (i & 3); }

struct Unit { int pm, pn, pb, ex; };
struct Gemm { const bf16* A; const bf16* Bt; int K; const int* rowidx; int lda; const bf16* A1; int ksplit; };

struct StaticOrder {
    int nM, nN, nwg, G, c;
    __device__ void init(int M, int N, int G_, int c_) { nM = M / BM; nN = N / BM; nwg = nM * nN; G = G_; c = c_; }
    __device__ bool next(int i, Unit& u) const {
        const long L = (long)i * G + c; if (L >= nwg) return false;
        int wgid = (int)L; { const int q = nwg / NXCD, r = nwg % NXCD, xcd = wgid % NXCD, off = wgid / NXCD; wgid = (xcd < r ? xcd * (q + 1) : r * (q + 1) + (xcd - r) * q) + off; }
        const int nig = WGM * nN, gid = wgid / nig, fm = gid * WGM, gsz = (nM - fm) < WGM ? (nM - fm) : WGM;
        u.pm = fm + ((wgid % nig) % gsz); u.pn = (wgid % nig) / gsz; u.pb = u.pn; u.ex = 0; return true;
    }
};
struct GroupedOrder {
    const LAS int* tstart;
    int nN, G, c, ntiles;
    __device__ bool next(int i, Unit& u) const {
        const long L = (long)i * G + c; if (L >= (long)ntiles * nN) return false;
        const int ti = (int)(L / nN), pn = (int)(L % nN);
        int e = 0;
#pragma unroll 1
        for (int k = 1; k < 32; ++k) e += (tstart[k] <= ti) ? 1 : 0;
        u.pm = ti; u.pn = pn; u.pb = e * nN + pn; u.ex = e; return true;
    }
};

template <class Epi, class Sched, bool ALIGN_EPI, bool GATHER = false, int QMODE = 0>
__device__ __forceinline__ void gemm_phase(LAS unsigned char* lds, const Gemm g, const Sched& S, const Epi& E) {
    const int lane = lane_fresh(), wid = __builtin_amdgcn_readfirstlane((int)threadIdx.x >> 6), tid = wid * 64 + lane, wr = wid >> 2, wc = wid & 3, fr = lane & 15, fq = lane >> 4;
    const int K = g.K, nt = K / BK;
    int RA[2], CA[2]; unsigned voffB[2];
#pragma unroll
    for (int i = 0; i < 2; ++i) { int R, C; stage_rc(tid * 16 + i * 8192, R, C); const int Rb = Epi::PERM ? ((R & ~31) + perm32(R & 31)) : R;
        RA[i] = R; CA[i] = C; voffB[i] = (unsigned)(Rb * K + C) * 2u; }
    const size_t kstep = (size_t)(BK * 2);
    const size_t hstep = (size_t)HALF * K * 2;
    const size_t tstep = 2 * hstep;
    const unsigned ldsw = (unsigned)wid * 1024u;
    const int aoff = lds_byte(wr * 64 + fr, fq * 8), boff = lds_byte(wc * 32 + fr, fq * 8);
#define PG8_SA(b, h) (((b) * 2 + (h)) * HTB)
#define PG8_SB(b, h) ((4 + (b) * 2 + (h)) * HTB)
#define PG8_STAGEB(bufoff, gbase) do { _Pragma("unroll") for (int _i = 0; _i < 2; ++_i) \
        __builtin_amdgcn_global_load_lds((const unsigned*)((const char*)(gbase) + voffB[_i]), (LAS unsigned*)(lds + (bufoff) + ldsw + _i * 8192), 16, 0, 0); } while (0)
#define PG8_STAGEA(bufoff, gbase, vo, h) do { _Pragma("unroll") for (int _i = 0; _i < 2; ++_i) \
        __builtin_amdgcn_global_load_lds((const unsigned*)((const char*)(gbase) + (vo)[h][_i]), (LAS unsigned*)(lds + (bufoff) + ldsw + _i * 8192), 16, 0, 0); } while (0)
#define PG8_LDA(dst, b, h) do { _Pragma("unroll") for (int m = 0; m < 4; ++m) _Pragma("unroll") for (int k = 0; k < 2; ++k) dst[m][k] = *(const LAS bf16x8*)(lds + PG8_SA(b, h) + aoff + m * 2048 + k * 1024); } while (0)
#define PG8_LDB(dst, b, h) do { _Pragma("unroll") for (int n = 0; n < 2; ++n) _Pragma("unroll") for (int k = 0; k < 2; ++k) dst[n][k] = *(const LAS bf16x8*)(lds + PG8_SB(b, h) + boff + n * 2048 + k * 1024); } while (0)
#define PG8_CAT(x0, x1) __builtin_shufflevector(__builtin_bit_cast(i32x4, x0), __builtin_bit_cast(i32x4, x1), 0, 1, 2, 3, 4, 5, 6, 7)
#define PG8_MMA(ai, bj, At, Bt) do { __builtin_amdgcn_s_setprio(1); _Pragma("unroll") for (int m = 0; m < 4; ++m) _Pragma("unroll") for (int n = 0; n < 2; ++n) { \
        if constexpr (QMODE == 1) asm volatile("v_mfma_scale_f32_16x16x128_f8f6f4 %0, %1, %2, %0, %3, %3 op_sel_hi:[0,0,0]" : "+v"(acc[ai][bj][m][n]) : "v"(PG8_CAT(Bt[n][0], Bt[n][1])), "v"(PG8_CAT(At[m][0], At[m][1])), "v"(sc1)); \
        else if constexpr (QMODE == 2) { _Pragma("unroll") for (int k = 0; k < 2; ++k) acc[ai][bj][m][n] = __builtin_bit_cast(f32x4, __builtin_amdgcn_mfma_i32_16x16x64_i8(__builtin_bit_cast(i32x4, Bt[n][k]), __builtin_bit_cast(i32x4, At[m][k]), __builtin_bit_cast(i32x4, acc[ai][bj][m][n]), 0, 0, 0)); } \
        else { _Pragma("unroll") for (int k = 0; k < 2; ++k) acc[ai][bj][m][n] = __builtin_amdgcn_mfma_f32_16x16x32_bf16(Bt[n][k], At[m][k], acc[ai][bj][m][n], 0, 0, 0); } } __builtin_amdgcn_s_setprio(0); } while (0)
#define PG8_WAIT_V(n) asm volatile("s_waitcnt vmcnt(" #n ")" ::: "memory")
#define PG8_WAIT_L(n) asm volatile("s_waitcnt lgkmcnt(" #n ")" ::: "memory")
#define PG8_BAR __builtin_amdgcn_s_barrier()
#define PG8_SCHED __builtin_amdgcn_sched_barrier(0)
#define PG8_AOFF(vo, u) do { _Pragma("unroll") for (int _h = 0; _h < 2; ++_h) _Pragma("unroll") for (int _i = 0; _i < 2; ++_i) { \
        const int _r = (GATHER ? (u).pm * BM : 0) + _h * HALF + RA[_i]; const int _row = GATHER ? g.rowidx[_r] : _r; (vo)[_h][_i] = (unsigned)(_row * g.lda + CA[_i]) * 2u; } } while (0)
    Unit cur, nxt; int ui = 0;
    if (!S.next(0, cur)) return;
    int sc1 = 0x7f7f7f7f; asm volatile("" : "+v"(sc1));
    f32x4 acc[2][2][4][2];
#pragma unroll
    for (int a = 0; a < 2; ++a)
#pragma unroll
        for (int b = 0; b < 2; ++b)
#pragma unroll
            for (int m = 0; m < 4; ++m)
#pragma unroll
                for (int n = 0; n < 2; ++n) acc[a][b][m][n] = (f32x4){0.f, 0.f, 0.f, 0.f};
    bf16x8 At[4][2], B0[2][2], B1[2][2];
    unsigned voC[2][2], voN[2][2];
    PG8_AOFF(voC, cur);
    const size_t tstepA = (size_t)BM * g.lda * 2;
    const char* cA = (const char*)g.A + (GATHER ? 0 : (size_t)cur.pm * tstepA); const char* cA1 = (const char*)g.A1 - (size_t)g.ksplit * kstep + (GATHER ? 0 : (size_t)cur.pm * tstepA);
#define PG8_AP(t_) (((t_) < g.ksplit ? cA : cA1) + (size_t)(t_) * kstep)
    const char* cB = (const char*)g.Bt + (size_t)cur.pb * tstep;
    PG8_STAGEB(PG8_SB(0, 0), cB); PG8_STAGEB(PG8_SB(0, 1), cB + hstep); PG8_STAGEA(PG8_SA(0, 0), cA, voC, 0); PG8_STAGEA(PG8_SA(0, 1), cA, voC, 1);
    if (wr == 1) PG8_BAR;
    PG8_WAIT_V(2); PG8_BAR;
    PG8_STAGEB(PG8_SB(1, 0), cB + kstep); PG8_STAGEA(PG8_SA(1, 0), PG8_AP(1), voC, 0); PG8_STAGEB(PG8_SB(1, 1), cB + hstep + kstep);
    PG8_WAIT_V(6); PG8_BAR;
    for (;;) {
        const bool has_next = S.next(ui + 1, nxt);
        if constexpr (GATHER) { if (has_next) { PG8_AOFF(voN, nxt); } else {
#pragma unroll
            for (int _h = 0; _h < 2; ++_h)
#pragma unroll
                for (int _i = 0; _i < 2; ++_i) voN[_h][_i] = voC[_h][_i]; } }
        const char* nB = has_next ? (const char*)g.Bt + (size_t)nxt.pb * tstep : cB;
        const char* nA = (GATHER || !has_next) ? cA : (const char*)g.A + (size_t)nxt.pm * tstepA;
        const char* nA1 = (GATHER || !has_next) ? cA1 : (const char*)g.A1 - (size_t)g.ksplit * kstep + (size_t)nxt.pm * tstepA;
        for (int t = 0; t < nt; t += 2) {
            const bool last = (t == nt - 2);
            const char* a1 = PG8_AP(t + 1);
            const char* a2 = last ? nA : PG8_AP(t + 2); const char* b2 = last ? nB : cB + (size_t)(t + 2) * kstep;
            const char* a3 = last ? nA + kstep : PG8_AP(t + 3); const char* b3 = b2 + kstep;
            if constexpr (Epi::MIDHOOK) { if (t == g.ksplit) E.mid(acc, cur, wr, wc, fr, fq); }
            unsigned vo2[2][2];
#pragma unroll
            for (int _h = 0; _h < 2; ++_h)
#pragma unroll
                for (int _i = 0; _i < 2; ++_i) { if constexpr (GATHER) vo2[_h][_i] = last ? voN[_h][_i] : voC[_h][_i]; else vo2[_h][_i] = voC[_h][_i]; }
            PG8_LDB(B0, 0, 0); PG8_LDB(B1, 0, 1); PG8_SCHED; PG8_LDA(At, 0, 0); PG8_STAGEA(PG8_SA(1, 1), a1, voC, 1);
            PG8_WAIT_V(8); PG8_WAIT_L(0); PG8_BAR; PG8_MMA(0, 0, At, B0); PG8_MMA(0, 1, At, B1); PG8_BAR; PG8_SCHED;
            PG8_LDA(At, 0, 1); PG8_STAGEB(PG8_SB(0, 0), b2); PG8_STAGEB(PG8_SB(0, 1), b2 + hstep); PG8_STAGEA(PG8_SA(0, 0), a2, vo2, 0);
            PG8_WAIT_V(8); PG8_WAIT_L(0); PG8_BAR; PG8_MMA(1, 0, At, B0); PG8_MMA(1, 1, At, B1); PG8_BAR; PG8_SCHED;
            PG8_LDB(B0, 1, 0); PG8_LDB(B1, 1, 1); PG8_SCHED; PG8_LDA(At, 1, 0); PG8_STAGEA(PG8_SA(0, 1), a2, vo2, 1);
            PG8_WAIT_V(8); PG8_WAIT_L(0); PG8_BAR; PG8_MMA(0, 0, At, B0); PG8_MMA(0, 1, At, B1); PG8_BAR; PG8_SCHED;
            PG8_LDA(At, 1, 1); PG8_STAGEB(PG8_SB(1, 0), b3); PG8_STAGEB(PG8_SB(1, 1), b3 + hstep); PG8_STAGEA(PG8_SA(1, 0), a3, vo2, 0);
            PG8_WAIT_V(8); PG8_WAIT_L(0); PG8_BAR; PG8_MMA(1, 0, At, B0); PG8_MMA(1, 1, At, B1); PG8_BAR; PG8_SCHED;
        }
        if constexpr (ALIGN_EPI) { if (wr == 0) PG8_BAR; }
        if constexpr (QMODE == 1) asm volatile("s_nop 15\n\ts_nop 15\n\ts_nop 15\n\ts_nop 15\n\ts_nop 15" ::: "memory");
        if constexpr (QMODE == 2) {
#pragma unroll
            for (int a = 0; a < 2; ++a)
#pragma unroll
                for (int b = 0; b < 2; ++b)
#pragma unroll
                    for (int m = 0; m < 4; ++m)
#pragma unroll
                        for (int n = 0; n < 2; ++n) acc[a][b][m][n] = __builtin_convertvector(__builtin_bit_cast(i32x4, acc[a][b][m][n]), f32x4); }
        E(acc, cur, wr, wc, fr, fq);
        if (!has_next) break;
#pragma unroll
        for (int a = 0; a < 2; ++a)
#pragma unroll
            for (int b = 0; b < 2; ++b)
#pragma unroll
                for (int m = 0; m < 4; ++m)
#pragma unroll
                    for (int n = 0; n < 2; ++n) acc[a][b][m][n] = (f32x4){0.f, 0.f, 0.f, 0.f};
        cur = nxt; cB = nB; cA = nA; cA1 = nA1; ++ui;
        if constexpr (GATHER) {
#pragma unroll
            for (int _h = 0; _h < 2; ++_h)
#pragma unroll
                for (int _i = 0; _i < 2; ++_i) voC[_h][_i] = voN[_h][_i]; }
        if constexpr (ALIGN_EPI) { if (wr == 1) PG8_BAR; }
    }
    PG8_WAIT_V(0);
    if constexpr (!ALIGN_EPI) { if (wr == 0) PG8_BAR; }
    PG8_BAR;
#undef PG8_SA
#undef PG8_SB
#undef PG8_STAGEA
#undef PG8_STAGEB
#undef PG8_LDA
#undef PG8_LDB
#undef PG8_MMA
#undef PG8_WAIT_V
#undef PG8_WAIT_L
#undef PG8_BAR
#undef PG8_SCHED
#undef PG8_AOFF
#undef PG8_AP
#undef PG8_CAT
}

#define EPI_LOOP_BEGIN _Pragma("unroll") for (int ai = 0; ai < 2; ++ai) _Pragma("unroll") for (int m = 0; m < 4; ++m) { const int row = u.pm * BM + ai * HALF + wr * 64 + m * 16 + fr; _Pragma("unroll") for (int bj = 0; bj < 2; ++bj) { const int colt = bj * HALF + wc * 32 + 8 * fq;
#define EPI_LOOP_END } }
__device__ __forceinline__ int opaque0() { int z = 0; asm volatile("" : "+v"(z)); return z; }
__device__ __forceinline__ u32x4 pack8(f32x4 v0, f32x4 v1) { u32x4 w; w.x = cvt_pk_bf16(v0[0], v0[1]); w.y = cvt_pk_bf16(v0[2], v0[3]); w.z = cvt_pk_bf16(v1[0], v1[1]); w.w = cvt_pk_bf16(v1[2], v1[3]); return w; }
__device__ __forceinline__ void unpack8(u32x4 w, f32x4& a, f32x4& b) { a = (f32x4){bf_lo(w.x), bf_hi(w.x), bf_lo(w.y), bf_hi(w.y)}; b = (f32x4){bf_lo(w.z), bf_hi(w.z), bf_lo(w.w), bf_hi(w.w)}; }

struct EpiQKV {
    static constexpr bool PERM = true, MIDHOOK = false;
    bf16* O; int pn0; const float* rsc; const float* csc;
    float* kmean;
    __device__ __forceinline__ void operator()(const f32x4 (&acc)[2][2][4][2], const Unit& u, int wr, int wc, int fr_, int fq_) const {
        const int fr = fr_ + opaque0(), fq = fq_ + opaque0();
        const int pn = u.pn + pn0;
        if (kmean != nullptr && (pn >> 2) == 1) {
#pragma unroll
            for (int bj = 0; bj < 2; ++bj)
#pragma unroll
                for (int n = 0; n < 2; ++n) { f32x4 sm = (f32x4){0.f, 0.f, 0.f, 0.f};
#pragma unroll
                    for (int ai = 0; ai < 2; ++ai)
#pragma unroll
                        for (int m = 0; m < 4; ++m) sm += rsc ? acc[ai][bj][m][n] * rsc[u.pm * BM + ai * HALF + wr * 64 + m * 16 + fr] : acc[ai][bj][m][n];
                    if (rsc) sm = sm * *(const f32x4*)(csc + u.pn * BM + bj * HALF + wc * 32 + 8 * fq + 4 * n);
#pragma unroll
                    for (int e = 0; e < 4; ++e) { float v = sm[e]; v += __shfl_xor(v, 1); v += __shfl_xor(v, 2); v += __shfl_xor(v, 4); v += __shfl_xor(v, 8); sm[e] = v; }
                    if ((fr_ & 15) == 0) { float* dst = kmean + ((size_t)((u.pm >> 5) * NH + (pn & 3) * 2 + bj) * 32 + (u.pm & 31)) * HD + wc * 32 + 8 * fq + 4 * n;
#pragma unroll
                        for (int e = 0; e < 4; ++e) atomicAdd(dst + e, sm[e] * (1.f / 256.f)); } }
        }
        bf16* base = O + (size_t)(pn >> 2) * ((size_t)NTOK * WQ) + (pn & 3) * 256;
        EPI_LOOP_BEGIN
            f32x4 v0 = acc[ai][bj][m][0], v1 = acc[ai][bj][m][1];
            if (rsc) { const float r = rsc[row]; v0 = v0 * r * *(const f32x4*)(csc + u.pn * BM + colt); v1 = v1 * r * *(const f32x4*)(csc + u.pn * BM + colt + 4); }
            *(u32x4*)(base + (size_t)row * WQ + colt) = pack8(v0, v1);
        EPI_LOOP_END
    }
};
struct EpiGates {
    static constexpr bool PERM = true, MIDHOOK = false;
    bf16* GD; bf16* R; const float* bias; const float* rsc; const float* csc;
    __device__ __forceinline__ void operator()(const f32x4 (&acc)[2][2][4][2], const Unit& u, int wr, int wc, int fr_, int fq_) const {
        const int fr = fr_ + opaque0(), fq = fq_ + opaque0();
        const int cl = wc * 32 + 8 * fq, col = u.pn * HALF + cl;
        const f32x4 cm0 = *(const f32x4*)(csc + u.pn * BM + cl), cm1 = *(const f32x4*)(csc + u.pn * BM + cl + 4), cd0 = *(const f32x4*)(csc + u.pn * BM + HALF + cl), cd1 = *(const f32x4*)(csc + u.pn * BM + HALF + cl + 4);
        const f32x4 bm0 = *(const f32x4*)(bias + col), bm1 = *(const f32x4*)(bias + col + 4), bd0 = *(const f32x4*)(bias + DM + col), bd1 = *(const f32x4*)(bias + DM + col + 4);
#pragma unroll
        for (int ai = 0; ai < 2; ++ai)
#pragma unroll
            for (int m = 0; m < 4; ++m) { const int row = u.pm * BM + ai * HALF + wr * 64 + m * 16 + fr; const float r = rsc[row];
                f32x4 am0 = acc[ai][0][m][0] * r * cm0 + bm0, am1 = acc[ai][0][m][1] * r * cm1 + bm1, ad0 = acc[ai][1][m][0] * r * cd0 + bd0, ad1 = acc[ai][1][m][1] * r * cd1 + bd1;
                f32x4 gd0, gd1, rr0, rr1;
#pragma unroll
                for (int e = 0; e < 4; ++e) { const float im0 = 1.f + __builtin_amdgcn_exp2f(-LOG2E * am0[e]), im1 = 1.f + __builtin_amdgcn_exp2f(-LOG2E * am1[e]);
                    const float id0 = 1.f + __builtin_amdgcn_exp2f(-LOG2E * ad0[e]), id1 = 1.f + __builtin_amdgcn_exp2f(-LOG2E * ad1[e]);
                    gd0[e] = __builtin_amdgcn_rcpf(id0); gd1[e] = __builtin_amdgcn_rcpf(id1); rr0[e] = id0 * __builtin_amdgcn_rcpf(im0); rr1[e] = id1 * __builtin_amdgcn_rcpf(im1); }
                *(u32x4*)(GD + (size_t)row * DM + col) = pack8(gd0, gd1); *(u32x4*)(R + (size_t)row * DM + col) = pack8(rr0, rr1); }
    }
};
template <bool ADD> struct EpiMix {
    static constexpr bool PERM = true, MIDHOOK = false;
    bf16* MIX; const bf16* G; int goff;
    __device__ __forceinline__ void operator()(const f32x4 (&acc)[2][2][4][2], const Unit& u, int wr, int wc, int fr_, int fq_) const {
        const int fr = fr_ + opaque0(), fq = fq_ + opaque0();
        EPI_LOOP_BEGIN
            const int col = u.pn * BM + colt;
            f32x4 g0, g1; unpack8(*(const u32x4*)(G + (size_t)row * NGATE + goff + col), g0, g1);
            f32x4 v0 = acc[ai][bj][m][0] * g0, v1 = acc[ai][bj][m][1] * g1;
            if (ADD) { f32x4 t0, t1; unpack8(*(const u32x4*)(MIX + (size_t)row * DM + col), t0, t1); v0 += t0; v1 += t1; }
            *(u32x4*)(MIX + (size_t)row * DM + col) = pack8(v0, v1);
        EPI_LOOP_END
    }
};
struct EpiMix2 {
    static constexpr bool PERM = true, MIDHOOK = true;
    bf16* MIX; const bf16* GD; const bf16* R; unsigned* mmax;
    __device__ __forceinline__ void mid(f32x4 (&acc)[2][2][4][2], const Unit& u, int wr, int wc, int fr_, int fq_) const {
        const int fr = fr_ + opaque0(), fq = fq_ + opaque0();
#pragma unroll
        for (int ai = 0; ai < 2; ++ai) {
            u32x4 rw[4][2];
#pragma unroll
            for (int m = 0; m < 4; ++m) { const int row = u.pm * BM + ai * HALF + wr * 64 + m * 16 + fr;
#pragma unroll
                for (int bj = 0; bj < 2; ++bj) rw[m][bj] = *(const u32x4*)(R + (size_t)row * DM + u.pn * BM + bj * HALF + wc * 32 + 8 * fq); }
#pragma unroll
            for (int m = 0; m < 4; ++m)
#pragma unroll
                for (int bj = 0; bj < 2; ++bj) { f32x4 r0, r1; unpack8(rw[m][bj], r0, r1); acc[ai][bj][m][0] *= r0; acc[ai][bj][m][1] *= r1; }
#pragma unroll
            for (int m = 0; m < 4; ++m) asm volatile("" : "+v"(acc[ai][0][m][0]), "+v"(acc[ai][0][m][1]), "+v"(acc[ai][1][m][0]), "+v"(acc[ai][1][m][1]) :: "memory");
        }
    }
    __device__ __forceinline__ void operator()(const f32x4 (&acc)[2][2][4][2], const Unit& u, int wr, int wc, int fr_, int fq_) const {
        const int fr = fr_ + opaque0(), fq = fq_ + opaque0();
#pragma unroll
        for (int ai = 0; ai < 2; ++ai)
#pragma unroll
            for (int m = 0; m < 4; ++m) { const int row = u.pm * BM + ai * HALF + wr * 64 + m * 16 + fr; float mx = 0.f;
#pragma unroll
                for (int bj = 0; bj < 2; ++bj) { const int col = u.pn * BM + bj * HALF + wc * 32 + 8 * fq;
                    f32x4 g0, g1; unpack8(*(const u32x4*)(GD + (size_t)row * DM + col), g0, g1);
                    const f32x4 v0 = acc[ai][bj][m][0] * g0, v1 = acc[ai][bj][m][1] * g1;
                    *(u32x4*)(MIX + (size_t)row * DM + col) = pack8(v0, v1);
#pragma unroll
                    for (int e = 0; e < 4; ++e) mx = fmaxf(mx, fmaxf(fabsf(v0[e]), fabsf(v1[e]))); }
                mx = fmaxf(mx, __shfl_xor(mx, 16)); mx = fmaxf(mx, __shfl_xor(mx, 32));
                if (fq == 0) __hip_atomic_fetch_max(mmax + row, __float_as_uint(mx), RLX_AGENT); }
    }
};
struct EpiResid {
    static constexpr bool PERM = true, MIDHOOK = false;
    const float* X; float* X1; const float* g2; unsigned* umax;
    const float* rsc; const float* csc;
    __device__ __forceinline__ void operator()(const f32x4 (&acc)[2][2][4][2], const Unit& u, int wr, int wc, int fr_, int fq_) const {
        const int fr = fr_ + opaque0(), fq = fq_ + opaque0();
        f32x4 gg[2][2];
#pragma unroll
        for (int bj = 0; bj < 2; ++bj) { const int c = u.pn * BM + bj * HALF + wc * 32 + 8 * fq; gg[bj][0] = *(const f32x4*)(g2 + c); gg[bj][1] = *(const f32x4*)(g2 + c + 4); }
#pragma unroll
        for (int ai = 0; ai < 2; ++ai)
#pragma unroll
            for (int m = 0; m < 4; ++m) { const int row = u.pm * BM + ai * HALF + wr * 64 + m * 16 + fr; float mx = 0.f;
#pragma unroll
                for (int bj = 0; bj < 2; ++bj) { const size_t o = (size_t)row * DM + u.pn * BM + bj * HALF + wc * 32 + 8 * fq;
                    const int colx = u.pn * BM + bj * HALF + wc * 32 + 8 * fq; const float rs_ = rsc[row];
                    const f32x4 v0 = *(const f32x4*)(X + o) + acc[ai][bj][m][0] * rs_ * *(const f32x4*)(csc + colx), v1 = *(const f32x4*)(X + o + 4) + acc[ai][bj][m][1] * rs_ * *(const f32x4*)(csc + colx + 4);
                    *(f32x4*)(X1 + o) = v0; *(f32x4*)(X1 + o + 4) = v1;
                    const f32x4 a0 = v0 * gg[bj][0], a1 = v1 * gg[bj][1];
#pragma unroll
                    for (int e = 0; e < 4; ++e) mx = fmaxf(mx, fmaxf(fabsf(a0[e]), fabsf(a1[e]))); }
                mx = fmaxf(mx, __shfl_xor(mx, 16)); mx = fmaxf(mx, __shfl_xor(mx, 32));
                if (fq == 0) __hip_atomic_fetch_max(umax + row, __float_as_uint(mx), RLX_AGENT); }
    }
};
struct EpiMoe1 {
    static constexpr bool PERM = true, MIDHOOK = false;
    bf16* H; const float* rms; const int* rowtok; const float* rsu; const float* csgu;
    __device__ __forceinline__ void operator()(const f32x4 (&acc)[2][2][4][2], const Unit& u, int wr, int wc, int fr_, int fq_) const {
        const int fr = fr_ + opaque0(), fq = fq_ + opaque0();
        const float* cg = csgu + (size_t)u.ex * 1024 + u.pn * BM + wc * 32 + 8 * fq;
        const f32x4 cg0 = *(const f32x4*)cg, cg1 = *(const f32x4*)(cg + 4), cu0 = *(const f32x4*)(cg + HALF), cu1 = *(const f32x4*)(cg + HALF + 4);
#pragma unroll
        for (int ai = 0; ai < 2; ++ai)
#pragma unroll
            for (int m = 0; m < 4; ++m) { const int row = u.pm * BM + ai * HALF + wr * 64 + m * 16 + fr; const int tok = rowtok[row]; const float rs = rms[tok] * rsu[tok];
                f32x4 o[2];
#pragma unroll
                for (int n = 0; n < 2; ++n)
#pragma unroll
                    for (int e = 0; e < 4; ++e) { const float gt = acc[ai][0][m][n][e] * rs * (n ? cg1[e] : cg0[e]), up = acc[ai][1][m][n][e] * rs * (n ? cu1[e] : cu0[e]);
                        o[n][e] = gt * __builtin_amdgcn_rcpf(1.f + __builtin_amdgcn_exp2f(-LOG2E * gt)) * up; }
                u32x2 h8; h8.x = pk_fp8x4(o[0][0] * H8_SCALE, o[0][1] * H8_SCALE, o[0][2] * H8_SCALE, o[0][3] * H8_SCALE); h8.y = pk_fp8x4(o[1][0] * H8_SCALE, o[1][1] * H8_SCALE, o[1][2] * H8_SCALE, o[1][3] * H8_SCALE);
                *(u32x2*)((unsigned char*)H + (size_t)row * DEXP + u.pn * HALF + wc * 32 + 8 * fq) = h8; }
    }
};
struct EpiMoe2 {
    static constexpr bool PERM = true, MIDHOOK = false;
    bf16* Y; const float* roww;
    __device__ __forceinline__ void operator()(const f32x4 (&acc)[2][2][4][2], const Unit& u, int wr, int wc, int fr_, int fq_) const {
        const int fr = fr_ + opaque0(), fq = fq_ + opaque0();
        EPI_LOOP_BEGIN
            const float w = roww[row] * (1.f / (H8_SCALE * WD8_SCALE));
            *(u32x4*)(Y + (size_t)row * DM + u.pn * BM + colt) = pack8(acc[ai][bj][m][0] * w, acc[ai][bj][m][1] * w);
        EPI_LOOP_END
    }
};
}

namespace att {
constexpr int SHM_K = 16384, SHM_V = 16384;
constexpr int L_V = 0, L_K = 2 * SHM_V;
constexpr int OST_STRIDE = 68, OST_WAVE = 32 * OST_STRIDE * 4;
constexpr int L_OST = 65536;
constexpr int L_TAB = 136 * 1024;
constexpr int L_SELPFX = 148 * 1024;
#define KSWZ(row, colB) ((row) * 256 + ((colB) ^ (((row) & 7) << 4)))
#define SBAR() __builtin_amdgcn_sched_barrier(0)
__device__ __forceinline__ int v_st(int k, int c) { const int kk = (k & ~0xC) | ((k & 4) << 1) | ((k & 8) >> 1); return ((kk >> 3) * 4 + (c >> 5)) * 512 + ((kk & 7) * 32 + (c & 31)) * 2; }
__device__ __forceinline__ int v_rd_base(int lane) { return ((lane & 3) << 3) | (((lane >> 2) & 3) << 6) | (((lane >> 4) & 1) << 5) | (((lane >> 5) & 1) << 8); }
constexpr int v_rd_off(int d0, int ks, int half) { return d0 * 512 + ks * 4096 + half * 2048; }
__device__ __forceinline__ int crow(int r, int hi) { return (r & 3) + 8 * (r >> 2) + 4 * hi; }

template <int KB>
__device__ __forceinline__ void qkt(f32x16& p0, f32x16& p1, const LAS char* K_lds, int r32, int hi, const bf16x8* qr, float bkc) {
#pragma unroll
    for (int r = 0; r < 16; ++r) { const float c_ = (float)((r & 3) + 8 * (r >> 2)); p0[r] = c_ * bkc; p1[r] = c_ * bkc; }
    const LAS char* kb[4];
#pragma unroll
    for (int dd = 0; dd < 4; ++dd) kb[dd] = K_lds + KB * SHM_K + KSWZ(r32, (dd * 16 + hi * 8) * 2);
#pragma unroll
    for (int d0 = 0; d0 < 8; ++d0) { const LAS char* a = kb[d0 & 3] + (d0 >> 2) * 128;
        bf16x8 b0 = *reinterpret_cast<const LAS bf16x8*>(a);
        bf16x8 b1 = *reinterpret_cast<const LAS bf16x8*>(a + 32 * 256);
        p0 = __builtin_amdgcn_mfma_f32_32x32x16_bf16(b0, qr[d0], p0, 0, 0, 0);
        p1 = __builtin_amdgcn_mfma_f32_32x32x16_bf16(b1, qr[d0], p1, 0, 0, 0); }
}
template <int VB>
__device__ __forceinline__ void pv_tile(f32x16* o, int vb0, bf16x8 pa0, bf16x8 pa1, bf16x8 pa2, bf16x8 pa3) {
#define TRRD(dst, off) asm volatile("ds_read_b64_tr_b16 %0, %1 offset:%2" : "=&v"(dst) : "v"(vb0), "i"(off) : "memory")
#define PV_D0(d0) do { s16x4 l0, l1, l2, l3, h0, h1, h2, h3; constexpr int b_ = VB * SHM_V + v_rd_off(d0, 0, 0); \
        TRRD(l0, b_); TRRD(h0, b_ + 2048); TRRD(l1, b_ + 4096); TRRD(h1, b_ + 6144); TRRD(l2, b_ + 8192); TRRD(h2, b_ + 10240); TRRD(l3, b_ + 12288); TRRD(h3, b_ + 14336); \
        asm volatile("s_waitcnt lgkmcnt(0)" ::: "memory"); SBAR(); \
        o[d0] = __builtin_amdgcn_mfma_f32_32x32x16_bf16((bf16x8){l0[0], l0[1], l0[2], l0[3], h0[0], h0[1], h0[2], h0[3]}, pa0, o[d0], 0, 0, 0); \
        o[d0] = __builtin_amdgcn_mfma_f32_32x32x16_bf16((bf16x8){l1[0], l1[1], l1[2], l1[3], h1[0], h1[1], h1[2], h1[3]}, pa1, o[d0], 0, 0, 0); \
        o[d0] = __builtin_amdgcn_mfma_f32_32x32x16_bf16((bf16x8){l2[0], l2[1], l2[2], l2[3], h2[0], h2[1], h2[2], h2[3]}, pa2, o[d0], 0, 0, 0); \
        o[d0] = __builtin_amdgcn_mfma_f32_32x32x16_bf16((bf16x8){l3[0], l3[1], l3[2], l3[3], h3[0], h3[1], h3[2], h3[3]}, pa3, o[d0], 0, 0, 0); } while (0)
    PV_D0(0); PV_D0(1); PV_D0(2); PV_D0(3);
#undef PV_D0
#undef TRRD
}

struct Parts { const bf16* pbase[3]; const float* plse[3]; const float* psc[3]; };
template <int NMERGE>
__device__ __forceinline__ void row_epilogue(f32x16 (&o)[4], float m_reg, float l_reg, int hi, bf16* dstb, long ro, float* lseb, float* scb, int li, int nparts, const Parts& P) {
    const bool ok = ro >= 0; const long rr = ok ? ro : 0; const int lj = ok ? li : 0;
    float M = (l_reg > 0.f) ? m_reg : -__builtin_inff();
    float L[3] = {-__builtin_inff(), -__builtin_inff(), -__builtin_inff()};
    if constexpr (NMERGE > 0) {
#pragma unroll
        for (int s = 0; s < NMERGE; ++s) if (s < nparts) { L[s] = P.plse[s][lj]; M = fmaxf(M, L[s]); }
    }
    const float f_own = (l_reg > 0.f) ? __builtin_amdgcn_exp2f(m_reg - M) : 0.f;
    float tot = l_reg * f_own; float fs[3] = {0.f, 0.f, 0.f};
    if constexpr (NMERGE > 0) {
#pragma unroll
        for (int s = 0; s < NMERGE; ++s) if (s < nparts) { fs[s] = (L[s] > -__builtin_inff()) ? __builtin_amdgcn_exp2f(L[s] - M) : 0.f; tot += fs[s]; }
    }
    const float inv = tot > 0.f ? 1.f / tot : 0.f, sc = f_own * inv;
    if (lseb != nullptr && ok && hi == 0) lseb[li] = (l_reg > 0.f) ? (m_reg + __builtin_log2f(l_reg)) : -__builtin_inff();
    if constexpr (NMERGE > 0) {
#pragma unroll
        for (int s = 0; s < NMERGE; ++s) fs[s] = (s < nparts) ? fs[s] * inv * P.psc[s][lj] : 0.f;
#pragma unroll
        for (int d0 = 0; d0 < 4; ++d0) {
#pragma unroll
            for (int r = 0; r < 16; ++r) o[d0][r] *= sc;
#pragma unroll
            for (int s = 0; s < NMERGE; ++s) if (s < nparts) { const float f = fs[s];
#pragma unroll
                for (int p = 0; p < 2; ++p) { const u32x2 w = *(const u32x2*)((const unsigned char*)P.pbase[s] + rr + 32 * d0 + 16 * p + 8 * hi);
                    auto q2 = __builtin_amdgcn_permlane32_swap(w.x, w.y, false, false);
#pragma unroll
                    for (int e = 0; e < 4; ++e) { o[d0][8 * p + e] += f * (float)(int)(signed char)((q2[0] >> (8 * e)) & 255u); o[d0][8 * p + 4 + e] += f * (float)(int)(signed char)((q2[1] >> (8 * e)) & 255u); } } }
#pragma unroll
            for (int p = 0; p < 2; ++p) {
                const unsigned ax = cvt_pk_bf16(o[d0][8 * p + 0], o[d0][8 * p + 1]), ay = cvt_pk_bf16(o[d0][8 * p + 2], o[d0][8 * p + 3]);
                const unsigned bx_ = cvt_pk_bf16(o[d0][8 * p + 4], o[d0][8 * p + 5]), by = cvt_pk_bf16(o[d0][8 * p + 6], o[d0][8 * p + 7]);
                auto r0 = __builtin_amdgcn_permlane32_swap(ax, bx_, false, false); auto r1 = __builtin_amdgcn_permlane32_swap(ay, by, false, false);
                const u32x4 w = {r0[0], r1[0], r0[1], r1[1]};
                if (ok) *(u32x4*)(dstb + rr + 32 * d0 + 16 * p + 8 * hi) = w;
            }
        }
    } else {
        float mx = 0.f;
#pragma unroll
        for (int d0 = 0; d0 < 4; ++d0)
#pragma unroll
            for (int r = 0; r < 16; ++r) { o[d0][r] *= sc; mx = fmaxf(mx, fabsf(o[d0][r])); }
        { auto rx = __builtin_amdgcn_permlane32_swap(__float_as_uint(mx), __float_as_uint(mx), false, false); mx = fmaxf(__uint_as_float(rx[0]), __uint_as_float(rx[1])); }
        const float qs = mx > 0.f ? 127.f / mx : 0.f;
        if (ok && hi == 0) scb[li] = mx * (1.f / 127.f);
#pragma unroll
        for (int d0 = 0; d0 < 4; ++d0)
#pragma unroll
            for (int p = 0; p < 2; ++p) {
                const unsigned a = pk_i8x4(o[d0][8 * p + 0] * qs, o[d0][8 * p + 1] * qs, o[d0][8 * p + 2] * qs, o[d0][8 * p + 3] * qs);
                const unsigned b = pk_i8x4(o[d0][8 * p + 4] * qs, o[d0][8 * p + 5] * qs, o[d0][8 * p + 6] * qs, o[d0][8 * p + 7] * qs);
                auto q2 = __builtin_amdgcn_permlane32_swap(a, b, false, false);
                const u32x2 w = {q2[0], q2[1]};
                if (ok) *(u32x2*)((unsigned char*)dstb + rr + 32 * d0 + 16 * p + 8 * hi) = w;
            }
    }
}
struct UD { const bf16* Q; const bf16* K; const bf16* V; int qoff, qpos, kp0, kst, t_lo, t_hi, w_lo, w_hi, W; float sl2; int ro, li, nparts; };
struct ND { const bf16* Q; const bf16* K; const bf16* V; int qoff, kp0, kst, t_lo; };
struct PF { bf16x8 qr[8]; bf16x8 k0, k1, v0, v1; };
__device__ __forceinline__ void attn_prefetch(const ND& d, PF& pf) {
    const int hi = lane_fresh() >> 5;
#pragma unroll
    for (int d0 = 0; d0 < 8; ++d0) pf.qr[d0] = *(const bf16x8*)(d.Q + d.qoff + d0 * 16 + hi * 8);
}
__device__ __forceinline__ void attn_prime(LAS char* lds, const ND& d, PF& pf) {
    const int tid = __builtin_amdgcn_readfirstlane((int)threadIdx.x >> 6) * 64 + lane_fresh(), sr = tid >> 4, sc = (tid & 15) * 8;
    const int p0_ = (d.kp0 + (64 * d.t_lo + sr) * d.kst) * WQ + sc, p1_ = p0_ + 32 * d.kst * WQ, p2_ = p0_ + 64 * d.kst * WQ, p3_ = p0_ + 96 * d.kst * WQ;
    const bf16x8 k0 = *(const bf16x8*)(d.K + p0_), k1 = *(const bf16x8*)(d.K + p1_), v0 = *(const bf16x8*)(d.V + p0_), v1 = *(const bf16x8*)(d.V + p1_);

    pf.k0 = *(const bf16x8*)(d.K + p2_); pf.k1 = *(const bf16x8*)(d.K + p3_); pf.v0 = *(const bf16x8*)(d.V + p2_); pf.v1 = *(const bf16x8*)(d.V + p3_);
    __syncthreads();
    *(LAS bf16x8*)(lds + L_K + KSWZ(sr, sc * 2)) = k0; *(LAS bf16x8*)(lds + L_K + KSWZ(sr, sc * 2) + 32 * 256) = k1;
    *(LAS bf16x8*)(lds + L_V + v_st(sr, sc)) = v0; *(LAS bf16x8*)(lds + L_V + v_st(32 + sr, sc)) = v1;
    __syncthreads();
}
template <int NMERGE, int MASKMODE>
__device__ __forceinline__ void attn_unit(LAS char* lds, const UD& d, bf16* dstb, float* lseb, float* scb, const Parts& P, PF& pf, bool has_next, const ND& nd) {
    const int lane = lane_fresh(), wid = __builtin_amdgcn_readfirstlane((int)threadIdx.x >> 6), tid = wid * 64 + lane, r32 = lane & 31, hi = lane >> 5;
    LAS char* V_lds = lds + L_V; LAS char* K_lds = lds + L_K;
    LAS float* tab = (LAS float*)(lds + L_TAB + wid * 1024);
    LAS float* al_l = tab; LAS float* li_l = tab + 32; LAS float* fac = tab + 96;
    const bf16* Kh = d.K; const bf16* Vh = d.V;
    const int kp0 = d.kp0, kst = d.kst, t_lo = d.t_lo, t_hi = d.t_hi, w_lo = d.w_lo, w_hi = d.w_hi, W = d.W, qpos = d.qpos, li = d.li, nparts = d.nparts;
    const float sl2 = d.sl2; const long ro = (long)d.ro;
    bf16x8 (&qr)[8] = pf.qr;
    float m_reg = -1e30f, l_reg = 0.f; f32x16 o[4] = {};
    const float qposf = (float)qpos, kstf = (float)kst;
    const float bk = sl2 * kstf, bkc = bk * (1.f / SM_C2), Wf = (float)W;
    const int qlo = __builtin_amdgcn_readfirstlane(qpos), qhi = qlo + 31 * kst;
    const int sr = tid >> 4, sc = (tid & 15) * 8, vst0 = v_st(sr, sc), vst1 = v_st(32 + sr, sc), kws = KSWZ(sr, sc * 2);
    const int vb0 = (int)(uintptr_t)V_lds + v_rd_base(lane);
    bf16x8 s0_k0, s0_k1, s0_v0, s0_v1;
    bf16x8 &s1_k0 = pf.k0, &s1_k1 = pf.k1, &s1_v0 = pf.v0, &s1_v1 = pf.v1;
#define A_LOAD2(SET, tt) do { const bool own_ = (tt) < t_hi; const bf16* Kp_ = own_ ? Kh : nd.K; const bf16* Vp_ = own_ ? Vh : nd.V; \
        const int kp_ = own_ ? kp0 : nd.kp0, ks_ = own_ ? kst : nd.kst, ti_ = own_ ? (tt) : (tt) - t_hi + nd.t_lo; \
        const int p0_ = (kp_ + (64 * ti_ + sr) * ks_) * WQ + sc, p1_ = p0_ + 32 * ks_ * WQ; \
        s##SET##_k0 = *(const bf16x8*)(Kp_ + p0_); s##SET##_k1 = *(const bf16x8*)(Kp_ + p1_); s##SET##_v0 = *(const bf16x8*)(Vp_ + p0_); s##SET##_v1 = *(const bf16x8*)(Vp_ + p1_); } while (0)
#define A_WRITE2(SET) do { *(LAS bf16x8*)(K_lds + (SET) * SHM_K + kws) = s##SET##_k0; *(LAS bf16x8*)(K_lds + (SET) * SHM_K + kws + 32 * 256) = s##SET##_k1; \
        *(LAS bf16x8*)(V_lds + (SET) * SHM_V + vst0) = s##SET##_v0; *(LAS bf16x8*)(V_lds + (SET) * SHM_V + vst1) = s##SET##_v1; } while (0)
#define A_STEP(KB, t) do { \
        if (KB == 0) A_LOAD2(0, (t) + 2); else A_LOAD2(1, (t) + 2);     \
        if ((t) >= w_lo && (t) <= w_hi) { \
            float bk_ = bk, bkc_ = bkc, kst_ = kstf; asm volatile("" : "+v"(bk_), "+v"(bkc_), "+v"(kst_));     \
            f32x16 p0, p1; SBAR(); qkt<KB>(p0, p1, K_lds, r32, hi, qr, bkc_); \
              \
            const float d0f = qposf - (float)(kp0 + (64 * (t) + 4 * hi) * kst); const float t0 = -sl2 * d0f, t1 = fmaf(32.f, bk_, t0); \
            bool needm = false; \
            if (MASKMODE != 0) { const int kfirst = kp0 + 64 * (t) * kst, klast = kfirst + 63 * kst; needm = !((qlo - klast >= 0) && (MASKMODE == 1 || qhi - kfirst <= W)); } \
            float pmax = -__builtin_inff(); \
            if (needm) { \
                _Pragma("unroll") for (int r = 0; r < 16; ++r) { const float c_ = (float)((r & 3) + 8 * (r >> 2)); \
                    const float a0 = fmaf(-c_, kst_, d0f), a1 = a0 - 32.f * kst_;        \
                    float z0 = fmaf(p0[r], SM_C2, t0), z1 = fmaf(p1[r], SM_C2, t1); \
                    const bool v0_ = (MASKMODE == 1) ? (a0 >= 0.f) : (__builtin_amdgcn_fmed3f(a0, 0.f, Wf) == a0), v1_ = (MASKMODE == 1) ? (a1 >= 0.f) : (__builtin_amdgcn_fmed3f(a1, 0.f, Wf) == a1); \
                    z0 = v0_ ? z0 : -__builtin_inff(); z1 = v1_ ? z1 : -__builtin_inff(); \
                    p0[r] = z0; p1[r] = z1; pmax = fmaxf(pmax, fmaxf(z0, z1)); } \
            } else { \
                _Pragma("unroll") for (int r = 0; r < 16; ++r) { const float z0 = fmaf(p0[r], SM_C2, t0), z1 = fmaf(p1[r], SM_C2, t1); p0[r] = z0; p1[r] = z1; pmax = fmaxf(pmax, fmaxf(z0, z1)); } \
            } \
            { auto rr = __builtin_amdgcn_permlane32_swap(__float_as_uint(pmax), __float_as_uint(pmax), false, false); pmax = fmaxf(__uint_as_float(rr[0]), __uint_as_float(rr[1])); } \
            float mn, alpha; \
            if (__all(pmax - m_reg <= 11.5f)) { mn = m_reg; alpha = 1.f; } \
            else { mn = fmaxf(m_reg, pmax); alpha = __builtin_amdgcn_exp2f(m_reg - mn); m_reg = mn; } \
            float ps = 0.f; \
            _Pragma("unroll") for (int r = 0; r < 16; ++r) { p0[r] = __builtin_amdgcn_exp2f(p0[r] - mn); p1[r] = __builtin_amdgcn_exp2f(p1[r] - mn); ps += p0[r] + p1[r]; } \
            { auto rr = __builtin_amdgcn_permlane32_swap(__float_as_uint(ps), __float_as_uint(ps), false, false); ps = __uint_as_float(rr[0]) + __uint_as_float(rr[1]); } \
            l_reg = l_reg * alpha + ps; \
            bf16x8 pa0, pa1, pa2, pa3; \
            A_PK4(p0, 0, pa0); A_PK4(p0, 8, pa1); A_PK4(p1, 0, pa2); A_PK4(p1, 8, pa3); \
            if (__any(alpha < 1.f)) { _Pragma("unroll") for (int d_ = 0; d_ < 4; ++d_) _Pragma("unroll") for (int r = 0; r < 16; ++r) o[d_][r] *= alpha; }     \
            SBAR(); pv_tile<KB>(o, vb0, pa0, pa1, pa2, pa3); \
        } \
        if (KB == 0) A_WRITE2(1); else A_WRITE2(0); \
        __syncthreads(); } while (0)
#define A_PK4(Pv, B_, OUT) do { unsigned a0 = cvt_pk_bf16(Pv[B_ + 0], Pv[B_ + 1]), a1 = cvt_pk_bf16(Pv[B_ + 2], Pv[B_ + 3]); \
        unsigned b0 = cvt_pk_bf16(Pv[B_ + 4], Pv[B_ + 5]), b1 = cvt_pk_bf16(Pv[B_ + 6], Pv[B_ + 7]); \
        auto r0 = __builtin_amdgcn_permlane32_swap(a0, b0, false, false); auto r1 = __builtin_amdgcn_permlane32_swap(a1, b1, false, false); \
        u32x4 w_ = {r0[0], r1[0], r0[1], r1[1]}; OUT = __builtin_bit_cast(bf16x8, w_); } while (0)
    for (int t = t_lo; t < t_hi; t += 2) {
        A_STEP(0, t);
        if (t + 1 < t_hi) A_STEP(1, t + 1);
    }
#undef A_STEP
#undef A_PK4
#undef A_LOAD2
#undef A_WRITE2
    if (has_next) attn_prefetch(nd, pf);
    row_epilogue<NMERGE>(o, m_reg, l_reg, hi, dstb, ro, lseb, scb, li, nparts, P);
}

__device__ __forceinline__ void attn_sel_chunks(LAS char* lds, int c0, int c1, const LAS int* pfx, const unsigned* cnts  , const unsigned* buck,
                                                const bf16* QM, const bf16* KM, const bf16* VM, bf16* PM, float* LM, float* SM) {
    const int lane = lane_fresh(), wid = __builtin_amdgcn_readfirstlane((int)threadIdx.x >> 6), tid = wid * 64 + lane, r32 = lane & 31, hi = lane >> 5;
    LAS char* V_lds = lds; LAS char* K_lds = lds + 65536;
    LAS float* tab = (LAS float*)(lds + L_TAB + wid * 1024);
    LAS float* al_l = tab; LAS float* fc_l = tab + 32; LAS int* ro_l = (LAS int*)(tab + 64);
    const int sr = tid >> 4, sc = (tid & 15) * 8, vst0 = v_st(sr, sc), vst1 = v_st(32 + sr, sc), kws = KSWZ(sr, sc * 2);
    const int vb0 = (int)(uintptr_t)V_lds + v_rd_base(lane);
    if (c0 >= c1) return;
    int bk = 0; { int klo = 0, khi = 1024; while (khi - klo > 1) { const int mid = (klo + khi) >> 1; if (pfx[mid] <= c0) klo = mid; else khi = mid; } bk = klo; }
    int cur_bk = -1;
#define S_QUERY(ch_, BK, E, QP, VALID, QF) do { int bk_ = (BK); while (pfx[bk_ + 1] <= (ch_)) ++bk_; (BK) = bk_; \
        const int chunk_ = (ch_) - pfx[bk_], bh_ = bk_ >> 5, j_ = bk_ & 31; \
        const int cnt_ = (int)__hip_atomic_load(cnts + 64 * bk_, RLX_AGENT); const int idx_ = chunk_ * 256 + wid * 32 + r32; \
        VALID = idx_ < cnt_; E = 0; if (VALID) E = buck[(size_t)bh_ * BUCK_PER_BH + buck_off(j_) + idx_]; \
        QP = VALID ? (int)(E & 0xffffu) : (j_ + 1) * 256; \
        const bf16* qrow_ = QM + ((bh_ >> 3) * SEQ) * WQ + (bh_ & 7) * HD + QP * WQ; \
        _Pragma("unroll") for (int d0 = 0; d0 < 8; ++d0) QF[d0] = *(const bf16x8*)(qrow_ + d0 * 16 + hi * 8); } while (0)
    bf16x8 qr[8], qn[8]; unsigned e = 0, en = 0; int qpos = 0, qposn = 0, bkn = bk; bool valid = false, validn = false;
    S_QUERY(c0, bkn, en, qposn, validn, qn);
#pragma unroll 1
    for (int ch = c0; ch < c1; ++ch) {
        while (pfx[bk + 1] <= ch) ++bk;
        const int bh = bk >> 5, j = bk & 31, b = bh >> 3, h = bh & 7;
        const int hb = (b * SEQ) * WQ + h * HD;
        e = en; qpos = qposn; valid = validn;
#pragma unroll
        for (int d0 = 0; d0 < 8; ++d0) qr[d0] = qn[d0];
        if (ch + 1 < c1) S_QUERY(ch + 1, bkn, en, qposn, validn, qn);
        if (bk != cur_bk) {
            cur_bk = bk;
            __syncthreads();
#pragma unroll
            for (int half = 0; half < 2; ++half) {
                bf16x8 k0[2], k1[2], v0[2], v1[2];
#pragma unroll
                for (int tt = 0; tt < 2; ++tt) { const int p0_ = hb + (j * 256 + 64 * (2 * half + tt) + sr) * WQ + sc, p1_ = p0_ + 32 * WQ;
                    k0[tt] = *(const bf16x8*)(KM + p0_); k1[tt] = *(const bf16x8*)(KM + p1_); v0[tt] = *(const bf16x8*)(VM + p0_); v1[tt] = *(const bf16x8*)(VM + p1_); }
#pragma unroll
                for (int tt = 0; tt < 2; ++tt) { const int T = 2 * half + tt;
                    *(LAS bf16x8*)(K_lds + T * SHM_K + kws) = k0[tt]; *(LAS bf16x8*)(K_lds + T * SHM_K + kws + 32 * 256) = k1[tt];
                    *(LAS bf16x8*)(V_lds + T * SHM_V + vst0) = v0[tt]; *(LAS bf16x8*)(V_lds + T * SHM_V + vst1) = v1[tt]; }
            }
            __syncthreads();
        }
        if (!__any(valid)) continue;
        const int slot = (int)(e >> 16);
        const float sl2 = __builtin_amdgcn_exp2f(-0.5f * (float)(2 * h + 1)) * LOG2E;
        const float bkc = sl2 * (1.f / SM_C2), qposf = (float)qpos;
        float m_reg = -1e30f, l_reg = 0.f; f32x16 o[4] = {};
#define S_TILE(KB) do { \
            float bkc_ = bkc; asm volatile("" : "+v"(bkc_)); \
            f32x16 p0, p1; SBAR(); qkt<KB>(p0, p1, K_lds, r32, hi, qr, bkc_); \
            const float t0 = -sl2 * (qposf - (float)(j * 256 + 64 * (KB) + 4 * hi)), t1 = fmaf(32.f, sl2, t0); \
            float pmax = -__builtin_inff(); \
            _Pragma("unroll") for (int r = 0; r < 16; ++r) { const float z0 = fmaf(p0[r], SM_C2, t0), z1 = fmaf(p1[r], SM_C2, t1); p0[r] = z0; p1[r] = z1; pmax = fmaxf(pmax, fmaxf(z0, z1)); } \
            { auto rr = __builtin_amdgcn_permlane32_swap(__float_as_uint(pmax), __float_as_uint(pmax), false, false); pmax = fmaxf(__uint_as_float(rr[0]), __uint_as_float(rr[1])); } \
            float mn, alpha; \
            if (__all(pmax - m_reg <= 11.5f)) { mn = m_reg; alpha = 1.f; } \
            else { mn = fmaxf(m_reg, pmax); alpha = __builtin_amdgcn_exp2f(m_reg - mn); m_reg = mn; } \
            float ps = 0.f; \
            _Pragma("unroll") for (int r = 0; r < 16; ++r) { p0[r] = __builtin_amdgcn_exp2f(p0[r] - mn); p1[r] = __builtin_amdgcn_exp2f(p1[r] - mn); ps += p0[r] + p1[r]; } \
            { auto rr = __builtin_amdgcn_permlane32_swap(__float_as_uint(ps), __float_as_uint(ps), false, false); ps = __uint_as_float(rr[0]) + __uint_as_float(rr[1]); } \
            l_reg = l_reg * alpha + ps; \
            bf16x8 pa0, pa1, pa2, pa3; \
            S_PK4(p0, 0, pa0); S_PK4(p0, 8, pa1); S_PK4(p1, 0, pa2); S_PK4(p1, 8, pa3); \
            if (__any(alpha < 1.f)) { _Pragma("unroll") for (int d_ = 0; d_ < 4; ++d_) _Pragma("unroll") for (int r = 0; r < 16; ++r) o[d_][r] *= alpha; } \
            SBAR(); pv_tile<KB>(o, vb0, pa0, pa1, pa2, pa3); } while (0)
#define S_PK4(Pv, B_, OUT) do { unsigned a0 = cvt_pk_bf16(Pv[B_ + 0], Pv[B_ + 1]), a1 = cvt_pk_bf16(Pv[B_ + 2], Pv[B_ + 3]); \
        unsigned b0 = cvt_pk_bf16(Pv[B_ + 4], Pv[B_ + 5]), b1 = cvt_pk_bf16(Pv[B_ + 6], Pv[B_ + 7]); \
        auto r0 = __builtin_amdgcn_permlane32_swap(a0, b0, false, false); auto r1 = __builtin_amdgcn_permlane32_swap(a1, b1, false, false); \
        u32x4 w_ = {r0[0], r1[0], r0[1], r1[1]}; OUT = __builtin_bit_cast(bf16x8, w_); } while (0)
        S_TILE(0); S_TILE(1); S_TILE(2); S_TILE(3);
#undef S_TILE
#undef S_PK4
        { const Parts nop{};
          row_epilogue<0>(o, m_reg, l_reg, hi, PM, valid ? (long)(slot * (NTOK * WQ) + hb + qpos * WQ) : -1L, LM, SM, slot * (NTOK * 8) + (b * SEQ + qpos) * 8 + h, 0, nop); }
    }
#undef S_QUERY
}
#undef SBAR
}

struct Args { const float* in[16]; float* out; unsigned char* ws; int ph_lo, ph_hi, dry, pad; };

__device__ __forceinline__ void transpose_item(const float* W, int N, int k0, int n0, bf16* WT, int ldk, long orow0, LAS float* scr, int lane) {
#pragma unroll 8
    for (int i = 0; i < 32; ++i) { const int kk = 2 * i + (lane >> 5); scr[kk * 33 + (lane & 31)] = W[(size_t)(k0 + kk) * N + n0 + (lane & 31)]; }
    LDS_WAIT(); asm volatile("" ::: "memory");
    const int c = lane & 7;
#pragma unroll
    for (int j = 0; j < 4; ++j) { const int n = (lane >> 3) + 8 * j; const LAS float* s = scr + (8 * c) * 33 + n;
        u32x4 o; o.x = cvt_pk_bf16(s[0 * 33], s[1 * 33]); o.y = cvt_pk_bf16(s[2 * 33], s[3 * 33]); o.z = cvt_pk_bf16(s[4 * 33], s[5 * 33]); o.w = cvt_pk_bf16(s[6 * 33], s[7 * 33]);
        *(u32x4*)(WT + (size_t)(orow0 + n) * ldk + k0 + 8 * c) = o; }
    LDS_WAIT(); asm volatile("" ::: "memory");
}

__device__ __forceinline__ void transpose_item_i8(const float* W, int N, int k0, int n0, unsigned char* WT, int ldk, long orow0, float cscale, LAS float* scr, int lane) {
#pragma unroll 8
    for (int i = 0; i < 32; ++i) { const int kk = 2 * i + (lane >> 5); scr[kk * 33 + (lane & 31)] = W[(size_t)(k0 + kk) * N + n0 + (lane & 31)] * cscale; }
    LDS_WAIT(); asm volatile("" ::: "memory");
    const int c = lane & 7;
#pragma unroll
    for (int j = 0; j < 4; ++j) { const int n = (lane >> 3) + 8 * j; const LAS float* s = scr + (8 * c) * 33 + n;
        u32x2 o; o.x = pk_i8x4(s[0 * 33], s[1 * 33], s[2 * 33], s[3 * 33]); o.y = pk_i8x4(s[4 * 33], s[5 * 33], s[6 * 33], s[7 * 33]);
        *(u32x2*)(WT + (size_t)(orow0 + n) * ldk + k0 + 8 * c) = o; }
    LDS_WAIT(); asm volatile("" ::: "memory");
}
__device__ __forceinline__ void transpose_regs_i8(const float (&v)[32], int k0, unsigned char* WT, int ldk, long orow0, float cscale, LAS float* scr, int lane) {
#pragma unroll
    for (int i = 0; i < 32; ++i) scr[(2 * i + (lane >> 5)) * 33 + (lane & 31)] = v[i] * cscale;
    LDS_WAIT(); asm volatile("" ::: "memory");
    const int c = lane & 7;
#pragma unroll
    for (int j = 0; j < 4; ++j) { const int n = (lane >> 3) + 8 * j; const LAS float* s = scr + (8 * c) * 33 + n;
        u32x2 o; o.x = pk_i8x4(s[0 * 33], s[1 * 33], s[2 * 33], s[3 * 33]); o.y = pk_i8x4(s[4 * 33], s[5 * 33], s[6 * 33], s[7 * 33]);
        *(u32x2*)(WT + (size_t)(orow0 + n) * ldk + k0 + 8 * c) = o; }
    LDS_WAIT(); asm volatile("" ::: "memory");
}
__device__ __forceinline__ void transpose_item_fp8(const float* W, int N, int k0, int n0, unsigned char* WT, int ldk, long orow0, float scale, LAS float* scr, int lane) {
#pragma unroll 8
    for (int i = 0; i < 32; ++i) { const int kk = 2 * i + (lane >> 5); scr[kk * 33 + (lane & 31)] = W[(size_t)(k0 + kk) * N + n0 + (lane & 31)] * scale; }
    LDS_WAIT(); asm volatile("" ::: "memory");
    const int c = lane & 7;
#pragma unroll
    for (int j = 0; j < 4; ++j) { const int n = (lane >> 3) + 8 * j; const LAS float* s = scr + (8 * c) * 33 + n;
        u32x2 o; o.x = pk_fp8x4(s[0 * 33], s[1 * 33], s[2 * 33], s[3 * 33]); o.y = pk_fp8x4(s[4 * 33], s[5 * 33], s[6 * 33], s[7 * 33]);
        *(u32x2*)(WT + (size_t)(orow0 + n) * ldk + k0 + 8 * c) = o; }
    LDS_WAIT(); asm volatile("" ::: "memory");
}

__global__ void __launch_bounds__(NWAVES * 64, 2) mk_fwd(Args args) {
    extern __shared__ __attribute__((aligned(16))) unsigned char lds_raw[];
    LAS unsigned char* lds = (LAS unsigned char*)lds_raw;
    volatile LAS unsigned* MISC = (volatile LAS unsigned*)(lds + MISC_OFF);
    const int wave = __builtin_amdgcn_readfirstlane((int)threadIdx.x >> 6);
#define PHASE_IDS const int lane = lane_fresh(), tid = wave * 64 + lane; (void)tid; (void)lane
    PHASE_IDS;
    const int G = gridDim.x, bx = blockIdx.x;
    const int vcu = (G % 8 == 0) ? (bx % 8) * (G / 8) + bx / 8 : bx;
    unsigned char* ws = args.ws;
    gu32* ctl = (gu32*)(ws + WS_CTL);
    for (int u = tid; u < (LDS_BYTES - RING_BYTES) / 4; u += NWAVES * 64) ((LAS unsigned*)(lds + RING_BYTES))[u] = 0u;
    __syncthreads();
    XcdBarrier bar; bar.bar = (unsigned*)ctl + CW_BAR; bar.x = 0; bar.st = nullptr;
    if (MK_N_LAUNCHES == 1 && !MK_DEBUG) bar = xcd_barrier_post((unsigned*)ctl + CW_BAR, MISC + 8);
    const int lo = args.ph_lo, hi_ph = args.ph_hi;
#define IN(k) (lo <= (k) && (k) < hi_ph)
#define SEAM(k) do { if (IN(k) && IN((k) + 1)) xcd_barrier(bar); } while (0)
    const int gw = vcu * NWAVES + wave, NGW = G * NWAVES;

    const float* x = args.in[0];
    bf16* Hb = (bf16*)(ws + WS_H);
    bf16* QM = (bf16*)(ws + WS_QM); bf16* KM = (bf16*)(ws + WS_KM); bf16* VM = (bf16*)(ws + WS_VM);
    bf16* QD = (bf16*)(ws + WS_QD); bf16* KD = (bf16*)(ws + WS_KD); bf16* VD = (bf16*)(ws + WS_VD);
    bf16* PM = (bf16*)(ws + WS_PM); bf16* PD = (bf16*)(ws + WS_PD);
    float* LM = (float*)(ws + WS_LM); float* LD = (float*)(ws + WS_LD); float* SM = (float*)(ws + WS_SM); float* SD = (float*)(ws + WS_SD);
    float* kmean = (float*)(ws + WS_KMEAN);
    unsigned* buck = (unsigned*)(ws + WS_BUCK);
    bf16* GATES = (bf16*)(ws + WS_GATES); bf16* MIX = (bf16*)(ws + WS_MIX); bf16* GINV = (bf16*)(ws + WS_GINV);
    float* X1 = (float*)(ws + WS_X1);
    int* EID = (int*)(ws + WS_EID); float* EW = (float*)(ws + WS_EW); float* RMS = (float*)(ws + WS_RMS); int* POS = (int*)(ws + WS_POS);
    int* ROWTOK = (int*)(ws + WS_ROWTOK); float* ROWW = (float*)(ws + WS_ROWW);
    bf16* WR = (bf16*)(ws + WS_WR);

    if (IN(0)) {
        PHASE_IDS;
        LAS float* scr = (LAS float*)(lds + wave * 16384);
        constexpr int I_IN = 32 * 320, I_OM = 16 * 64, I_O = 32 * 64;
        constexpr int NIT = I_IN + 2 * I_OM; (void)I_O;
        for (int it = gw; it < NIT; it += NGW) {
            int r = it;
            if (r < I_IN) { const int kb = r / 320, nb = r % 320;
                if (32 * nb < NBF) transpose_item(args.in[2], 10240, 64 * kb, 32 * nb, (bf16*)(ws + WS_WIN), 2048, 32 * nb, scr, lane);
                continue; } r -= I_IN;
            if (r < I_OM) { const int kb = r / 64, nb = r % 64; transpose_item(args.in[4], 2048, 64 * kb, 32 * nb, (bf16*)(ws + WS_WOM), 2048, 32 * nb, scr, lane); continue; } r -= I_OM;
            if (r < I_OM) { const int kb = r / 64, nb = r % 64; transpose_item(args.in[5], 2048, 64 * kb, 32 * nb, (bf16*)(ws + WS_WOM) + 1024, 2048, 32 * nb, scr, lane); continue; } r -= I_OM;
            (void)r;
        }
        {
            LAS float* cmax = (LAS float*)(lds + 136 * 1024);
            float* colsc = (float*)(ws + WS_CS8);
            constexpr int NG_IN = (10240 - NBF) / 32, NG_WO = 2048 / 32;
            for (int grp = vcu; grp < NG_IN + NG_WO; grp += G) {
                const bool is_wo = grp >= NG_IN;
                const int lane = lane_fresh();
                const float* Wsrc = is_wo ? args.in[6] : args.in[2]; const int Nsrc = is_wo ? 2048 : 10240;
                const int n0 = is_wo ? 32 * (grp - NG_IN) : NBF + 32 * grp;
                float mx = 0.f;
                float vv[4][32];
#pragma unroll
                for (int q4 = 0; q4 < 4; ++q4) { const int kb = wave * 4 + q4;
#pragma unroll
                    for (int i = 0; i < 32; ++i) vv[q4][i] = Wsrc[(size_t)(64 * kb + 2 * i + (lane >> 5)) * Nsrc + n0 + (lane & 31)]; }
#pragma unroll
                for (int q4 = 0; q4 < 4; ++q4)
#pragma unroll
                    for (int i = 0; i < 32; ++i) mx = fmaxf(mx, fabsf(vv[q4][i]));
                mx = fmaxf(mx, __shfl_xor(mx, 32));
                __syncthreads();
                if (lane < 32) cmax[wave * 32 + lane] = mx;
                __syncthreads();
                float cm = 0.f;
#pragma unroll
                for (int w8 = 0; w8 < 8; ++w8) cm = fmaxf(cm, cmax[w8 * 32 + (lane & 31)]);
                int drow = is_wo ? n0 : n0 - NBF;
                if (!is_wo && n0 >= NQKV) { const int c = n0 - NQKV, which = c >> 11, cc = c & 2047; drow = (NQKV - NBF) + (cc >> 7) * 256 + which * 128 + (cc & 127); }
                if (wave == 0 && lane < 32) (is_wo ? (float*)(ws + WS_CSWO) : colsc)[drow + lane] = cm * (1.f / 127.f);
                const float cscale = cm > 0.f ? 127.f / cm : 0.f;
#pragma unroll
                for (int q4 = 0; q4 < 4; ++q4) transpose_regs_i8(vv[q4], 64 * (wave * 4 + q4), is_wo ? ws + WS_WO : ws + WS_WIN8, 2048, drow, cscale, scr, lane);
            }
        }
        for (int i = (bx * NWAVES * 64 + tid); i < 64 * 2048; i += G * NWAVES * 64) {
            const int row = i >> 11, k = i & 2047;
            float w = 0.f;
            if (row < 32) w = args.in[10][(size_t)k * 32 + row]; else if (row < 40) w = args.in[8][(size_t)k * 4 + ((row - 32) & 3)];
            const unsigned h = cvt_pk_bf16(w, 0.f) & 0xffffu; const float lo_f = w - bf_lo(h); const unsigned l = cvt_pk_bf16(lo_f, 0.f) & 0xffffu;
            const bool glo = row >= 36 && row < 40;
            WR[i] = (bf16)(glo ? l : h); WR[64 * 2048 + i] = (bf16)(glo ? 0u : l);
        }
        const float* g1 = args.in[1];
        for (int m = gw; m < NTOK; m += NGW) {
            const float* xr = x + (size_t)m * DM;
            f32x4 v[8]; float s = 0.f;
#pragma unroll
            for (int j = 0; j < 4; ++j) { v[2 * j] = *(const f32x4*)(xr + j * 512 + lane * 8); v[2 * j + 1] = *(const f32x4*)(xr + j * 512 + lane * 8 + 4); }
#pragma unroll
            for (int j = 0; j < 8; ++j) s += (v[j].x * v[j].x + v[j].y * v[j].y) + (v[j].z * v[j].z + v[j].w * v[j].w);
            const float rs = 1.0f / sqrtf(wave_sum(s) * (1.f / DM) + RMS_EPS);
            float amax = 0.f;
#pragma unroll
            for (int j = 0; j < 4; ++j) { const f32x4 ga = *(const f32x4*)(g1 + j * 512 + lane * 8), gb = *(const f32x4*)(g1 + j * 512 + lane * 8 + 4);
                v[2 * j] = v[2 * j] * rs * ga; v[2 * j + 1] = v[2 * j + 1] * rs * gb;
                if (NBF > 0) *(u32x4*)(Hb + (size_t)m * DM + j * 512 + lane * 8) = pg8::pack8(v[2 * j], v[2 * j + 1]);
#pragma unroll
                for (int e = 0; e < 4; ++e) amax = fmaxf(amax, fmaxf(fabsf(v[2 * j][e]), fabsf(v[2 * j + 1][e]))); }
#pragma unroll
            for (int o = 1; o < 64; o <<= 1) amax = fmaxf(amax, __shfl_xor(amax, o));
            const float qs = amax > 0.f ? 127.f / amax : 0.f;
            if (lane == 0) ((float*)(ws + WS_RS8))[m] = amax * (1.f / 127.f);
#pragma unroll
            for (int j = 0; j < 4; ++j) { const f32x4 ha = v[2 * j] * qs, hb4 = v[2 * j + 1] * qs;
                u32x2 h8; h8.x = pk_i8x4(ha.x, ha.y, ha.z, ha.w); h8.y = pk_i8x4(hb4.x, hb4.y, hb4.z, hb4.w);
                *(u32x2*)(ws + WS_H8 + (size_t)m * DM + j * 512 + lane * 8) = h8; }
        }
    }
    if (IN(0) && IN(1)) xcd_barrier(bar);

    if (IN(1)) {
        { pg8::Gemm g{Hb, (const bf16*)(ws + WS_WIN), DM, nullptr, DM, Hb, 1 << 30}; pg8::StaticOrder S; S.init(NTOK, NBF, G, bx);
          pg8::EpiQKV E{QM, 0, nullptr, nullptr, nullptr};
          pg8::gemm_phase<pg8::EpiQKV, pg8::StaticOrder, true>(lds, g, S, E); }
        { pg8::Gemm g{(const bf16*)(ws + WS_H8), (const bf16*)(ws + WS_WIN8), DM / 2, nullptr, DM / 2, (const bf16*)(ws + WS_H8), 1 << 30}; pg8::StaticOrder S; S.init(NTOK, NQKV - NBF, G, bx);
          pg8::EpiQKV E{QM, NBF / 256, (const float*)(ws + WS_RS8), (const float*)(ws + WS_CS8), kmean};
          pg8::gemm_phase<pg8::EpiQKV, pg8::StaticOrder, true, false, QIN>(lds, g, S, E); }
    }
    if (IN(1) && IN(3)) xcd_barrier(bar);


    if (IN(3)) {
        PHASE_IDS;
        LAS int* hist = (LAS int*)lds;
        const int r32 = lane & 31, hi = lane >> 5;
        for (int u = bx; u < NB * NH * 32; u += G) {
            const int b = u >> 8, h = (u >> 5) & 7, qb = u & 31;
            if (qb == 0) continue;
            __syncthreads();
            if (tid < 64) hist[tid] = 0;
            __syncthreads();
            const int tq = qb * 256 + wave * 32 + r32;
            const bf16* qrow = QM + (size_t)(b * SEQ + tq) * WQ + h * HD;
            const float* km = kmean + (size_t)((b * NH + h) * 32 + r32) * HD;
            f32x16 acc = {};
#pragma unroll
            for (int s = 0; s < 8; ++s) {
                const bf16x8 qf = *(const bf16x8*)(qrow + s * 16 + hi * 8);
                const f32x4 ka = *(const f32x4*)(km + s * 16 + hi * 8), kb2 = *(const f32x4*)(km + s * 16 + hi * 8 + 4);
                const u32x4 kh = pg8::pack8(ka, kb2);
                f32x4 ha, hb; pg8::unpack8(kh, ha, hb);
                const u32x4 kl = pg8::pack8(ka - ha, kb2 - hb);
                acc = __builtin_amdgcn_mfma_f32_32x32x16_bf16(__builtin_bit_cast(bf16x8, kh), qf, acc, 0, 0, 0);
                acc = __builtin_amdgcn_mfma_f32_32x32x16_bf16(__builtin_bit_cast(bf16x8, kl), qf, acc, 0, 0, 0);
            }
            float t0 = -__builtin_inff(), t1 = t0, t2 = t0; int i0 = 64, i1 = 64, i2 = 64;
#define INS3(v_, j_) do { const float _iv = (v_); const int _ij = (j_); \
                if (_iv > t0 || (_iv == t0 && _ij < i0)) { t2 = t1; i2 = i1; t1 = t0; i1 = i0; t0 = _iv; i0 = _ij; } \
                else if (_iv > t1 || (_iv == t1 && _ij < i1)) { t2 = t1; i2 = i1; t1 = _iv; i1 = _ij; } \
                else if (_iv > t2 || (_iv == t2 && _ij < i2)) { t2 = _iv; i2 = _ij; } } while (0)
#pragma unroll
            for (int r = 0; r < 16; ++r) { const int j = att::crow(r, hi); const float v = (j < qb) ? acc[r] : -__builtin_inff(); INS3(v, j); }
            { const float o0 = __shfl_xor(t0, 32), o1 = __shfl_xor(t1, 32), o2 = __shfl_xor(t2, 32); const int j0 = __shfl_xor(i0, 32), j1 = __shfl_xor(i1, 32), j2 = __shfl_xor(i2, 32);
              INS3(o0, j0); INS3(o1, j1); INS3(o2, j2); }
#undef INS3
            int rk0 = 0, rk1 = 0, rk2 = 0;
            const bool v0 = t0 > -__builtin_inff() && i0 < qb, v1 = t1 > -__builtin_inff() && i1 < qb, v2 = t2 > -__builtin_inff() && i2 < qb;
            if (hi == 0) {
                if (v0) rk0 = __hip_atomic_fetch_add(&hist[i0], 1, __ATOMIC_RELAXED, __HIP_MEMORY_SCOPE_WORKGROUP);
                if (v1) rk1 = __hip_atomic_fetch_add(&hist[i1], 1, __ATOMIC_RELAXED, __HIP_MEMORY_SCOPE_WORKGROUP);
                if (v2) rk2 = __hip_atomic_fetch_add(&hist[i2], 1, __ATOMIC_RELAXED, __HIP_MEMORY_SCOPE_WORKGROUP);
            }
            __syncthreads();
            if (tid < 32 && hist[tid] > 0) hist[32 + tid] = (int)__hip_atomic_fetch_add((unsigned*)ctl + CW_BCNT + 64 * (((b * NH + h) << 5) + tid), (unsigned)hist[tid], RLX_AGENT);
            __syncthreads();
            if (hi == 0) {
                unsigned* bb = buck + (size_t)(b * NH + h) * BUCK_PER_BH;
                if (v0) bb[buck_off(i0) + hist[32 + i0] + rk0] = (unsigned)tq | (0u << 16);
                if (v1) bb[buck_off(i1) + hist[32 + i1] + rk1] = (unsigned)tq | (1u << 16);
                if (v2) bb[buck_off(i2) + hist[32 + i2] + rk2] = (unsigned)tq | (2u << 16);
            }
        }
    }
    SEAM(3);

    if (IN(4)) {
        PHASE_IDS;
        LAS int* pfx = (LAS int*)(lds + att::L_SELPFX);
        __syncthreads();
        for (int k = tid; k < 1024; k += NWAVES * 64) { const unsigned c = __hip_atomic_load((unsigned*)ctl + CW_BCNT + 64 * k, RLX_AGENT); pfx[k + 1] = (int)((c + 255u) >> 8); }
        if (tid == 0) pfx[0] = 0;
        __syncthreads();
        if (tid == 0) { int s = 0; for (int k = 1; k <= 1024; ++k) { s += pfx[k]; pfx[k] = s; } }
        __syncthreads();
        const int nsel = pfx[1024];
        constexpr int NDIL = 2 * 1024;
        const int total = nsel + NDIL;
        att::Parts noparts{};
        const int r32 = lane & 31;
#define DECODE4(u_, D) do { const int uu = (u_); \
            if (uu < NDIL) {     \
                const int p = uu >> 10, v = uu & 1023, bh = v >> 5, w5 = v & 31; \
                const int dd = p ? 4 : 1, res = p ? (w5 >> 3) : 0, l0 = p ? (w5 & 7) * 256 : w5 * 256, b = bh >> 3, h = bh & 7; \
                const int hb = (b * SEQ) * WQ + h * HD; \
                D.Q = QD + hb; D.K = KD + hb; D.V = VD + hb; D.qpos = (l0 + wave * 32 + r32) * dd + res; D.qoff = D.qpos * WQ; \
                D.kp0 = (l0 - 128) * dd + res; D.kst = dd; D.t_lo = l0 == 0 ? 2 : 0; D.t_hi = 6; D.w_lo = wave >> 1; D.w_hi = (wave >> 1) + 2; D.W = 128 * dd; \
                D.sl2 = __builtin_amdgcn_exp2f(-(float)(h + 1)) * LOG2E; \
                D.ro = p * (NTOK * WQ) + hb + D.qpos * WQ; D.li = p * (NTOK * 8) + (b * SEQ + D.qpos) * 8 + h; D.nparts = 0; \
            } else {             \
                const int su = uu - NDIL; int klo = 0, khi = 1024; \
                while (khi - klo > 1) { const int mid = (klo + khi) >> 1; if (pfx[mid] <= su) klo = mid; else khi = mid; } \
                const int bk = klo, chunk = su - pfx[bk], bh = bk >> 5, j = bk & 31, b = bh >> 3, h = bh & 7; \
                const int cnt = (int)__hip_atomic_load((unsigned*)ctl + CW_BCNT + 64 * bk, RLX_AGENT); \
                const int idx = chunk * 256 + wave * 32 + r32; const bool valid = idx < cnt; \
                unsigned e = 0; if (valid) e = buck[(size_t)bh * BUCK_PER_BH + buck_off(j) + idx]; \
                const int slot = (int)(e >> 16), hb = (b * SEQ) * WQ + h * HD; \
                D.Q = QM + hb; D.K = KM + hb; D.V = VM + hb; D.qpos = valid ? (int)(e & 0xffffu) : (j + 1) * 256; D.qoff = D.qpos * WQ; \
                D.kp0 = j * 256; D.kst = 1; D.t_lo = 0; D.t_hi = 4; D.w_lo = 0; D.w_hi = 3; D.W = 1 << 20; \
                D.sl2 = __builtin_amdgcn_exp2f(-0.5f * (float)(2 * h + 1)) * LOG2E; \
                D.ro = valid ? slot * (NTOK * WQ) + hb + D.qpos * WQ : -1; D.li = slot * (NTOK * 8) + (b * SEQ + D.qpos) * 8 + h; D.nparts = 0; \
            } } while (0)
        att::UD cur; att::ND nd; att::PF pf;
#define TO_ND(D, N) do { N.Q = D.Q; N.K = D.K; N.V = D.V; N.qoff = D.qoff; N.kp0 = D.kp0; N.kst = D.kst; N.t_lo = D.t_lo; } while (0)
        if (bx < NDIL) { DECODE4(bx, cur); TO_ND(cur, nd); att::attn_prefetch(nd, pf); att::attn_prime((LAS char*)lds, nd, pf); }
        for (int u = bx; u < NDIL; u += G) {
            const bool has_next = u + G < NDIL;
            { att::UD tmp; DECODE4(has_next ? u + G : u, tmp); TO_ND(tmp, nd); }
            DECODE4(u, cur);
            att::attn_unit<0, 2>((LAS char*)lds, cur, PD, LD, SD, noparts, pf, has_next, nd);
        }
#undef DECODE4
        { const int c0 = (int)(((long)nsel * bx) / G), c1 = (int)(((long)nsel * (bx + 1)) / G);
          att::attn_sel_chunks((LAS char*)lds, c0, c1, pfx, (const unsigned*)ctl + CW_BCNT, buck, QM, KM, VM, PM, LM, SM); }
    }
    SEAM(4);
    if (IN(5)) {
        PHASE_IDS;
        const int r32 = lane & 31;
        att::Parts PMp, PDp;
#pragma unroll
        for (int s3 = 0; s3 < 3; ++s3) { PMp.pbase[s3] = (const bf16*)((const unsigned char*)PM + (size_t)s3 * NTOK * WQ); PMp.plse[s3] = LM + (size_t)s3 * NTOK * 8; PMp.psc[s3] = SM + (size_t)s3 * NTOK * 8;
            PDp.pbase[s3] = (const bf16*)((const unsigned char*)PD + (size_t)(s3 < 2 ? s3 : 0) * NTOK * WQ); PDp.plse[s3] = LD + (size_t)(s3 < 2 ? s3 : 0) * NTOK * 8; PDp.psc[s3] = SD + (size_t)(s3 < 2 ? s3 : 0) * NTOK * 8; }
#define DECODE5(u_, D) do { const int uu = (u_); \
            if (uu < 1024) {     \
                const int bh = uu >> 5, qb = uu & 31, b = bh >> 3, h = bh & 7, hb = (b * SEQ) * WQ + h * HD; \
                D.Q = QM + hb; D.K = KM + hb; D.V = VM + hb; D.qpos = qb * 256 + wave * 32 + r32; D.qoff = D.qpos * WQ; \
                D.kp0 = qb * 256; D.kst = 1; D.t_lo = 0; D.t_hi = 4; D.w_lo = 0; D.w_hi = wave >> 1; D.W = 1 << 20; \
                D.sl2 = __builtin_amdgcn_exp2f(-0.5f * (float)(2 * h + 1)) * LOG2E; \
                D.ro = hb + D.qpos * WQ; D.li = (b * SEQ + D.qpos) * 8 + h; D.nparts = qb < 3 ? qb : 3; \
            } else {             \
                const int v = uu - 1024, bh = v >> 5, w5 = v & 31, res = w5 >> 1, l0 = (w5 & 1) * 256, b = bh >> 3, h = bh & 7, hb = (b * SEQ) * WQ + h * HD; \
                D.Q = QD + hb; D.K = KD + hb; D.V = VD + hb; D.qpos = (l0 + wave * 32 + r32) * 16 + res; D.qoff = D.qpos * WQ; \
                D.kp0 = (l0 - 128) * 16 + res; D.kst = 16; D.t_lo = l0 == 0 ? 2 : 0; D.t_hi = 6; D.w_lo = wave >> 1; D.w_hi = (wave >> 1) + 2; D.W = 128 * 16; \
                D.sl2 = __builtin_amdgcn_exp2f(-(float)(h + 1)) * LOG2E; \
                D.ro = hb + D.qpos * WQ; D.li = (b * SEQ + D.qpos) * 8 + h; D.nparts = 2; \
            } } while (0)
        att::UD cur; att::ND nd; att::PF pf;
        if (bx < 2048) { DECODE5(bx, cur); TO_ND(cur, nd); att::attn_prefetch(nd, pf); att::attn_prime((LAS char*)lds, nd, pf); }
        for (int u = bx; u < 2048; u += G) {
            const bool has_next = u + G < 2048;
            { att::UD tmp; DECODE5(has_next ? u + G : u, tmp); TO_ND(tmp, nd); }
            DECODE5(u, cur);
            if (u < 1024) att::attn_unit<3, 1>((LAS char*)lds, cur, MK_DEBUG ? Hb : QM, nullptr, nullptr, PMp, pf, has_next, nd);
            else att::attn_unit<2, 2>((LAS char*)lds, cur, MK_DEBUG ? Hb + (size_t)NTOK * WQ : QD, nullptr, nullptr, PDp, pf, has_next, nd);
        }
#undef DECODE5
#undef TO_ND
    }
    SEAM(5);

    if (IN(6)) {
        pg8::Gemm g{(const bf16*)(ws + WS_H8), (const bf16*)(ws + WS_WIN8 + (size_t)(NQKV - NBF) * DM), DM / 2, nullptr, DM / 2, (const bf16*)(ws + WS_H8), 1 << 30}; pg8::StaticOrder S; S.init(NTOK, NGATE, G, bx);
        pg8::EpiGates E{GATES, GATES + (size_t)NTOK * DM, args.in[3], (const float*)(ws + WS_RS8), (const float*)(ws + WS_CS8) + (NQKV - NBF)};
        pg8::gemm_phase<pg8::EpiGates, pg8::StaticOrder, true, false, QIN>(lds, g, S, E);
    }
    SEAM(6);
    if (IN(7)) {
        pg8::Gemm g{QM, (const bf16*)(ws + WS_WOM), DM, nullptr, WQ, QD, 16}; pg8::StaticOrder S; S.init(NTOK, DM, G, bx);
        pg8::EpiMix2 E{MIX, GATES, GATES + (size_t)NTOK * DM, (unsigned*)ctl + CW_MMAX};
        pg8::gemm_phase<pg8::EpiMix2, pg8::StaticOrder, true>(lds, g, S, E);
    }
    SEAM(7);
    if (IN(8)) {
        PHASE_IDS;
        unsigned char* M8 = ws + WS_MIX8; float* rsm = (float*)(ws + WS_RSM);
        for (int m = gw; m < NTOK; m += NGW) {
            const float mx = __uint_as_float(__hip_atomic_load((unsigned*)ctl + CW_MMAX + m, RLX_AGENT));
            const float qs = mx > 0.f ? 127.f / mx : 0.f;
            if (lane == 0) rsm[m] = mx * (1.f / 127.f);
#pragma unroll
            for (int j = 0; j < 4; ++j) { f32x4 a, b; pg8::unpack8(*(const u32x4*)(MIX + (size_t)m * DM + j * 512 + lane * 8), a, b);
                u32x2 q; q.x = pk_i8x4(a.x * qs, a.y * qs, a.z * qs, a.w * qs); q.y = pk_i8x4(b.x * qs, b.y * qs, b.z * qs, b.w * qs);
                *(u32x2*)(M8 + (size_t)m * DM + j * 512 + lane * 8) = q; }
        }
    }
    SEAM(8);
    if (IN(9)) {
        pg8::Gemm g{(const bf16*)(ws + WS_MIX8), (const bf16*)(ws + WS_WO), DM / 2, nullptr, DM / 2, (const bf16*)(ws + WS_MIX8), 1 << 30}; pg8::StaticOrder S; S.init(NTOK, DM, G, bx);
        pg8::EpiResid E{x, X1, args.in[7], (unsigned*)ctl + CW_UMAX, (const float*)(ws + WS_RSM), (const float*)(ws + WS_CSWO)};
        pg8::gemm_phase<pg8::EpiResid, pg8::StaticOrder, true, false, 2>(lds, g, S, E);
    }
    SEAM(9);

    if (IN(10)) {
        PHASE_IDS;
        const int r32 = lane & 31, hi = lane >> 5;
        constexpr int RSTR = 1040;
        constexpr int IMG = 2 * 32 * RSTR;
        LAS float* part = (LAS float*)(lds + IMG);
        LAS float* ssl = (LAS float*)(lds + 2 * IMG);
        LAS int* ecnt = (LAS int*)(lds + 2 * IMG + 256);
        LAS f32x4* G2L = (LAS f32x4*)(lds + 2 * IMG + 1024);
        if (tid < 32) ecnt[tid] = 0;
        G2L[tid + (tid >> 3)] = *(const f32x4*)(args.in[7] + 4 * tid);
        __syncthreads();
        const float* bgrp = args.in[9]; const float* bexp = args.in[11];
        const int tok = tid >> 4, part16 = tid & 15;
        for (int tile = bx; tile < NTOK / 32; tile += G) {
            const int t0 = tile * 32;
            f32x16 accE = {}, accG = {};
            float ss = 0.f;
            f32x4 xv[8];
            const float* xr = X1 + (size_t)(t0 + tok) * DM + part16 * 32;
            const float umx = __uint_as_float(__hip_atomic_load((unsigned*)ctl + CW_UMAX + t0 + tok, RLX_AGENT));
            const float uq = umx > 0.f ? 127.f / umx : 0.f;
            if (part16 == 0) ((float*)(ws + WS_RSU))[t0 + tok] = umx * (1.f / 127.f);
#pragma unroll
            for (int i = 0; i < 8; ++i) xv[i] = *(const f32x4*)(xr + 4 * i);
#pragma unroll 1
            for (int c = 0; c < 4; ++c) {
                if ((RT_ABL & 8) && args.dry) { asm volatile("" :: "v"(xv[0]), "v"(xv[1]), "v"(xv[2]), "v"(xv[3]), "v"(xv[4]), "v"(xv[5]), "v"(xv[6]), "v"(xv[7])); continue; }
                const int kc = c * 512 + part16 * 32;
                bf16x8 wEh[4], wEl[4], wG[4];
#pragma unroll
                for (int s4 = 0; s4 < 4; ++s4) { const int k = c * 512 + (wave * 4 + s4) * 16 + hi * 8; wEh[s4] = *(const bf16x8*)(WR + (size_t)r32 * DM + k); wEl[s4] = *(const bf16x8*)(WR + (size_t)(64 + r32) * DM + k); wG[s4] = *(const bf16x8*)(WR + (size_t)(32 + r32) * DM + k); }
                u32x2 u8[4];
                LAS unsigned char* UH = lds + (c & 1) * IMG; LAS unsigned char* UL = UH + 32 * RSTR;
#pragma unroll
                for (int i = 0; i < 4; ++i) {
                    const f32x4 ga = G2L[(kc >> 2) + (kc >> 5) + 2 * i], gb = G2L[(kc >> 2) + (kc >> 5) + 2 * i + 1];
                    const f32x4 xa = xv[2 * i], xb = xv[2 * i + 1];
                    ss += (xa.x * xa.x + xa.y * xa.y) + (xa.z * xa.z + xa.w * xa.w) + (xb.x * xb.x + xb.y * xb.y) + (xb.z * xb.z + xb.w * xb.w);
                    const f32x4 ua = xa * ga, ub = xb * gb;
                    const u32x4 uh = pg8::pack8(ua, ub);
                    f32x4 ha, hb2; pg8::unpack8(uh, ha, hb2);
                    *(LAS u32x4*)(UH + tok * RSTR + part16 * 64 + 16 * i) = uh;
                    *(LAS u32x4*)(UL + tok * RSTR + part16 * 64 + 16 * i) = pg8::pack8(ua - ha, ub - hb2);
                    u8[i].x = pk_i8x4_magic(ua.x, ua.y, ua.z, ua.w, uq); u8[i].y = pk_i8x4_magic(ub.x, ub.y, ub.z, ub.w, uq);
                }
                if (c < 3 && !((RT_ABL & 4) && args.dry)) {
#pragma unroll
                    for (int i = 0; i < 8; ++i) xv[i] = *(const f32x4*)(xr + (c + 1) * 512 + 4 * i);
                }
                if ((RT_ABL & 2) && args.dry) {
#pragma unroll
                    for (int i = 0; i < 4; ++i) asm volatile("" :: "v"(u8[i]));
                } else {
#pragma unroll
                for (int i = 0; i < 4; ++i) *(u32x2*)((unsigned char*)Hb + (size_t)(t0 + tok) * DM + kc + 8 * i) = u8[i];
                }
                if ((RT_ABL & 1) && args.dry) continue;
                __syncthreads();
#pragma unroll
                for (int s = 0; s < 4; ++s) {
                    const int kl = (wave * 4 + s) * 16 + hi * 8;
                    const bf16x8 uhv = *(const LAS bf16x8*)(UH + r32 * RSTR + kl * 2), ulv = *(const LAS bf16x8*)(UL + r32 * RSTR + kl * 2);
                    accE = __builtin_amdgcn_mfma_f32_32x32x16_bf16(wEh[s], uhv, accE, 0, 0, 0);
                    accE = __builtin_amdgcn_mfma_f32_32x32x16_bf16(wEh[s], ulv, accE, 0, 0, 0);
                    accE = __builtin_amdgcn_mfma_f32_32x32x16_bf16(wEl[s], uhv, accE, 0, 0, 0);
                    accG = __builtin_amdgcn_mfma_f32_32x32x16_bf16(wG[s], uhv, accG, 0, 0, 0);
                    accG = __builtin_amdgcn_mfma_f32_32x32x16_bf16(wG[s], ulv, accG, 0, 0, 0);
                }
            }
            ss += __shfl_xor(ss, 1); ss += __shfl_xor(ss, 2); ss += __shfl_xor(ss, 4); ss += __shfl_xor(ss, 8);
            __syncthreads();
            if (part16 == 0) ssl[tok] = ss;
            LAS float* pw = part + wave * (32 * 40);
#pragma unroll
            for (int r = 0; r < 16; ++r) pw[r32 * 40 + att::crow(r, hi)] = accE[r];
#pragma unroll
            for (int r = 0; r < 4; ++r) pw[r32 * 40 + 32 + 4 * hi + r] = accG[r];
            __syncthreads();
            if (tid < 32) {
                const int t = t0 + tid;
                const float rs = 1.0f / sqrtf(ssl[tid] * (1.f / DM) + RMS_EPS);
                float gl[4];
#pragma unroll
                for (int g = 0; g < 4; ++g) { float a = 0.f;
#pragma unroll
                    for (int w8 = 0; w8 < 8; ++w8) a += part[w8 * (32 * 40) + tid * 40 + 32 + g] + part[w8 * (32 * 40) + tid * 40 + 36 + g];
                    gl[g] = a * rs + bgrp[g]; }
                float gm = gl[0]; int gi = 0;
#pragma unroll
                for (int g = 1; g < 4; ++g) if (gl[g] > gm) { gm = gl[g]; gi = g; }
                float gs = 0.f;
#pragma unroll
                for (int g = 0; g < 4; ++g) gs += __expf(gl[g] - gm);
                const float gp = 1.0f / gs;
                float le[8];
#pragma unroll
                for (int e = 0; e < 8; ++e) { float a = 0.f;
#pragma unroll
                    for (int w8 = 0; w8 < 8; ++w8) a += part[w8 * (32 * 40) + tid * 40 + gi * 8 + e];
                    le[e] = a * rs + bexp[gi * 8 + e]; }
                float m0 = le[0]; int i0 = 0;
#pragma unroll
                for (int e = 1; e < 8; ++e) if (le[e] > m0) { m0 = le[e]; i0 = e; }
                float m1 = -__builtin_inff(); int i1 = 0;
#pragma unroll
                for (int e = 0; e < 8; ++e) if (e != i0 && le[e] > m1) { m1 = le[e]; i1 = e; }
                const float p1 = __expf(m1 - m0);
                const int e0 = gi * 8 + i0, e1 = gi * 8 + i1;
                EID[t * 2] = e0; EID[t * 2 + 1] = e1;
                EW[t * 2] = gp / (1.f + p1); EW[t * 2 + 1] = gp * p1 / (1.f + p1);
                RMS[t] = rs;
                __hip_atomic_fetch_add(&ecnt[e0], 1, __ATOMIC_RELAXED, __HIP_MEMORY_SCOPE_WORKGROUP); __hip_atomic_fetch_add(&ecnt[e1], 1, __ATOMIC_RELAXED, __HIP_MEMORY_SCOPE_WORKGROUP);
            }
        }
        __syncthreads();
        if (tid < 32 && ecnt[tid] > 0 && !args.dry) __hip_atomic_fetch_add((unsigned*)ctl + CW_ECNT + 64 * tid, (unsigned)ecnt[tid], RLX_AGENT);
    }
    SEAM(10);

    if (IN(11)) {
        PHASE_IDS;
        LAS int* pst = (LAS int*)(lds + 131072 - 1024);
        LAS int* ehist = pst + 64; LAS int* ebase = pst + 96;
        __syncthreads();
        if (tid == 0) { int s = 0; for (int e = 0; e < 32; ++e) { pst[e] = s; const int c = (int)__hip_atomic_load((unsigned*)ctl + CW_ECNT + 64 * e, RLX_AGENT); s += ((c + 255) >> 8) << 8; } pst[32] = s; }
        if (tid < 32) ehist[tid] = 0;
        __syncthreads();
        for (int t0 = bx * 128; t0 < NTOK && !args.dry; t0 += G * 128) {
            int e = 0, rk = 0;
            if (tid < 256) { e = EID[t0 * 2 + tid]; rk = __hip_atomic_fetch_add(&ehist[e], 1, __ATOMIC_RELAXED, __HIP_MEMORY_SCOPE_WORKGROUP); }
            __syncthreads();
            if (tid < 32) { const int c = ehist[tid]; ebase[tid] = c > 0 ? (int)__hip_atomic_fetch_add((unsigned*)ctl + CW_EFILL + 64 * tid, (unsigned)c, RLX_AGENT) : 0; }
            __syncthreads();
            if (tid < 256) { const int pos = pst[e] + ebase[e] + rk; ROWTOK[pos] = t0 + (tid >> 1); ROWW[pos] = EW[t0 * 2 + tid]; POS[t0 * 2 + tid] = pos; }
            __syncthreads();
            if (tid < 32) ehist[tid] = 0;
            __syncthreads();
        }
        if (bx < 32 && !args.dry) { const int c = (int)__hip_atomic_load((unsigned*)ctl + CW_ECNT + 64 * bx, RLX_AGENT); for (int r = pst[bx] + c + tid; r < pst[bx + 1]; r += NWAVES * 64) { ROWTOK[r] = 0; ROWW[r] = 0.f; } }
        LAS float* scr = (LAS float*)(lds + wave * 8704);
        LAS float* cmax = (LAS float*)(lds + 120 * 1024);
        float* csgu = (float*)(ws + WS_CSGU);
        for (int grp = vcu * 4; grp < 1024; grp += G * 4)
#pragma unroll 1
            for (int g4 = 0; g4 < 4; ++g4) {
                const int gg = grp + g4, which = gg & 1, r = gg >> 1, e = r >> 4, nb = r & 15, n0 = 32 * nb;
                const int lane = lane_fresh();
                const float* W = args.in[12 + which] + (size_t)e * DM * DEXP;
                float mx = 0.f;
                float vv[4][32];
#pragma unroll
                for (int q4 = 0; q4 < 4; ++q4) { const int kb = wave * 4 + q4;
#pragma unroll
                    for (int i = 0; i < 32; ++i) vv[q4][i] = W[(size_t)(64 * kb + 2 * i + (lane >> 5)) * DEXP + n0 + (lane & 31)]; }
#pragma unroll
                for (int q4 = 0; q4 < 4; ++q4)
#pragma unroll
                    for (int i = 0; i < 32; ++i) mx = fmaxf(mx, fabsf(vv[q4][i]));
                mx = fmaxf(mx, __shfl_xor(mx, 32));
                __syncthreads();
                if (lane < 32) cmax[wave * 32 + lane] = mx;
                __syncthreads();
                float cm = 0.f;
#pragma unroll
                for (int w8 = 0; w8 < 8; ++w8) cm = fmaxf(cm, cmax[w8 * 32 + (lane & 31)]);
                const long orow0 = (long)e * 1024 + (n0 >> 7) * 256 + which * 128 + (n0 & 127);
                if (wave == 0 && lane < 32) csgu[orow0 + lane] = cm * (1.f / 127.f);
                const float cscale = cm > 0.f ? 127.f / cm : 0.f;
#pragma unroll
                for (int q4 = 0; q4 < 4; ++q4) transpose_regs_i8(vv[q4], 64 * (wave * 4 + q4), ws + WS_WGU, DM, orow0, cscale, scr, lane);
            }
        constexpr int I_DN = 32 * 8 * 64;
        for (int it = gw; it < I_DN; it += NGW) { const int e = it >> 9, kb = (it >> 6) & 7, nb = it & 63;
            transpose_item_fp8(args.in[14] + (size_t)e * DEXP * DM, DM, 64 * kb, 32 * nb, ws + WS_WDN, DEXP, (long)e * 2048 + 32 * nb, WD8_SCALE, scr, lane); }
    }
    SEAM(11);

    if (IN(12) || IN(13)) {
        PHASE_IDS;
        LAS int* tst = (LAS int*)(lds + RING_BYTES + 64);
        __syncthreads();
        if (tid == 0) { int s = 0; for (int e = 0; e < 32; ++e) { tst[e] = s; const int c = (int)__hip_atomic_load((unsigned*)ctl + CW_ECNT + 64 * e, RLX_AGENT); s += (c + 255) >> 8; } tst[32] = s; }
        __syncthreads();
        const int ntiles = tst[32];
        if (IN(12)) {
            pg8::Gemm g{Hb, (const bf16*)(ws + WS_WGU), DM / 2, ROWTOK, DM / 2, Hb, 1 << 30}; pg8::GroupedOrder S{tst, 4, G, bx, ntiles};
            pg8::EpiMoe1 E{(bf16*)(ws + WS_HMOE), RMS, ROWTOK, (const float*)(ws + WS_RSU), (const float*)(ws + WS_CSGU)};
            pg8::gemm_phase<pg8::EpiMoe1, pg8::GroupedOrder, true, true, 2>(lds, g, S, E);
        }
        SEAM(12);
        if (IN(13)) {
            pg8::Gemm g{(const bf16*)(ws + WS_HMOE), (const bf16*)(ws + WS_WDN), DEXP / 2, nullptr, DEXP / 2, (const bf16*)(ws + WS_HMOE), 1 << 30}; pg8::GroupedOrder S{tst, 8, G, bx, ntiles};
            pg8::EpiMoe2 E{(bf16*)(ws + WS_YMOE), ROWW};
            pg8::gemm_phase<pg8::EpiMoe2, pg8::GroupedOrder, true, false, 1>(lds, g, S, E);
        }
    }
    SEAM(13);

    if (IN(14)) {
        PHASE_IDS;
        const float* gf = args.in[15]; const bf16* Y = (const bf16*)(ws + WS_YMOE);
        const unsigned tmo = __hip_atomic_load((unsigned*)ctl + CW_BAR + XB_TMO, RLX_AGENT);
        for (int m = gw; m < NTOK; m += NGW) {
            const float* xr = X1 + (size_t)m * DM; const int p0 = POS[m * 2], p1 = POS[m * 2 + 1];
            f32x4 v[8]; float s = 0.f;
#pragma unroll
            for (int j = 0; j < 4; ++j) { const int c = j * 512 + lane * 8;
                f32x4 a0, a1, b0, b1; pg8::unpack8(*(const u32x4*)(Y + (size_t)p0 * DM + c), a0, a1); pg8::unpack8(*(const u32x4*)(Y + (size_t)p1 * DM + c), b0, b1);
                v[2 * j] = *(const f32x4*)(xr + c) + a0 + b0; v[2 * j + 1] = *(const f32x4*)(xr + c + 4) + a1 + b1; }
#pragma unroll
            for (int j = 0; j < 8; ++j) s += (v[j].x * v[j].x + v[j].y * v[j].y) + (v[j].z * v[j].z + v[j].w * v[j].w);
            float rs = 1.0f / sqrtf(wave_sum(s) * (1.f / DM) + RMS_EPS);
            if (tmo) rs = __builtin_nanf("");
#pragma unroll
            for (int j = 0; j < 4; ++j) { const int c = j * 512 + lane * 8;
                *(f32x4*)(args.out + (size_t)m * DM + c) = v[2 * j] * rs * *(const f32x4*)(gf + c);
                *(f32x4*)(args.out + (size_t)m * DM + c + 4) = v[2 * j + 1] * rs * *(const f32x4*)(gf + c + 4); }
        }
    }
#undef IN
#undef SEAM
}

#if MK_DEBUG
namespace dbg {
__device__ __forceinline__ float b2f(bf16 v) { return __uint_as_float((unsigned)v << 16); }
__device__ __forceinline__ float wmax(float v) {
#pragma unroll
    for (int o = 1; o < 64; o <<= 1) v = fmaxf(v, __shfl_xor(v, o));
    return v;
}
__device__ __forceinline__ void wave_attend(const bf16* Q, const bf16* K, const bf16* V, int b, int h, int t, float slope, const int* kpos, int nk, float* qs, float* sc, float& o0, float& o1) {
    const int lane = threadIdx.x & 63;
    const size_t hb = (size_t)b * SEQ * WQ + h * HD;
    qs[lane] = b2f(Q[hb + (size_t)t * WQ + lane]); qs[lane + 64] = b2f(Q[hb + (size_t)t * WQ + lane + 64]);
    __builtin_amdgcn_s_waitcnt(0); __builtin_amdgcn_wave_barrier();
    float m = -INFINITY;
    for (int n = lane; n < nk; n += 64) { const int kp = kpos[n]; const bf16* kr = K + hb + (size_t)kp * WQ; float s = 0.f;
        for (int d = 0; d < HD; ++d) s = fmaf(qs[d], b2f(kr[d]), s);
        s = s * 0.08838834764831845f - slope * (float)(t - kp); sc[n] = s; m = fmaxf(m, s); }
    m = wmax(m);
    float l = 0.f;
    for (int n = lane; n < nk; n += 64) { const float p = expf(sc[n] - m); sc[n] = p; l += p; }
    l = wave_sum(l);
    __builtin_amdgcn_s_waitcnt(0); __builtin_amdgcn_wave_barrier();
    o0 = 0.f; o1 = 0.f;
    for (int n = 0; n < nk; ++n) { const float p = sc[n]; const bf16* vr = V + hb + (size_t)kpos[n] * WQ; o0 = fmaf(p, b2f(vr[lane]), o0); o1 = fmaf(p, b2f(vr[lane + 64]), o1); }
    o0 /= l; o1 /= l;
    __builtin_amdgcn_wave_barrier();
}
__global__ void __launch_bounds__(256) k_check(unsigned char* ws, int mode) {
    __shared__ int kpos_s[4][1024];
    __shared__ float sc_s[4][1024];
    __shared__ float qs_s[4][128];
    const int w = threadIdx.x >> 6, lane = threadIdx.x & 63;
    const unsigned sidx = blockIdx.x * 4 + w;
    const unsigned hsh = sidx * 2654435761u;
    const int b = (hsh >> 28) & 3, h = (hsh >> 24) & 7; int t = (hsh >> 8) & 8191;
    if ((sidx & 7) == 0) t = (sidx >> 3) & 511;
    const bf16* QM = (const bf16*)(ws + WS_QM); const bf16* KM = (const bf16*)(ws + WS_KM); const bf16* VM = (const bf16*)(ws + WS_VM);
    const bf16* QD = (const bf16*)(ws + WS_QD); const bf16* KD = (const bf16*)(ws + WS_KD); const bf16* VD = (const bf16*)(ws + WS_VD);
    const float* kmean = (const float*)(ws + WS_KMEAN);
    const bf16* OM = (const bf16*)(ws + WS_H); const bf16* OD = OM + (size_t)NTOK * WQ;
    float* accum = (float*)(ws + WS_CTL) + 200000;
    int* kp = kpos_s[w]; int nk = 0; float o0, o1; const bf16* O;
    const size_t hb = (size_t)b * SEQ * WQ + h * HD;
    if (mode == 1) {
        const int qblk = t >> 8;
        float g = -INFINITY;
        if (lane < qblk) { float s = 0.f; for (int d = 0; d < HD; ++d) s = fmaf(b2f(QM[hb + (size_t)t * WQ + d]), kmean[(size_t)((b * NH + h) * 32 + lane) * HD + d], s); g = s; }
        int s0 = -1, s1 = -1, s2 = -1; float g3 = 0.f, g4 = -INFINITY;
        { float mx = wmax(g);
          if (mx != -INFINITY) { s0 = __ffsll((long long)__ballot(g == mx)) - 1; if (lane == s0) g = -INFINITY; }
          mx = wmax(g);
          if (s0 >= 0 && mx != -INFINITY) { s1 = __ffsll((long long)__ballot(g == mx)) - 1; if (lane == s1) g = -INFINITY; }
          mx = wmax(g);
          if (s1 >= 0 && mx != -INFINITY) { s2 = __ffsll((long long)__ballot(g == mx)) - 1; g3 = mx; if (lane == s2) g = -INFINITY; }
          g4 = wmax(g); }
        if (s2 >= 0 && g4 != -INFINITY && g3 - g4 < 2e-3f) return;
        if (s0 >= 0) { for (int i = lane; i < 256; i += 64) kp[nk + i] = s0 * 256 + i; nk += 256; }
        if (s1 >= 0) { for (int i = lane; i < 256; i += 64) kp[nk + i] = s1 * 256 + i; nk += 256; }
        if (s2 >= 0) { for (int i = lane; i < 256; i += 64) kp[nk + i] = s2 * 256 + i; nk += 256; }
        const int own = t - qblk * 256 + 1;
        for (int i = lane; i < own; i += 64) kp[nk + i] = qblk * 256 + i;
        nk += own;
        __builtin_amdgcn_s_waitcnt(0); __builtin_amdgcn_wave_barrier();
        wave_attend(QM, KM, VM, b, h, t, exp2f(-0.5f * (float)(2 * h + 1)), kp, nk, qs_s[w], sc_s[w], o0, o1); O = OM;
    } else {
#pragma unroll
        for (int p = 0; p < 3; ++p) { const int d = (p == 0) ? 1 : (p == 1 ? 4 : 16); int cnt = t / d + 1; if (cnt > 129) cnt = 129;
            for (int i = lane; i < cnt; i += 64) kp[nk + i] = t - i * d; nk += cnt; }
        __builtin_amdgcn_s_waitcnt(0); __builtin_amdgcn_wave_barrier();
        wave_attend(QD, KD, VD, b, h, t, exp2f(-(float)(h + 1)), kp, nk, qs_s[w], sc_s[w], o0, o1); O = OD;
    }
    const float a0 = b2f(O[hb + (size_t)t * WQ + lane]), a1 = b2f(O[hb + (size_t)t * WQ + lane + 64]);
    float d2 = (a0 - o0) * (a0 - o0) + (a1 - o1) * (a1 - o1), r2 = o0 * o0 + o1 * o1;
    d2 = wave_sum(d2); r2 = wave_sum(r2);
    if (lane == 0) { atomicAdd(&accum[0], d2); atomicAdd(&accum[64], r2); }
}
__global__ void __launch_bounds__(256) k_report(unsigned char* ws, float* out, int n) {
    const int i = blockIdx.x * 256 + threadIdx.x;
    const float* accum = (const float*)(ws + WS_CTL) + 200000;
    if (i < n) out[i] = (i == 0) ? 1e4f * sqrtf(accum[0] / accum[64]) : 0.f;
}
}
#endif

extern "C" void kernel_launch(void* const* d_in, const int* in_sizes, int n_in, void* d_out, int out_size, void* d_ws, size_t ws_size, hipStream_t stream) {
    static int grid = 0;
    if (grid == 0) {
        if (n_in != 16 || ws_size < WS_END) { fprintf(stderr, "kernel_launch: need 16 inputs and %zu B of workspace (got %d, %zu)\n", (size_t)WS_END, n_in, ws_size); grid = -1; return; }
        int dev = 0, cus = 0, per_cu = 0;
        if (hipGetDevice(&dev) != hipSuccess || hipDeviceGetAttribute(&cus, hipDeviceAttributeMultiprocessorCount, dev) != hipSuccess) { grid = -1; return; }
        if (hipFuncSetAttribute((const void*)mk_fwd, hipFuncAttributeMaxDynamicSharedMemorySize, LDS_BYTES) != hipSuccess) { fprintf(stderr, "kernel_launch: hipFuncSetAttribute failed\n"); grid = -1; return; }
        if (hipOccupancyMaxActiveBlocksPerMultiprocessor(&per_cu, (const void*)mk_fwd, NWAVES * 64, LDS_BYTES) != hipSuccess || per_cu < 1) fprintf(stderr, "kernel_launch: occupancy query says %d\n", per_cu);
        (void)hipGetLastError();
        grid = cus;
    }
    if (grid < 0) return;
    (void)hipMemsetAsync((char*)d_ws + WS_CTL, 0, CTL_ZERO_BYTES, stream);
    (void)hipMemsetAsync((char*)d_ws + WS_KMEAN, 0, (size_t)NB * NH * 32 * HD * 4, stream);
    Args a{};
    for (int i = 0; i < 16; ++i) a.in[i] = (const float*)d_in[i];
    a.out = (float*)d_out; a.ws = (unsigned char*)d_ws;
    constexpr int NPH = 15;
#if MK_DEBUG
    for (int p = 0; p < 6; ++p) { a.ph_lo = p; a.ph_hi = p + 1; hipLaunchKernelGGL(mk_fwd, dim3(grid), dim3(NWAVES * 64), LDS_BYTES, stream, a); }
    hipLaunchKernelGGL(dbg::k_check, dim3(4096), dim3(256), 0, stream, (unsigned char*)d_ws, (int)MK_DEBUG);
    hipLaunchKernelGGL(dbg::k_report, dim3((out_size + 255) / 256), dim3(256), 0, stream, (unsigned char*)d_ws, (float*)d_out, out_size);
    return;
#endif
    if (MK_N_LAUNCHES == 1) { a.ph_lo = 0; a.ph_hi = NPH; hipLaunchKernelGGL(mk_fwd, dim3(grid), dim3(NWAVES * 64), LDS_BYTES, stream, a); }
    else { for (int p = 0; p < NPH; ++p) { const int reps = ((MK_REP_MASK >> p) & 1) ? 2 : 1; if (p == 2) continue;
            for (int r = 0; r < reps; ++r) { a.ph_lo = p; a.ph_hi = p + 1; a.dry = ((p == 10 || p == 11) && reps == 2 && r == 0) ? 1 : ((p == 4 && reps == 2 && r == 0) ? MK_DRY4 : 0); hipLaunchKernelGGL(mk_fwd, dim3(grid), dim3(NWAVES * 64), LDS_BYTES, stream, a);
            } } }
}
```

```cpp
#include <hip/hip_runtime.h>
#include <cstdio>
#include <cstdint>

#ifndef MK_N_LAUNCHES
#define MK_N_LAUNCHES 1
#endif

#ifndef MK_REP_MASK
#define MK_REP_MASK 0
#endif
#ifndef MK_DRY4
#define MK_DRY4 0
#endif
#ifndef MK_DEBUG
#define MK_DEBUG 0
#endif
#define LAS __attribute__((address_space(3)))
#define GAS __attribute__((address_space(1)))
typedef unsigned short bf16;
typedef short bf16x8 __attribute__((ext_vector_type(8)));
typedef short s16x4 __attribute__((ext_vector_type(4)));
typedef float f32x2 __attribute__((ext_vector_type(2)));
typedef float f32x4 __attribute__((ext_vector_type(4)));
typedef float f32x16 __attribute__((ext_vector_type(16)));
typedef unsigned u32x2 __attribute__((ext_vector_type(2)));
typedef unsigned u32x4 __attribute__((ext_vector_type(4)));
typedef int i32x4 __attribute__((ext_vector_type(4)));
typedef int i32x8 __attribute__((ext_vector_type(8)));
typedef GAS unsigned gu32;

constexpr int DM = 2048, NB = 4, SEQ = 8192, NTOK = NB * SEQ, HD = 128, NH = 8, WQ = 1024;
constexpr int NQKV = 6144, NGATE = 4096, NEXP = 32, DEXP = 512;
constexpr int NBF = 0;
constexpr int QIN = 2;
constexpr int RMAX = 73728;
constexpr float RMS_EPS = 1e-6f;
constexpr float LOG2E = 1.4426950408889634f;
constexpr float SM_C2 = 0.08838834764831845f * LOG2E;

constexpr size_t MiB = 1u << 20;
constexpr size_t WS_CTL = 0, CTL_ZERO_BYTES = 1 * MiB;
constexpr size_t WS_WOM = 1 * MiB, WS_WOD = 5 * MiB, WS_WO = 9 * MiB, WS_WIN = 17 * MiB;
constexpr size_t WS_WIN8 = 25 * MiB;
constexpr size_t WS_H8 = 912 * MiB;
constexpr size_t WS_BUCK = 57 * MiB;
constexpr size_t WS_CS8 = 73 * MiB;
constexpr size_t WS_RS8 = 73 * MiB + 64 * 1024;
constexpr size_t WS_KMEAN = 74 * MiB;
constexpr size_t WS_WR = 74 * MiB + 512 * 1024;
constexpr size_t WS_H = 75 * MiB;
constexpr size_t WS_QM = 203 * MiB, WS_KM = 267 * MiB, WS_VM = 331 * MiB, WS_QD = 395 * MiB, WS_KD = 459 * MiB, WS_VD = 523 * MiB;
constexpr size_t WS_PM = 587 * MiB;
constexpr size_t WS_PD = 779 * MiB;
constexpr size_t WS_LM = 907 * MiB, WS_LD = 910 * MiB;
constexpr size_t WS_SM = 976 * MiB, WS_SD = 980 * MiB;
constexpr size_t WS_GATES = 587 * MiB;
constexpr size_t WS_GINV = 75 * MiB;
constexpr size_t WS_MIX = 267 * MiB;
constexpr size_t WS_X1 = 768 * MiB;
constexpr size_t WS_WGU = 203 * MiB, WS_WDN = 331 * MiB;
constexpr size_t WS_HMOE = 395 * MiB;
constexpr size_t WS_YMOE = 467 * MiB;
constexpr size_t WS_END = 1024 * MiB;
constexpr size_t WS_RSM = WS_BUCK + 2560 * 1024, WS_CSWO = 73 * MiB + 48 * 1024;
constexpr size_t WS_MIX8 = 75 * MiB;
constexpr size_t WS_RSU = WS_BUCK + 2048 * 1024, WS_CSGU = WS_BUCK + 2304 * 1024;
constexpr size_t WS_EID = WS_BUCK, WS_EW = WS_BUCK + 256 * 1024, WS_RMS = WS_BUCK + 512 * 1024, WS_POS = WS_BUCK + 768 * 1024, WS_ROWTOK = WS_BUCK + 1024 * 1024, WS_ROWW = WS_BUCK + 1536 * 1024;
static_assert(WS_YMOE + (size_t)RMAX * 2048 * 2 <= WS_X1 && WS_HMOE + (size_t)RMAX * 512 * 2 <= WS_YMOE && WS_LD + 2 * (size_t)NTOK * 8 * 4 <= WS_END, "ws map");

constexpr int CW_TMO = 0;
constexpr int CW_BAR = 4096;
constexpr int CW_BCNT = 8192;
constexpr int CW_ECNT = 8192 + 65536;
constexpr int CW_EFILL = CW_ECNT + 64 * 32;
constexpr int CW_MMAX = 163840;
constexpr int CW_UMAX = 131072;
constexpr int CW_Q10 = 200000;
constexpr int CW_CMAX = 81920;
static_assert(CW_EFILL + 64 * 32 <= CW_CMAX && CW_CMAX + 8192 <= CW_UMAX && CW_UMAX + NTOK <= CW_MMAX && (CW_MMAX + NTOK) * 4 <= (int)CTL_ZERO_BYTES, "ctl");

constexpr int BUCK_PER_BH = 256 * 496;
__host__ __device__ __forceinline__ int buck_off(int j) { return 256 * (31 * j - (j * (j - 1)) / 2); }

constexpr int RING_BYTES = 131072, LDS_BYTES = 163840, MISC_OFF = LDS_BYTES - 512;
constexpr int NWAVES = 8;

#define LDS_WAIT() asm volatile("s_waitcnt lgkmcnt(0)" ::: "memory")
#define VM_WAIT() asm volatile("s_waitcnt vmcnt(0)" ::: "memory")
#define RLX_AGENT __ATOMIC_RELAXED, __HIP_MEMORY_SCOPE_AGENT

__device__ __forceinline__ unsigned cvt_pk_bf16(float lo, float hi) { unsigned r; asm volatile("v_cvt_pk_bf16_f32 %0, %1, %2" : "=v"(r) : "v"(lo), "v"(hi)); return r; }
__device__ __forceinline__ float bf_lo(unsigned w) { return __uint_as_float(w << 16); }
__device__ __forceinline__ float bf_hi(unsigned w) { return __uint_as_float(w & 0xffff0000u); }
__device__ __forceinline__ unsigned pk_fp8x4(float a, float b, float c, float d) {
    a = fminf(fmaxf(a, -448.f), 448.f); b = fminf(fmaxf(b, -448.f), 448.f); c = fminf(fmaxf(c, -448.f), 448.f); d = fminf(fmaxf(d, -448.f), 448.f);
    unsigned w = 0; w = __builtin_amdgcn_cvt_pk_fp8_f32(a, b, w, false); w = __builtin_amdgcn_cvt_pk_fp8_f32(c, d, w, true); return w; }
constexpr float H8_SCALE = 8.f, WD8_SCALE = 256.f;
__device__ __forceinline__ int lane_fresh() { int l = (int)__builtin_amdgcn_mbcnt_hi(~0u, __builtin_amdgcn_mbcnt_lo(~0u, 0u)); asm volatile("" : "+v"(l)); return l; }
__device__ __forceinline__ unsigned pk_i8x4(float a, float b, float c, float d) {
    const int ia = (int)fminf(fmaxf(__builtin_rintf(a), -127.f), 127.f), ib = (int)fminf(fmaxf(__builtin_rintf(b), -127.f), 127.f);
    const int ic = (int)fminf(fmaxf(__builtin_rintf(c), -127.f), 127.f), id = (int)fminf(fmaxf(__builtin_rintf(d), -127.f), 127.f);
    return (unsigned)(ia & 255) | ((unsigned)(ib & 255) << 8) | ((unsigned)(ic & 255) << 16) | ((unsigned)(id & 255) << 24); }
__device__ __forceinline__ float wave_sum(float v) {
#pragma unroll
    for (int o = 1; o < 64; o <<= 1) v += __shfl_xor(v, o);
    return v;
}

#define XB_TMO      128
#define XB_XCNT(j)  (256  + 64 * (j))
#define XB_XSUB(j)  (1280 + 64 * (j))
#define XB_XGEN(j)  (2304 + 64 * (j))
#define XB_TOP      3328
#define XB_TOPGEN   3392
#define XCD_BAR_WORDS 3456
#define XB_SPIN_CAP (1u << 22)
__device__ __forceinline__ unsigned xb_ld(unsigned* p)              { return __hip_atomic_load(p, __ATOMIC_RELAXED, __HIP_MEMORY_SCOPE_AGENT); }
__device__ __forceinline__ unsigned xb_add(unsigned* p, unsigned v) { return __hip_atomic_fetch_add(p, v, __ATOMIC_RELAXED, __HIP_MEMORY_SCOPE_AGENT); }
__device__ __forceinline__ unsigned xb_xcc_id() { return (unsigned)__builtin_amdgcn_s_getreg((3 << 11) | 20) & 0xFu; }
#define XB_SPIN(cond, bar) do { unsigned _sp = 0; while (cond) { __builtin_amdgcn_s_sleep(1); \
    if ((++_sp & 255u) == 0u) { if (xb_ld(&(bar)[XB_TMO])) break; if (_sp > XB_SPIN_CAP) { atomicAdd(&(bar)[XB_TMO], 1u); break; } } } } while (0)
struct XcdBarrier { unsigned* bar; unsigned x; volatile LAS unsigned* st; };
__device__ __forceinline__ XcdBarrier xcd_barrier_post(unsigned* bar, volatile LAS unsigned* st) {
    XcdBarrier b; b.bar = bar; b.x = xb_xcc_id(); b.st = st;
    if (threadIdx.x == 0) (void)xb_add(&bar[XB_XCNT(b.x)], 1u);
    return b;
}
__device__ __forceinline__ void xcd_barrier_complete(unsigned* bar, unsigned x, unsigned& nloc, unsigned& nx) {
    const unsigned G = gridDim.x * gridDim.y * gridDim.z;
    unsigned sum, cnt, mine, sp = 0u;
    for (;;) {
        sum = 0u; cnt = 0u; mine = 0u;
#pragma unroll
        for (unsigned j = 0; j < 16; ++j) { const unsigned c = xb_ld(&bar[XB_XCNT(j)]); sum += c; cnt += (c > 0u) ? 1u : 0u; mine = (j == x) ? c : mine; }
        if (sum == G) break;
        __builtin_amdgcn_s_sleep(1);
        if ((++sp & 255u) == 0u) { if (xb_ld(&bar[XB_TMO])) break; if (sp > XB_SPIN_CAP) { atomicAdd(&bar[XB_TMO], 1u); break; } }
    }
    nloc = mine > 0u ? mine : 1u; nx = cnt > 0u ? cnt : 1u;
}
__device__ __forceinline__ void xcd_barrier(const XcdBarrier& b) {
    asm volatile("s_waitcnt vmcnt(0)" ::: "memory");
    __syncthreads();
    if (threadIdx.x == 0) {
        unsigned* bar = b.bar;
        __builtin_amdgcn_s_waitcnt(0);
        unsigned nloc = b.st[0], nx = b.st[1];
        if (nloc == 0u) { xcd_barrier_complete(bar, b.x, nloc, nx); b.st[0] = nloc; b.st[1] = nx; }
        const unsigned old = xb_add(&bar[XB_XSUB(b.x)], 1u);
        const unsigned gen = old / nloc;
        if (old + 1u == (gen + 1u) * nloc) {
            __builtin_amdgcn_fence(__ATOMIC_RELEASE, "agent");
            asm volatile("s_waitcnt vmcnt(0)" ::: "memory");
            const unsigned og = xb_add(&bar[XB_TOP], 1u);
            const unsigned tg = og / nx;
            if (og + 1u == (tg + 1u) * nx) xb_add(&bar[XB_TOPGEN], 1u);
            else XB_SPIN(xb_ld(&bar[XB_TOPGEN]) == tg, bar);
            __builtin_amdgcn_fence(__ATOMIC_ACQUIRE, "agent");
            xb_add(&bar[XB_XGEN(b.x)], 1u);
            asm volatile("s_waitcnt vmcnt(0)" ::: "memory");
        } else {
            XB_SPIN(xb_ld(&bar[XB_XGEN(b.x)]) == gen, bar);
            __builtin_amdgcn_fence(__ATOMIC_ACQUIRE, "agent");
            asm volatile("s_waitcnt vmcnt(0)" ::: "memory");
        }
    }
    __syncthreads();
}

namespace pg8 {
constexpr int BM = 256, BK = 64, HALF = 128, HTB = HALF * BK * 2, NXCD = 8, WGM = 8;
__host__ __device__ __forceinline__ int lds_byte(int r, int c) { const int st = (r >> 4) * 2 + (c >> 5), rr = r & 15, cc = c & 31, ob = rr * 64 + cc * 2; return st * 1024 + (ob ^ (((ob >> 9) & 1) << 5)); }
__host__ __device__ __forceinline__ void stage_rc(int b, int& R, int& C) { const int st = b / 1024, sb = b % 1024, swz = sb ^ (((sb >> 9) & 1) << 5); R = (st >> 1) * 16 + swz / 64; C = (st & 1) * 32 + (swz % 64) / 2; }
__host__ __device__ __forceinline__ int perm32(int rho) { const int n = rho >> 4, i = rho & 15; return 8 * (i >> 2) + 4 * n + (i & 3); }

struct Unit { int pm, pn, pb, ex; };
struct Gemm { const bf16* A; const bf16* Bt; int K; const int* rowidx; int lda; const bf16* A1; int ksplit; };

struct StaticOrder {
    int nM, nN, nwg, G, c;
    __device__ void init(int M, int N, int G_, int c_) { nM = M / BM; nN = N / BM; nwg = nM * nN; G = G_; c = c_; }
    __device__ bool next(int i, Unit& u) const {
        const long L = (long)i * G + c; if (L >= nwg) return false;
        int wgid = (int)L; { const int q = nwg / NXCD, r = nwg % NXCD, xcd = wgid % NXCD, off = wgid / NXCD; wgid = (xcd < r ? xcd * (q + 1) : r * (q + 1) + (xcd - r) * q) + off; }
        const int nig = WGM * nN, gid = wgid / nig, fm = gid * WGM, gsz = (nM - fm) < WGM ? (nM - fm) : WGM;
        u.pm = fm + ((wgid % nig) % gsz); u.pn = (wgid % nig) / gsz; u.pb = u.pn; u.ex = 0; return true;
    }
};
struct GroupedOrder {
    const LAS int* tstart;
    int nN, G, c, ntiles;
    __device__ bool next(int i, Unit& u) const {
        const long L = (long)i * G + c; if (L >= (long)ntiles * nN) return false;
        const int ti = (int)(L / nN), pn = (int)(L % nN);
        int e = 0;
#pragma unroll 1
        for (int k = 1; k < 32; ++k) e += (tstart[k] <= ti) ? 1 : 0;
        u.pm = ti; u.pn = pn; u.pb = e * nN + pn; u.ex = e; return true;
    }
};

template <class Epi, class Sched, bool ALIGN_EPI, bool GATHER = false, int QMODE = 0>
__device__ __forceinline__ void gemm_phase(LAS unsigned char* lds, const Gemm g, const Sched& S, const Epi& E) {
    const int lane = lane_fresh(), wid = __builtin_amdgcn_readfirstlane((int)threadIdx.x >> 6), tid = wid * 64 + lane, wr = wid >> 2, wc = wid & 3, fr = lane & 15, fq = lane >> 4;
    const int K = g.K, nt = K / BK;
    int RA[2], CA[2]; unsigned voffB[2];
#pragma unroll
    for (int i = 0; i < 2; ++i) { int R, C; stage_rc(tid * 16 + i * 8192, R, C); const int Rb = Epi::PERM ? ((R & ~31) + perm32(R & 31)) : R;
        RA[i] = R; CA[i] = C; voffB[i] = (unsigned)(Rb * K + C) * 2u; }
    const size_t kstep = (size_t)(BK * 2);
    const size_t hstep = (size_t)HALF * K * 2;
    const size_t tstep = 2 * hstep;
    const unsigned ldsw = (unsigned)wid * 1024u;
    const int aoff = lds_byte(wr * 64 + fr, fq * 8), boff = lds_byte(wc * 32 + fr, fq * 8);
#define PG8_SA(b, h) (((b) * 2 + (h)) * HTB)
#define PG8_SB(b, h) ((4 + (b) * 2 + (h)) * HTB)
#define PG8_STAGEB(bufoff, gbase) do { _Pragma("unroll") for (int _i = 0; _i < 2; ++_i) \
        __builtin_amdgcn_global_load_lds((const unsigned*)((const char*)(gbase) + voffB[_i]), (LAS unsigned*)(lds + (bufoff) + ldsw + _i * 8192), 16, 0, 0); } while (0)
#define PG8_STAGEA(bufoff, gbase, vo, h) do { _Pragma("unroll") for (int _i = 0; _i < 2; ++_i) \
        __builtin_amdgcn_global_load_lds((const unsigned*)((const char*)(gbase) + (vo)[h][_i]), (LAS unsigned*)(lds + (bufoff) + ldsw + _i * 8192), 16, 0, 0); } while (0)
#define PG8_LDA(dst, b, h) do { _Pragma("unroll") for (int m = 0; m < 4; ++m) _Pragma("unroll") for (int k = 0; k < 2; ++k) dst[m][k] = *(const LAS bf16x8*)(lds + PG8_SA(b, h) + aoff + m * 2048 + k * 1024); } while (0)
#define PG8_LDB(dst, b, h) do { _Pragma("unroll") for (int n = 0; n < 2; ++n) _Pragma("unroll") for (int k = 0; k < 2; ++k) dst[n][k] = *(const LAS bf16x8*)(lds + PG8_SB(b, h) + boff + n * 2048 + k * 1024); } while (0)
#define PG8_CAT(x0, x1) __builtin_shufflevector(__builtin_bit_cast(i32x4, x0), __builtin_bit_cast(i32x4, x1), 0, 1, 2, 3, 4, 5, 6, 7)
#define PG8_MMA(ai, bj, At, Bt) do { __builtin_amdgcn_s_setprio(1); _Pragma("unroll") for (int m = 0; m < 4; ++m) _Pragma("unroll") for (int n = 0; n < 2; ++n) { \
        if constexpr (QMODE == 1) asm volatile("v_mfma_scale_f32_16x16x128_f8f6f4 %0, %1, %2, %0, %3, %3 op_sel_hi:[0,0,0]" : "+v"(acc[ai][bj][m][n]) : "v"(PG8_CAT(Bt[n][0], Bt[n][1])), "v"(PG8_CAT(At[m][0], At[m][1])), "v"(sc1)); \
        else if constexpr (QMODE == 2) { _Pragma("unroll") for (int k = 0; k < 2; ++k) acc[ai][bj][m][n] = __builtin_bit_cast(f32x4, __builtin_amdgcn_mfma_i32_16x16x64_i8(__builtin_bit_cast(i32x4, Bt[n][k]), __builtin_bit_cast(i32x4, At[m][k]), __builtin_bit_cast(i32x4, acc[ai][bj][m][n]), 0, 0, 0)); } \
        else { _Pragma("unroll") for (int k = 0; k < 2; ++k) acc[ai][bj][m][n] = __builtin_amdgcn_mfma_f32_16x16x32_bf16(Bt[n][k], At[m][k], acc[ai][bj][m][n], 0, 0, 0); } } __builtin_amdgcn_s_setprio(0); } while (0)
#define PG8_WAIT_V(n) asm volatile("s_waitcnt vmcnt(" #n ")" ::: "memory")
#define PG8_WAIT_L(n) asm volatile("s_waitcnt lgkmcnt(" #n ")" ::: "memory")
#define PG8_BAR __builtin_amdgcn_s_barrier()
#define PG8_SCHED __builtin_amdgcn_sched_barrier(0)
#define PG8_AOFF(vo, u) do { _Pragma("unroll") for (int _h = 0; _h < 2; ++_h) _Pragma("unroll") for (int _i = 0; _i < 2; ++_i) { \
        const int _r = (GATHER ? (u).pm * BM : 0) + _h * HALF + RA[_i]; const int _row = GATHER ? g.rowidx[_r] : _r; (vo)[_h][_i] = (unsigned)(_row * g.lda + CA[_i]) * 2u; } } while (0)
    Unit cur, nxt; int ui = 0;
    if (!S.next(0, cur)) return;
    int sc1 = 0x7f7f7f7f; asm volatile("" : "+v"(sc1));
    f32x4 acc[2][2][4][2];
#pragma unroll
    for (int a = 0; a < 2; ++a)
#pragma unroll
        for (int b = 0; b < 2; ++b)
#pragma unroll
            for (int m = 0; m < 4; ++m)
#pragma unroll
                for (int n = 0; n < 2; ++n) acc[a][b][m][n] = (f32x4){0.f, 0.f, 0.f, 0.f};
    bf16x8 At[4][2], B0[2][2], B1[2][2];
    unsigned voC[2][2], voN[2][2];
    PG8_AOFF(voC, cur);
    const size_t tstepA = (size_t)BM * g.lda * 2;
    const char* cA = (const char*)g.A + (GATHER ? 0 : (size_t)cur.pm * tstepA); const char* cA1 = (const char*)g.A1 - (size_t)g.ksplit * kstep + (GATHER ? 0 : (size_t)cur.pm * tstepA);
#define PG8_AP(t_) (((t_) < g.ksplit ? cA : cA1) + (size_t)(t_) * kstep)
    const char* cB = (const char*)g.Bt + (size_t)cur.pb * tstep;
    PG8_STAGEB(PG8_SB(0, 0), cB); PG8_STAGEB(PG8_SB(0, 1), cB + hstep); PG8_STAGEA(PG8_SA(0, 0), cA, voC, 0); PG8_STAGEA(PG8_SA(0, 1), cA, voC, 1);
    if (wr == 1) PG8_BAR;
    PG8_WAIT_V(2); PG8_BAR;
    PG8_STAGEB(PG8_SB(1, 0), cB + kstep); PG8_STAGEA(PG8_SA(1, 0), PG8_AP(1), voC, 0); PG8_STAGEB(PG8_SB(1, 1), cB + hstep + kstep);
    PG8_WAIT_V(6); PG8_BAR;
    for (;;) {
        const bool has_next = S.next(ui + 1, nxt);
        if constexpr (GATHER) { if (has_next) { PG8_AOFF(voN, nxt); } else {
#pragma unroll
            for (int _h = 0; _h < 2; ++_h)
#pragma unroll
                for (int _i = 0; _i < 2; ++_i) voN[_h][_i] = voC[_h][_i]; } }
        const char* nB = has_next ? (const char*)g.Bt + (size_t)nxt.pb * tstep : cB;
        const char* nA = (GATHER || !has_next) ? cA : (const char*)g.A + (size_t)nxt.pm * tstepA;
        const char* nA1 = (GATHER || !has_next) ? cA1 : (const char*)g.A1 - (size_t)g.ksplit * kstep + (size_t)nxt.pm * tstepA;
        for (int t = 0; t < nt; t += 2) {
            const bool last = (t == nt - 2);
            const char* a1 = PG8_AP(t + 1);
            const char* a2 = last ? nA : PG8_AP(t + 2); const char* b2 = last ? nB : cB + (size_t)(t + 2) * kstep;
            const char* a3 = last ? nA + kstep : PG8_AP(t + 3); const char* b3 = b2 + kstep;
            if constexpr (Epi::MIDHOOK) { if (t == g.ksplit) E.mid(acc, cur, wr, wc, fr, fq); }
            unsigned vo2[2][2];
#pragma unroll
            for (int _h = 0; _h < 2; ++_h)
#pragma unroll
                for (int _i = 0; _i < 2; ++_i) { if constexpr (GATHER) vo2[_h][_i] = last ? voN[_h][_i] : voC[_h][_i]; else vo2[_h][_i] = voC[_h][_i]; }
            PG8_LDB(B0, 0, 0); PG8_LDB(B1, 0, 1); PG8_SCHED; PG8_LDA(At, 0, 0); PG8_STAGEA(PG8_SA(1, 1), a1, voC, 1);
            PG8_WAIT_V(8); PG8_WAIT_L(0); PG8_BAR; PG8_MMA(0, 0, At, B0); PG8_MMA(0, 1, At, B1); PG8_BAR; PG8_SCHED;
            PG8_LDA(At, 0, 1); PG8_STAGEB(PG8_SB(0, 0), b2); PG8_STAGEB(PG8_SB(0, 1), b2 + hstep); PG8_STAGEA(PG8_SA(0, 0), a2, vo2, 0);
            PG8_WAIT_V(8); PG8_WAIT_L(0); PG8_BAR; PG8_MMA(1, 0, At, B0); PG8_MMA(1, 1, At, B1); PG8_BAR; PG8_SCHED;
            PG8_LDB(B0, 1, 0); PG8_LDB(B1, 1, 1); PG8_SCHED; PG8_LDA(At, 1, 0); PG8_STAGEA(PG8_SA(0, 1), a2, vo2, 1);
            PG8_WAIT_V(8); PG8_WAIT_L(0); PG8_BAR; PG8_MMA(0, 0, At, B0); PG8_MMA(0, 1, At, B1); PG8_BAR; PG8_SCHED;
            PG8_LDA(At, 1, 1); PG8_STAGEB(PG8_SB(1, 0), b3); PG8_STAGEB(PG8_SB(1, 1), b3 + hstep); PG8_STAGEA(PG8_SA(1, 0), a3, vo2, 0);
            PG8_WAIT_V(8); PG8_WAIT_L(0); PG8_BAR; PG8_MMA(1, 0, At, B0); PG8_MMA(1, 1, At, B1); PG8_BAR; PG8_SCHED;
        }
        if constexpr (ALIGN_EPI) { if (wr == 0) PG8_BAR; }
        if constexpr (QMODE == 1) asm volatile("s_nop 15\n\ts_nop 15\n\ts_nop 15\n\ts_nop 15\n\ts_nop 15" ::: "memory");
        if constexpr (QMODE == 2) {
#pragma unroll
            for (int a = 0; a < 2; ++a)
#pragma unroll
                for (int b = 0; b < 2; ++b)
#pragma unroll
                    for (int m = 0; m < 4; ++m)
#pragma unroll
                        for (int n = 0; n < 2; ++n) acc[a][b][m][n] = __builtin_convertvector(__builtin_bit_cast(i32x4, acc[a][b][m][n]), f32x4); }
        E(acc, cur, wr, wc, fr, fq);
        if (!has_next) break;
#pragma unroll
        for (int a = 0; a < 2; ++a)
#pragma unroll
            for (int b = 0; b < 2; ++b)
#pragma unroll
                for (int m = 0; m < 4; ++m)
#pragma unroll
                    for (int n = 0; n < 2; ++n) acc[a][b][m][n] = (f32x4){0.f, 0.f, 0.f, 0.f};
        cur = nxt; cB = nB; cA = nA; cA1 = nA1; ++ui;
        if constexpr (GATHER) {
#pragma unroll
            for (int _h = 0; _h < 2; ++_h)
#pragma unroll
                for (int _i = 0; _i < 2; ++_i) voC[_h][_i] = voN[_h][_i]; }
        if constexpr (ALIGN_EPI) { if (wr == 1) PG8_BAR; }
    }
    PG8_WAIT_V(0);
    if constexpr (!ALIGN_EPI) { if (wr == 0) PG8_BAR; }
    PG8_BAR;
#undef PG8_SA
#undef PG8_SB
#undef PG8_STAGEA
#undef PG8_STAGEB
#undef PG8_LDA
#undef PG8_LDB
#undef PG8_MMA
#undef PG8_WAIT_V
#undef PG8_WAIT_L
#undef PG8_BAR
#undef PG8_SCHED
#undef PG8_AOFF
#undef PG8_AP
#undef PG8_CAT
}

#define EPI_LOOP_BEGIN _Pragma("unroll") for (int ai = 0; ai < 2; ++ai) _Pragma("unroll") for (int m = 0; m < 4; ++m) { const int row = u.pm * BM + ai * HALF + wr * 64 + m * 16 + fr; _Pragma("unroll") for (int bj = 0; bj < 2; ++bj) { const int colt = bj * HALF + wc * 32 + 8 * fq;
#define EPI_LOOP_END } }
__device__ __forceinline__ int opaque0() { int z = 0; asm volatile("" : "+v"(z)); return z; }
__device__ __forceinline__ u32x4 pack8(f32x4 v0, f32x4 v1) { u32x4 w; w.x = cvt_pk_bf16(v0[0], v0[1]); w.y = cvt_pk_bf16(v0[2], v0[3]); w.z = cvt_pk_bf16(v1[0], v1[1]); w.w = cvt_pk_bf16(v1[2], v1[3]); return w; }
__device__ __forceinline__ void unpack8(u32x4 w, f32x4& a, f32x4& b) { a = (f32x4){bf_lo(w.x), bf_hi(w.x), bf_lo(w.y), bf_hi(w.y)}; b = (f32x4){bf_lo(w.z), bf_hi(w.z), bf_lo(w.w), bf_hi(w.w)}; }

struct EpiQKV {
    static constexpr bool PERM = true, MIDHOOK = false;
    bf16* O; int pn0; const float* rsc; const float* csc;
    float* kmean;
    __device__ __forceinline__ void operator()(const f32x4 (&acc)[2][2][4][2], const Unit& u, int wr, int wc, int fr_, int fq_) const {
        const int fr = fr_ + opaque0(), fq = fq_ + opaque0();
        const int pn = u.pn + pn0;
        if (kmean != nullptr && (pn >> 2) == 1) {
#pragma unroll
            for (int bj = 0; bj < 2; ++bj)
#pragma unroll
                for (int n = 0; n < 2; ++n) { f32x4 sm = (f32x4){0.f, 0.f, 0.f, 0.f};
#pragma unroll
                    for (int ai = 0; ai < 2; ++ai)
#pragma unroll
                        for (int m = 0; m < 4; ++m) sm += rsc ? acc[ai][bj][m][n] * rsc[u.pm * BM + ai * HALF + wr * 64 + m * 16 + fr] : acc[ai][bj][m][n];
                    if (rsc) sm = sm * *(const f32x4*)(csc + u.pn * BM + bj * HALF + wc * 32 + 8 * fq + 4 * n);
#pragma unroll
                    for (int e = 0; e < 4; ++e) { float v = sm[e]; v += __shfl_xor(v, 1); v += __shfl_xor(v, 2); v += __shfl_xor(v, 4); v += __shfl_xor(v, 8); sm[e] = v; }
                    if ((fr_ & 15) == 0) { float* dst = kmean + ((size_t)((u.pm >> 5) * NH + (pn & 3) * 2 + bj) * 32 + (u.pm & 31)) * HD + wc * 32 + 8 * fq + 4 * n;
#pragma unroll
                        for (int e = 0; e < 4; ++e) atomicAdd(dst + e, sm[e] * (1.f / 256.f)); } }
        }
        bf16* base = O + (size_t)(pn >> 2) * ((size_t)NTOK * WQ) + (pn & 3) * 256;
        EPI_LOOP_BEGIN
            f32x4 v0 = acc[ai][bj][m][0], v1 = acc[ai][bj][m][1];
            if (rsc) { const float r = rsc[row]; v0 = v0 * r * *(const f32x4*)(csc + u.pn * BM + colt); v1 = v1 * r * *(const f32x4*)(csc + u.pn * BM + colt + 4); }
            *(u32x4*)(base + (size_t)row * WQ + colt) = pack8(v0, v1);
        EPI_LOOP_END
    }
};
struct EpiGates {
    static constexpr bool PERM = true, MIDHOOK = false;
    bf16* GD; bf16* R; const float* bias; const float* rsc; const float* csc;
    __device__ __forceinline__ void operator()(const f32x4 (&acc)[2][2][4][2], const Unit& u, int wr, int wc, int fr_, int fq_) const {
        const int fr = fr_ + opaque0(), fq = fq_ + opaque0();
        const int cl = wc * 32 + 8 * fq, col = u.pn * HALF + cl;
        const f32x4 cm0 = *(const f32x4*)(csc + u.pn * BM + cl), cm1 = *(const f32x4*)(csc + u.pn * BM + cl + 4), cd0 = *(const f32x4*)(csc + u.pn * BM + HALF + cl), cd1 = *(const f32x4*)(csc + u.pn * BM + HALF + cl + 4);
        const f32x4 bm0 = *(const f32x4*)(bias + col), bm1 = *(const f32x4*)(bias + col + 4), bd0 = *(const f32x4*)(bias + DM + col), bd1 = *(const f32x4*)(bias + DM + col + 4);
#pragma unroll
        for (int ai = 0; ai < 2; ++ai)
#pragma unroll
            for (int m = 0; m < 4; ++m) { const int row = u.pm * BM + ai * HALF + wr * 64 + m * 16 + fr; const float r = rsc[row];
                f32x4 am0 = acc[ai][0][m][0] * r * cm0 + bm0, am1 = acc[ai][0][m][1] * r * cm1 + bm1, ad0 = acc[ai][1][m][0] * r * cd0 + bd0, ad1 = acc[ai][1][m][1] * r * cd1 + bd1;
                f32x4 gd0, gd1, rr0, rr1;
#pragma unroll
                for (int e = 0; e < 4; ++e) { const float im0 = 1.f + __builtin_amdgcn_exp2f(-LOG2E * am0[e]), im1 = 1.f + __builtin_amdgcn_exp2f(-LOG2E * am1[e]);
                    const float id0 = 1.f + __builtin_amdgcn_exp2f(-LOG2E * ad0[e]), id1 = 1.f + __builtin_amdgcn_exp2f(-LOG2E * ad1[e]);
                    gd0[e] = __builtin_amdgcn_rcpf(id0); gd1[e] = __builtin_amdgcn_rcpf(id1); rr0[e] = id0 * __builtin_amdgcn_rcpf(im0); rr1[e] = id1 * __builtin_amdgcn_rcpf(im1); }
                *(u32x4*)(GD + (size_t)row * DM + col) = pack8(gd0, gd1); *(u32x4*)(R + (size_t)row * DM + col) = pack8(rr0, rr1); }
    }
};
template <bool ADD> struct EpiMix {
    static constexpr bool PERM = true, MIDHOOK = false;
    bf16* MIX; const bf16* G; int goff;
    __device__ __forceinline__ void operator()(const f32x4 (&acc)[2][2][4][2], const Unit& u, int wr, int wc, int fr_, int fq_) const {
        const int fr = fr_ + opaque0(), fq = fq_ + opaque0();
        EPI_LOOP_BEGIN
            const int col = u.pn * BM + colt;
            f32x4 g0, g1; unpack8(*(const u32x4*)(G + (size_t)row * NGATE + goff + col), g0, g1);
            f32x4 v0 = acc[ai][bj][m][0] * g0, v1 = acc[ai][bj][m][1] * g1;
            if (ADD) { f32x4 t0, t1; unpack8(*(const u32x4*)(MIX + (size_t)row * DM + col), t0, t1); v0 += t0; v1 += t1; }
            *(u32x4*)(MIX + (size_t)row * DM + col) = pack8(v0, v1);
        EPI_LOOP_END
    }
};
struct EpiMix2 {
    static constexpr bool PERM = true, MIDHOOK = true;
    bf16* MIX; const bf16* GD; const bf16* R; unsigned* mmax;
    __device__ __forceinline__ void mid(f32x4 (&acc)[2][2][4][2], const Unit& u, int wr, int wc, int fr_, int fq_) const {
        const int fr = fr_ + opaque0(), fq = fq_ + opaque0();
#pragma unroll
        for (int ai = 0; ai < 2; ++ai) {
            u32x4 rw[4][2];
#pragma unroll
            for (int m = 0; m < 4; ++m) { const int row = u.pm * BM + ai * HALF + wr * 64 + m * 16 + fr;
#pragma unroll
                for (int bj = 0; bj < 2; ++bj) rw[m][bj] = *(const u32x4*)(R + (size_t)row * DM + u.pn * BM + bj * HALF + wc * 32 + 8 * fq); }
#pragma unroll
            for (int m = 0; m < 4; ++m)
#pragma unroll
                for (int bj = 0; bj < 2; ++bj) { f32x4 r0, r1; unpack8(rw[m][bj], r0, r1); acc[ai][bj][m][0] *= r0; acc[ai][bj][m][1] *= r1; }
#pragma unroll
            for (int m = 0; m < 4; ++m) asm volatile("" : "+v"(acc[ai][0][m][0]), "+v"(acc[ai][0][m][1]), "+v"(acc[ai][1][m][0]), "+v"(acc[ai][1][m][1]) :: "memory");
        }
    }
    __device__ __forceinline__ void operator()(const f32x4 (&acc)[2][2][4][2], const Unit& u, int wr, int wc, int fr_, int fq_) const {
        const int fr = fr_ + opaque0(), fq = fq_ + opaque0();
#pragma unroll
        for (int ai = 0; ai < 2; ++ai)
#pragma unroll
            for (int m = 0; m < 4; ++m) { const int row = u.pm * BM + ai * HALF + wr * 64 + m * 16 + fr; float mx = 0.f;
#pragma unroll
                for (int bj = 0; bj < 2; ++bj) { const int col = u.pn * BM + bj * HALF + wc * 32 + 8 * fq;
                    f32x4 g0, g1; unpack8(*(const u32x4*)(GD + (size_t)row * DM + col), g0, g1);
                    const f32x4 v0 = acc[ai][bj][m][0] * g0, v1 = acc[ai][bj][m][1] * g1;
                    *(u32x4*)(MIX + (size_t)row * DM + col) = pack8(v0, v1);
#pragma unroll
                    for (int e = 0; e < 4; ++e) mx = fmaxf(mx, fmaxf(fabsf(v0[e]), fabsf(v1[e]))); }
                mx = fmaxf(mx, __shfl_xor(mx, 16)); mx = fmaxf(mx, __shfl_xor(mx, 32));
                if (fq == 0) __hip_atomic_fetch_max(mmax + row, __float_as_uint(mx), RLX_AGENT); }
    }
};
struct EpiResid {
    static constexpr bool PERM = true, MIDHOOK = false;
    const float* X; float* X1; const float* g2; unsigned* umax;
    const float* rsc; const float* csc;
    __device__ __forceinline__ void operator()(const f32x4 (&acc)[2][2][4][2], const Unit& u, int wr, int wc, int fr_, int fq_) const {
        const int fr = fr_ + opaque0(), fq = fq_ + opaque0();
        f32x4 gg[2][2];
#pragma unroll
        for (int bj = 0; bj < 2; ++bj) { const int c = u.pn * BM + bj * HALF + wc * 32 + 8 * fq; gg[bj][0] = *(const f32x4*)(g2 + c); gg[bj][1] = *(const f32x4*)(g2 + c + 4); }
#pragma unroll
        for (int ai = 0; ai < 2; ++ai)
#pragma unroll
            for (int m = 0; m < 4; ++m) { const int row = u.pm * BM + ai * HALF + wr * 64 + m * 16 + fr; float mx = 0.f;
#pragma unroll
                for (int bj = 0; bj < 2; ++bj) { const size_t o = (size_t)row * DM + u.pn * BM + bj * HALF + wc * 32 + 8 * fq;
                    const int colx = u.pn * BM + bj * HALF + wc * 32 + 8 * fq; const float rs_ = rsc[row];
                    const f32x4 v0 = *(const f32x4*)(X + o) + acc[ai][bj][m][0] * rs_ * *(const f32x4*)(csc + colx), v1 = *(const f32x4*)(X + o + 4) + acc[ai][bj][m][1] * rs_ * *(const f32x4*)(csc + colx + 4);
                    *(f32x4*)(X1 + o) = v0; *(f32x4*)(X1 + o + 4) = v1;
                    const f32x4 a0 = v0 * gg[bj][0], a1 = v1 * gg[bj][1];
#pragma unroll
                    for (int e = 0; e < 4; ++e) mx = fmaxf(mx, fmaxf(fabsf(a0[e]), fabsf(a1[e]))); }
                mx = fmaxf(mx, __shfl_xor(mx, 16)); mx = fmaxf(mx, __shfl_xor(mx, 32));
                if (fq == 0) __hip_atomic_fetch_max(umax + row, __float_as_uint(mx), RLX_AGENT); }
    }
};
struct EpiMoe1 {
    static constexpr bool PERM = true, MIDHOOK = false;
    bf16* H; const float* rms; const int* rowtok; const float* rsu; const float* csgu;
    __device__ __forceinline__ void operator()(const f32x4 (&acc)[2][2][4][2], const Unit& u, int wr, int wc, int fr_, int fq_) const {
        const int fr = fr_ + opaque0(), fq = fq_ + opaque0();
        const float* cg = csgu + (size_t)u.ex * 1024 + u.pn * BM + wc * 32 + 8 * fq;
        const f32x4 cg0 = *(const f32x4*)cg, cg1 = *(const f32x4*)(cg + 4), cu0 = *(const f32x4*)(cg + HALF), cu1 = *(const f32x4*)(cg + HALF + 4);
#pragma unroll
        for (int ai = 0; ai < 2; ++ai)
#pragma unroll
            for (int m = 0; m < 4; ++m) { const int row = u.pm * BM + ai * HALF + wr * 64 + m * 16 + fr; const int tok = rowtok[row]; const float rs = rms[tok] * rsu[tok];
                f32x4 o[2];
#pragma unroll
                for (int n = 0; n < 2; ++n)
#pragma unroll
                    for (int e = 0; e < 4; ++e) { const float gt = acc[ai][0][m][n][e] * rs * (n ? cg1[e] : cg0[e]), up = acc[ai][1][m][n][e] * rs * (n ? cu1[e] : cu0[e]);
                        o[n][e] = gt * __builtin_amdgcn_rcpf(1.f + __builtin_amdgcn_exp2f(-LOG2E * gt)) * up; }
                u32x2 h8; h8.x = pk_fp8x4(o[0][0] * H8_SCALE, o[0][1] * H8_SCALE, o[0][2] * H8_SCALE, o[0][3] * H8_SCALE); h8.y = pk_fp8x4(o[1][0] * H8_SCALE, o[1][1] * H8_SCALE, o[1][2] * H8_SCALE, o[1][3] * H8_SCALE);
                *(u32x2*)((unsigned char*)H + (size_t)row * DEXP + u.pn * HALF + wc * 32 + 8 * fq) = h8; }
    }
};
struct EpiMoe2 {
    static constexpr bool PERM = true, MIDHOOK = false;
    bf16* Y; const float* roww;
    __device__ __forceinline__ void operator()(const f32x4 (&acc)[2][2][4][2], const Unit& u, int wr, int wc, int fr_, int fq_) const {
        const int fr = fr_ + opaque0(), fq = fq_ + opaque0();
        EPI_LOOP_BEGIN
            const float w = roww[row] * (1.f / (H8_SCALE * WD8_SCALE));
            *(u32x4*)(Y + (size_t)row * DM + u.pn * BM + colt) = pack8(acc[ai][bj][m][0] * w, acc[ai][bj][m][1] * w);
        EPI_LOOP_END
    }
};
}

namespace att {
constexpr int SHM_K = 16384, SHM_V = 16384;
constexpr int L_V = 0, L_K = 2 * SHM_V;
constexpr int OST_STRIDE = 68, OST_WAVE = 32 * OST_STRIDE * 4;
constexpr int L_OST = 65536;
constexpr int L_TAB = 136 * 1024;
constexpr int L_SELPFX = 148 * 1024;
#define KSWZ(row, colB) ((row) * 256 + ((colB) ^ (((row) & 7) << 4)))
#define SBAR() __builtin_amdgcn_sched_barrier(0)
__device__ __forceinline__ int v_st(int k, int c) { const int kk = (k & ~0xC) | ((k & 4) << 1) | ((k & 8) >> 1); return ((kk >> 3) * 4 + (c >> 5)) * 512 + ((kk & 7) * 32 + (c & 31)) * 2; }
__device__ __forceinline__ int v_rd_base(int lane) { return ((lane & 3) << 3) | (((lane >> 2) & 3) << 6) | (((lane >> 4) & 1) << 5) | (((lane >> 5) & 1) << 8); }
constexpr int v_rd_off(int d0, int ks, int half) { return d0 * 512 + ks * 4096 + half * 2048; }
__device__ __forceinline__ int crow(int r, int hi) { return (r & 3) + 8 * (r >> 2) + 4 * hi; }

template <int KB>
__device__ __forceinline__ void qkt(f32x16& p0, f32x16& p1, const LAS char* K_lds, int r32, int hi, const bf16x8* qr, float bkc) {
#pragma unroll
    for (int r = 0; r < 16; ++r) { const float c_ = (float)((r & 3) + 8 * (r >> 2)); p0[r] = c_ * bkc; p1[r] = c_ * bkc; }
    const LAS char* kb[4];
#pragma unroll
    for (int dd = 0; dd < 4; ++dd) kb[dd] = K_lds + KB * SHM_K + KSWZ(r32, (dd * 16 + hi * 8) * 2);
#pragma unroll
    for (int d0 = 0; d0 < 8; ++d0) { const LAS char* a = kb[d0 & 3] + (d0 >> 2) * 128;
        bf16x8 b0 = *reinterpret_cast<const LAS bf16x8*>(a);
        bf16x8 b1 = *reinterpret_cast<const LAS bf16x8*>(a + 32 * 256);
        p0 = __builtin_amdgcn_mfma_f32_32x32x16_bf16(b0, qr[d0], p0, 0, 0, 0);
        p1 = __builtin_amdgcn_mfma_f32_32x32x16_bf16(b1, qr[d0], p1, 0, 0, 0); }
}
template <int VB>
__device__ __forceinline__ void pv_tile(f32x16* o, int vb0, bf16x8 pa0, bf16x8 pa1, bf16x8 pa2, bf16x8 pa3) {
#define TRRD(dst, off) asm volatile("ds_read_b64_tr_b16 %0, %1 offset:%2" : "=&v"(dst) : "v"(vb0), "i"(off) : "memory")
#define PV_D0(d0) do { s16x4 l0, l1, l2, l3, h0, h1, h2, h3; constexpr int b_ = VB * SHM_V + v_rd_off(d0, 0, 0); \
        TRRD(l0, b_); TRRD(h0, b_ + 2048); TRRD(l1, b_ + 4096); TRRD(h1, b_ + 6144); TRRD(l2, b_ + 8192); TRRD(h2, b_ + 10240); TRRD(l3, b_ + 12288); TRRD(h3, b_ + 14336); \
        asm volatile("s_waitcnt lgkmcnt(0)" ::: "memory"); SBAR(); \
        o[d0] = __builtin_amdgcn_mfma_f32_32x32x16_bf16((bf16x8){l0[0], l0[1], l0[2], l0[3], h0[0], h0[1], h0[2], h0[3]}, pa0, o[d0], 0, 0, 0); \
        o[d0] = __builtin_amdgcn_mfma_f32_32x32x16_bf16((bf16x8){l1[0], l1[1], l1[2], l1[3], h1[0], h1[1], h1[2], h1[3]}, pa1, o[d0], 0, 0, 0); \
        o[d0] = __builtin_amdgcn_mfma_f32_32x32x16_bf16((bf16x8){l2[0], l2[1], l2[2], l2[3], h2[0], h2[1], h2[2], h2[3]}, pa2, o[d0], 0, 0, 0); \
        o[d0] = __builtin_amdgcn_mfma_f32_32x32x16_bf16((bf16x8){l3[0], l3[1], l3[2], l3[3], h3[0], h3[1], h3[2], h3[3]}, pa3, o[d0], 0, 0, 0); } while (0)
    PV_D0(0); PV_D0(1); PV_D0(2); PV_D0(3);
#undef PV_D0
#undef TRRD
}

struct Parts { const bf16* pbase[3]; const float* plse[3]; const float* psc[3]; };
template <int NMERGE>
__device__ __forceinline__ void row_epilogue(f32x16 (&o)[4], float m_reg, float l_reg, int hi, bf16* dstb, long ro, float* lseb, float* scb, int li, int nparts, const Parts& P) {
    const bool ok = ro >= 0; const long rr = ok ? ro : 0; const int lj = ok ? li : 0;
    float M = (l_reg > 0.f) ? m_reg : -__builtin_inff();
    float L[3] = {-__builtin_inff(), -__builtin_inff(), -__builtin_inff()};
    if constexpr (NMERGE > 0) {
#pragma unroll
        for (int s = 0; s < NMERGE; ++s) if (s < nparts) { L[s] = P.plse[s][lj]; M = fmaxf(M, L[s]); }
    }
    const float f_own = (l_reg > 0.f) ? __builtin_amdgcn_exp2f(m_reg - M) : 0.f;
    float tot = l_reg * f_own; float fs[3] = {0.f, 0.f, 0.f};
    if constexpr (NMERGE > 0) {
#pragma unroll
        for (int s = 0; s < NMERGE; ++s) if (s < nparts) { fs[s] = (L[s] > -__builtin_inff()) ? __builtin_amdgcn_exp2f(L[s] - M) : 0.f; tot += fs[s]; }
    }
    const float inv = tot > 0.f ? 1.f / tot : 0.f, sc = f_own * inv;
    if (lseb != nullptr && ok && hi == 0) lseb[li] = (l_reg > 0.f) ? (m_reg + __builtin_log2f(l_reg)) : -__builtin_inff();
    if constexpr (NMERGE > 0) {
#pragma unroll
        for (int s = 0; s < NMERGE; ++s) fs[s] = (s < nparts) ? fs[s] * inv * P.psc[s][lj] : 0.f;
#pragma unroll
        for (int d0 = 0; d0 < 4; ++d0) {
#pragma unroll
            for (int r = 0; r < 16; ++r) o[d0][r] *= sc;
#pragma unroll
            for (int s = 0; s < NMERGE; ++s) if (s < nparts) { const float f = fs[s];
#pragma unroll
                for (int p = 0; p < 2; ++p) { const u32x2 w = *(const u32x2*)((const unsigned char*)P.pbase[s] + rr + 32 * d0 + 16 * p + 8 * hi);
                    auto q2 = __builtin_amdgcn_permlane32_swap(w.x, w.y, false, false);
#pragma unroll
                    for (int e = 0; e < 4; ++e) { o[d0][8 * p + e] += f * (float)(int)(signed char)((q2[0] >> (8 * e)) & 255u); o[d0][8 * p + 4 + e] += f * (float)(int)(signed char)((q2[1] >> (8 * e)) & 255u); } } }
#pragma unroll
            for (int p = 0; p < 2; ++p) {
                const unsigned ax = cvt_pk_bf16(o[d0][8 * p + 0], o[d0][8 * p + 1]), ay = cvt_pk_bf16(o[d0][8 * p + 2], o[d0][8 * p + 3]);
                const unsigned bx_ = cvt_pk_bf16(o[d0][8 * p + 4], o[d0][8 * p + 5]), by = cvt_pk_bf16(o[d0][8 * p + 6], o[d0][8 * p + 7]);
                auto r0 = __builtin_amdgcn_permlane32_swap(ax, bx_, false, false); auto r1 = __builtin_amdgcn_permlane32_swap(ay, by, false, false);
                const u32x4 w = {r0[0], r1[0], r0[1], r1[1]};
                if (ok) *(u32x4*)(dstb + rr + 32 * d0 + 16 * p + 8 * hi) = w;
            }
        }
    } else {
        float mx = 0.f;
#pragma unroll
        for (int d0 = 0; d0 < 4; ++d0)
#pragma unroll
            for (int r = 0; r < 16; ++r) { o[d0][r] *= sc; mx = fmaxf(mx, fabsf(o[d0][r])); }
        { auto rx = __builtin_amdgcn_permlane32_swap(__float_as_uint(mx), __float_as_uint(mx), false, false); mx = fmaxf(__uint_as_float(rx[0]), __uint_as_float(rx[1])); }
        const float qs = mx > 0.f ? 127.f / mx : 0.f;
        if (ok && hi == 0) scb[li] = mx * (1.f / 127.f);
#pragma unroll
        for (int d0 = 0; d0 < 4; ++d0)
#pragma unroll
            for (int p = 0; p < 2; ++p) {
                const unsigned a = pk_i8x4(o[d0][8 * p + 0] * qs, o[d0][8 * p + 1] * qs, o[d0][8 * p + 2] * qs, o[d0][8 * p + 3] * qs);
                const unsigned b = pk_i8x4(o[d0][8 * p + 4] * qs, o[d0][8 * p + 5] * qs, o[d0][8 * p + 6] * qs, o[d0][8 * p + 7] * qs);
                auto q2 = __builtin_amdgcn_permlane32_swap(a, b, false, false);
                const u32x2 w = {q2[0], q2[1]};
                if (ok) *(u32x2*)((unsigned char*)dstb + rr + 32 * d0 + 16 * p + 8 * hi) = w;
            }
    }
}
struct UD { const bf16* Q; const bf16* K; const bf16* V; int qoff, qpos, kp0, kst, t_lo, t_hi, w_lo, w_hi, W; float sl2; int ro, li, nparts; };
struct ND { const bf16* Q; const bf16* K; const bf16* V; int qoff, kp0, kst, t_lo; };
struct PF { bf16x8 qr[8]; bf16x8 k0, k1, v0, v1; };
__device__ __forceinline__ void attn_prefetch(const ND& d, PF& pf) {
    const int hi = lane_fresh() >> 5;
#pragma unroll
    for (int d0 = 0; d0 < 8; ++d0) pf.qr[d0] = *(const bf16x8*)(d.Q + d.qoff + d0 * 16 + hi * 8);
}
__device__ __forceinline__ void attn_prime(LAS char* lds, const ND& d, PF& pf) {
    const int tid = __builtin_amdgcn_readfirstlane((int)threadIdx.x >> 6) * 64 + lane_fresh(), sr = tid >> 4, sc = (tid & 15) * 8;
    const int p0_ = (d.kp0 + (64 * d.t_lo + sr) * d.kst) * WQ + sc, p1_ = p0_ + 32 * d.kst * WQ, p2_ = p0_ + 64 * d.kst * WQ, p3_ = p0_ + 96 * d.kst * WQ;
    const bf16x8 k0 = *(const bf16x8*)(d.K + p0_), k1 = *(const bf16x8*)(d.K + p1_), v0 = *(const bf16x8*)(d.V + p0_), v1 = *(const bf16x8*)(d.V + p1_);

    pf.k0 = *(const bf16x8*)(d.K + p2_); pf.k1 = *(const bf16x8*)(d.K + p3_); pf.v0 = *(const bf16x8*)(d.V + p2_); pf.v1 = *(const bf16x8*)(d.V + p3_);
    __syncthreads();
    *(LAS bf16x8*)(lds + L_K + KSWZ(sr, sc * 2)) = k0; *(LAS bf16x8*)(lds + L_K + KSWZ(sr, sc * 2) + 32 * 256) = k1;
    *(LAS bf16x8*)(lds + L_V + v_st(sr, sc)) = v0; *(LAS bf16x8*)(lds + L_V + v_st(32 + sr, sc)) = v1;
    __syncthreads();
}
template <int NMERGE, int MASKMODE>
__device__ __forceinline__ void attn_unit(LAS char* lds, const UD& d, bf16* dstb, float* lseb, float* scb, const Parts& P, PF& pf, bool has_next, const ND& nd) {
    const int lane = lane_fresh(), wid = __builtin_amdgcn_readfirstlane((int)threadIdx.x >> 6), tid = wid * 64 + lane, r32 = lane & 31, hi = lane >> 5;
    LAS char* V_lds = lds + L_V; LAS char* K_lds = lds + L_K;
    LAS float* tab = (LAS float*)(lds + L_TAB + wid * 1024);
    LAS float* al_l = tab; LAS float* li_l = tab + 32; LAS float* fac = tab + 96;
    const bf16* Kh = d.K; const bf16* Vh = d.V;
    const int kp0 = d.kp0, kst = d.kst, t_lo = d.t_lo, t_hi = d.t_hi, w_lo = d.w_lo, w_hi = d.w_hi, W = d.W, qpos = d.qpos, li = d.li, nparts = d.nparts;
    const float sl2 = d.sl2; const long ro = (long)d.ro;
    bf16x8 (&qr)[8] = pf.qr;
    float m_reg = -1e30f, l_reg = 0.f; f32x16 o[4] = {};
    const float qposf = (float)qpos, kstf = (float)kst;
    const float bk = sl2 * kstf, bkc = bk * (1.f / SM_C2), Wf = (float)W;
    const int qlo = __builtin_amdgcn_readfirstlane(qpos), qhi = qlo + 31 * kst;
    const int sr = tid >> 4, sc = (tid & 15) * 8, vst0 = v_st(sr, sc), vst1 = v_st(32 + sr, sc), kws = KSWZ(sr, sc * 2);
    const int vb0 = (int)(uintptr_t)V_lds + v_rd_base(lane);
    bf16x8 s0_k0, s0_k1, s0_v0, s0_v1;
    bf16x8 &s1_k0 = pf.k0, &s1_k1 = pf.k1, &s1_v0 = pf.v0, &s1_v1 = pf.v1;
#define A_LOAD2(SET, tt) do { const bool own_ = (tt) < t_hi; const bf16* Kp_ = own_ ? Kh : nd.K; const bf16* Vp_ = own_ ? Vh : nd.V; \
        const int kp_ = own_ ? kp0 : nd.kp0, ks_ = own_ ? kst : nd.kst, ti_ = own_ ? (tt) : (tt) - t_hi + nd.t_lo; \
        const int p0_ = (kp_ + (64 * ti_ + sr) * ks_) * WQ + sc, p1_ = p0_ + 32 * ks_ * WQ; \
        s##SET##_k0 = *(const bf16x8*)(Kp_ + p0_); s##SET##_k1 = *(const bf16x8*)(Kp_ + p1_); s##SET##_v0 = *(const bf16x8*)(Vp_ + p0_); s##SET##_v1 = *(const bf16x8*)(Vp_ + p1_); } while (0)
#define A_WRITE2(SET) do { *(LAS bf16x8*)(K_lds + (SET) * SHM_K + kws) = s##SET##_k0; *(LAS bf16x8*)(K_lds + (SET) * SHM_K + kws + 32 * 256) = s##SET##_k1; \
        *(LAS bf16x8*)(V_lds + (SET) * SHM_V + vst0) = s##SET##_v0; *(LAS bf16x8*)(V_lds + (SET) * SHM_V + vst1) = s##SET##_v1; } while (0)
#define A_STEP(KB, t) do { \
        if (KB == 0) A_LOAD2(0, (t) + 2); else A_LOAD2(1, (t) + 2);     \
        if ((t) >= w_lo && (t) <= w_hi) { \
            float bk_ = bk, bkc_ = bkc, kst_ = kstf; asm volatile("" : "+v"(bk_), "+v"(bkc_), "+v"(kst_));     \
            f32x16 p0, p1; SBAR(); qkt<KB>(p0, p1, K_lds, r32, hi, qr, bkc_); \
              \
            const float d0f = qposf - (float)(kp0 + (64 * (t) + 4 * hi) * kst); const float t0 = -sl2 * d0f, t1 = fmaf(32.f, bk_, t0); \
            bool needm = false; \
            if (MASKMODE != 0) { const int kfirst = kp0 + 64 * (t) * kst, klast = kfirst + 63 * kst; needm = !((qlo - klast >= 0) && (MASKMODE == 1 || qhi - kfirst <= W)); } \
            float pmax = -__builtin_inff(); \
            if (needm) { \
                _Pragma("unroll") for (int r = 0; r < 16; ++r) { const float c_ = (float)((r & 3) + 8 * (r >> 2)); \
                    const float a0 = fmaf(-c_, kst_, d0f), a1 = a0 - 32.f * kst_;        \
                    float z0 = fmaf(p0[r], SM_C2, t0), z1 = fmaf(p1[r], SM_C2, t1); \
                    const bool v0_ = (MASKMODE == 1) ? (a0 >= 0.f) : (__builtin_amdgcn_fmed3f(a0, 0.f, Wf) == a0), v1_ = (MASKMODE == 1) ? (a1 >= 0.f) : (__builtin_amdgcn_fmed3f(a1, 0.f, Wf) == a1); \
                    z0 = v0_ ? z0 : -__builtin_inff(); z1 = v1_ ? z1 : -__builtin_inff(); \
                    p0[r] = z0; p1[r] = z1; pmax = fmaxf(pmax, fmaxf(z0, z1)); } \
            } else { \
                _Pragma("unroll") for (int r = 0; r < 16; ++r) { const float z0 = fmaf(p0[r], SM_C2, t0), z1 = fmaf(p1[r], SM_C2, t1); p0[r] = z0; p1[r] = z1; pmax = fmaxf(pmax, fmaxf(z0, z1)); } \
            } \
            { auto rr = __builtin_amdgcn_permlane32_swap(__float_as_uint(pmax), __float_as_uint(pmax), false, false); pmax = fmaxf(__uint_as_float(rr[0]), __uint_as_float(rr[1])); } \
            float mn, alpha; \
            if (__all(pmax - m_reg <= 11.5f)) { mn = m_reg; alpha = 1.f; } \
            else { mn = fmaxf(m_reg, pmax); alpha = __builtin_amdgcn_exp2f(m_reg - mn); m_reg = mn; } \
            float ps = 0.f; \
            _Pragma("unroll") for (int r = 0; r < 16; ++r) { p0[r] = __builtin_amdgcn_exp2f(p0[r] - mn); p1[r] = __builtin_amdgcn_exp2f(p1[r] - mn); ps += p0[r] + p1[r]; } \
            { auto rr = __builtin_amdgcn_permlane32_swap(__float_as_uint(ps), __float_as_uint(ps), false, false); ps = __uint_as_float(rr[0]) + __uint_as_float(rr[1]); } \
            l_reg = l_reg * alpha + ps; \
            bf16x8 pa0, pa1, pa2, pa3; \
            A_PK4(p0, 0, pa0); A_PK4(p0, 8, pa1); A_PK4(p1, 0, pa2); A_PK4(p1, 8, pa3); \
            if (__any(alpha < 1.f)) { _Pragma("unroll") for (int d_ = 0; d_ < 4; ++d_) _Pragma("unroll") for (int r = 0; r < 16; ++r) o[d_][r] *= alpha; }     \
            SBAR(); pv_tile<KB>(o, vb0, pa0, pa1, pa2, pa3); \
        } \
        if (KB == 0) A_WRITE2(1); else A_WRITE2(0); \
        __syncthreads(); } while (0)
#define A_PK4(Pv, B_, OUT) do { unsigned a0 = cvt_pk_bf16(Pv[B_ + 0], Pv[B_ + 1]), a1 = cvt_pk_bf16(Pv[B_ + 2], Pv[B_ + 3]); \
        unsigned b0 = cvt_pk_bf16(Pv[B_ + 4], Pv[B_ + 5]), b1 = cvt_pk_bf16(Pv[B_ + 6], Pv[B_ + 7]); \
        auto r0 = __builtin_amdgcn_permlane32_swap(a0, b0, false, false); auto r1 = __builtin_amdgcn_permlane32_swap(a1, b1, false, false); \
        u32x4 w_ = {r0[0], r1[0], r0[1], r1[1]}; OUT = __builtin_bit_cast(bf16x8, w_); } while (0)
    for (int t = t_lo; t < t_hi; t += 2) {
        A_STEP(0, t);
        if (t + 1 < t_hi) A_STEP(1, t + 1);
    }
#undef A_STEP
#undef A_PK4
#undef A_LOAD2
#undef A_WRITE2
    if (has_next) attn_prefetch(nd, pf);
    row_epilogue<NMERGE>(o, m_reg, l_reg, hi, dstb, ro, lseb, scb, li, nparts, P);
}

__device__ __forceinline__ void attn_sel_chunks(LAS char* lds, int c0, int c1, const LAS int* pfx, const unsigned* cnts  , const unsigned* buck,
                                                const bf16* QM, const bf16* KM, const bf16* VM, bf16* PM, float* LM, float* SM) {
    const int lane = lane_fresh(), wid = __builtin_amdgcn_readfirstlane((int)threadIdx.x >> 6), tid = wid * 64 + lane, r32 = lane & 31, hi = lane >> 5;
    LAS char* V_lds = lds; LAS char* K_lds = lds + 65536;
    LAS float* tab = (LAS float*)(lds + L_TAB + wid * 1024);
    LAS float* al_l = tab; LAS float* fc_l = tab + 32; LAS int* ro_l = (LAS int*)(tab + 64);
    const int sr = tid >> 4, sc = (tid & 15) * 8, vst0 = v_st(sr, sc), vst1 = v_st(32 + sr, sc), kws = KSWZ(sr, sc * 2);
    const int vb0 = (int)(uintptr_t)V_lds + v_rd_base(lane);
    if (c0 >= c1) return;
    int bk = 0; { int klo = 0, khi = 1024; while (khi - klo > 1) { const int mid = (klo + khi) >> 1; if (pfx[mid] <= c0) klo = mid; else khi = mid; } bk = klo; }
    int cur_bk = -1;
#define S_QUERY(ch_, BK, E, QP, VALID, QF) do { int bk_ = (BK); while (pfx[bk_ + 1] <= (ch_)) ++bk_; (BK) = bk_; \
        const int chunk_ = (ch_) - pfx[bk_], bh_ = bk_ >> 5, j_ = bk_ & 31; \
        const int cnt_ = (int)__hip_atomic_load(cnts + 64 * bk_, RLX_AGENT); const int idx_ = chunk_ * 256 + wid * 32 + r32; \
        VALID = idx_ < cnt_; E = 0; if (VALID) E = buck[(size_t)bh_ * BUCK_PER_BH + buck_off(j_) + idx_]; \
        QP = VALID ? (int)(E & 0xffffu) : (j_ + 1) * 256; \
        const bf16* qrow_ = QM + ((bh_ >> 3) * SEQ) * WQ + (bh_ & 7) * HD + QP * WQ; \
        _Pragma("unroll") for (int d0 = 0; d0 < 8; ++d0) QF[d0] = *(const bf16x8*)(qrow_ + d0 * 16 + hi * 8); } while (0)
    bf16x8 qr[8], qn[8]; unsigned e = 0, en = 0; int qpos = 0, qposn = 0, bkn = bk; bool valid = false, validn = false;
    S_QUERY(c0, bkn, en, qposn, validn, qn);
#pragma unroll 1
    for (int ch = c0; ch < c1; ++ch) {
        while (pfx[bk + 1] <= ch) ++bk;
        const int bh = bk >> 5, j = bk & 31, b = bh >> 3, h = bh & 7;
        const int hb = (b * SEQ) * WQ + h * HD;
        e = en; qpos = qposn; valid = validn;
#pragma unroll
        for (int d0 = 0; d0 < 8; ++d0) qr[d0] = qn[d0];
        if (ch + 1 < c1) S_QUERY(ch + 1, bkn, en, qposn, validn, qn);
        if (bk != cur_bk) {
            cur_bk = bk;
            __syncthreads();
#pragma unroll
            for (int half = 0; half < 2; ++half) {
                bf16x8 k0[2], k1[2], v0[2], v1[2];
#pragma unroll
                for (int tt = 0; tt < 2; ++tt) { const int p0_ = hb + (j * 256 + 64 * (2 * half + tt) + sr) * WQ + sc, p1_ = p0_ + 32 * WQ;
                    k0[tt] = *(const bf16x8*)(KM + p0_); k1[tt] = *(const bf16x8*)(KM + p1_); v0[tt] = *(const bf16x8*)(VM + p0_); v1[tt] = *(const bf16x8*)(VM + p1_); }
#pragma unroll
                for (int tt = 0; tt < 2; ++tt) { const int T = 2 * half + tt;
                    *(LAS bf16x8*)(K_lds + T * SHM_K + kws) = k0[tt]; *(LAS bf16x8*)(K_lds + T * SHM_K + kws + 32 * 256) = k1[tt];
                    *(LAS bf16x8*)(V_lds + T * SHM_V + vst0) = v0[tt]; *(LAS bf16x8*)(V_lds + T * SHM_V + vst1) = v1[tt]; }
            }
            __syncthreads();
        }
        if (!__any(valid)) continue;
        const int slot = (int)(e >> 16);
        const float sl2 = __builtin_amdgcn_exp2f(-0.5f * (float)(2 * h + 1)) * LOG2E;
        const float bkc = sl2 * (1.f / SM_C2), qposf = (float)qpos;
        float m_reg = -1e30f, l_reg = 0.f; f32x16 o[4] = {};
#define S_TILE(KB) do { \
            float bkc_ = bkc; asm volatile("" : "+v"(bkc_)); \
            f32x16 p0, p1; SBAR(); qkt<KB>(p0, p1, K_lds, r32, hi, qr, bkc_); \
            const float t0 = -sl2 * (qposf - (float)(j * 256 + 64 * (KB) + 4 * hi)), t1 = fmaf(32.f, sl2, t0); \
            float pmax = -__builtin_inff(); \
            _Pragma("unroll") for (int r = 0; r < 16; ++r) { const float z0 = fmaf(p0[r], SM_C2, t0), z1 = fmaf(p1[r], SM_C2, t1); p0[r] = z0; p1[r] = z1; pmax = fmaxf(pmax, fmaxf(z0, z1)); } \
            { auto rr = __builtin_amdgcn_permlane32_swap(__float_as_uint(pmax), __float_as_uint(pmax), false, false); pmax = fmaxf(__uint_as_float(rr[0]), __uint_as_float(rr[1])); } \
            float mn, alpha; \
            if (__all(pmax - m_reg <= 11.5f)) { mn = m_reg; alpha = 1.f; } \
            else { mn = fmaxf(m_reg, pmax); alpha = __builtin_amdgcn_exp2f(m_reg - mn); m_reg = mn; } \
            float ps = 0.f; \
            _Pragma("unroll") for (int r = 0; r < 16; ++r) { p0[r] = __builtin_amdgcn_exp2f(p0[r] - mn); p1[r] = __builtin_amdgcn_exp2f(p1[r] - mn); ps += p0[r] + p1[r]; } \
            { auto rr = __builtin_amdgcn_permlane32_swap(__float_as_uint(ps), __float_as_uint(ps), false, false); ps = __uint_as_float(rr[0]) + __uint_as_float(rr[1]); } \
            l_reg = l_reg * alpha + ps; \
            bf16x8 pa0, pa1, pa2, pa3; \
            S_PK4(p0, 0, pa0); S_PK4(p0, 8, pa1); S_PK4(p1, 0, pa2); S_PK4(p1, 8, pa3); \
            if (__any(alpha < 1.f)) { _Pragma("unroll") for (int d_ = 0; d_ < 4; ++d_) _Pragma("unroll") for (int r = 0; r < 16; ++r) o[d_][r] *= alpha; } \
            SBAR(); pv_tile<KB>(o, vb0, pa0, pa1, pa2, pa3); } while (0)
#define S_PK4(Pv, B_, OUT) do { unsigned a0 = cvt_pk_bf16(Pv[B_ + 0], Pv[B_ + 1]), a1 = cvt_pk_bf16(Pv[B_ + 2], Pv[B_ + 3]); \
        unsigned b0 = cvt_pk_bf16(Pv[B_ + 4], Pv[B_ + 5]), b1 = cvt_pk_bf16(Pv[B_ + 6], Pv[B_ + 7]); \
        auto r0 = __builtin_amdgcn_permlane32_swap(a0, b0, false, false); auto r1 = __builtin_amdgcn_permlane32_swap(a1, b1, false, false); \
        u32x4 w_ = {r0[0], r1[0], r0[1], r1[1]}; OUT = __builtin_bit_cast(bf16x8, w_); } while (0)
        S_TILE(0); S_TILE(1); S_TILE(2); S_TILE(3);
#undef S_TILE
#undef S_PK4
        { const Parts nop{};
          row_epilogue<0>(o, m_reg, l_reg, hi, PM, valid ? (long)(slot * (NTOK * WQ) + hb + qpos * WQ) : -1L, LM, SM, slot * (NTOK * 8) + (b * SEQ + qpos) * 8 + h, 0, nop); }
    }
#undef S_QUERY
}
#undef SBAR
}

struct Args { const float* in[16]; float* out; unsigned char* ws; int ph_lo, ph_hi, dry, pad; };

__device__ __forceinline__ void transpose_item(const float* W, int N, int k0, int n0, bf16* WT, int ldk, long orow0, LAS float* scr, int lane) {
#pragma unroll 8
    for (int i = 0; i < 32; ++i) { const int kk = 2 * i + (lane >> 5); scr[kk * 33 + (lane & 31)] = W[(size_t)(k0 + kk) * N + n0 + (lane & 31)]; }
    LDS_WAIT(); asm volatile("" ::: "memory");
    const int c = lane & 7;
#pragma unroll
    for (int j = 0; j < 4; ++j) { const int n = (lane >> 3) + 8 * j; const LAS float* s = scr + (8 * c) * 33 + n;
        u32x4 o; o.x = cvt_pk_bf16(s[0 * 33], s[1 * 33]); o.y = cvt_pk_bf16(s[2 * 33], s[3 * 33]); o.z = cvt_pk_bf16(s[4 * 33], s[5 * 33]); o.w = cvt_pk_bf16(s[6 * 33], s[7 * 33]);
        *(u32x4*)(WT + (size_t)(orow0 + n) * ldk + k0 + 8 * c) = o; }
    LDS_WAIT(); asm volatile("" ::: "memory");
}

__device__ __forceinline__ void transpose_item_i8(const float* W, int N, int k0, int n0, unsigned char* WT, int ldk, long orow0, float cscale, LAS float* scr, int lane) {
#pragma unroll 8
    for (int i = 0; i < 32; ++i) { const int kk = 2 * i + (lane >> 5); scr[kk * 33 + (lane & 31)] = W[(size_t)(k0 + kk) * N + n0 + (lane & 31)] * cscale; }
    LDS_WAIT(); asm volatile("" ::: "memory");
    const int c = lane & 7;
#pragma unroll
    for (int j = 0; j < 4; ++j) { const int n = (lane >> 3) + 8 * j; const LAS float* s = scr + (8 * c) * 33 + n;
        u32x2 o; o.x = pk_i8x4(s[0 * 33], s[1 * 33], s[2 * 33], s[3 * 33]); o.y = pk_i8x4(s[4 * 33], s[5 * 33], s[6 * 33], s[7 * 33]);
        *(u32x2*)(WT + (size_t)(orow0 + n) * ldk + k0 + 8 * c) = o; }
    LDS_WAIT(); asm volatile("" ::: "memory");
}
__device__ __forceinline__ void transpose_regs_i8(const float (&v)[32], int k0, unsigned char* WT, int ldk, long orow0, float cscale, LAS float* scr, int lane) {
#pragma unroll
    for (int i = 0; i < 32; ++i) scr[(2 * i + (lane >> 5)) * 33 + (lane & 31)] = v[i] * cscale;
    LDS_WAIT(); asm volatile("" ::: "memory");
    const int c = lane & 7;
#pragma unroll
    for (int j = 0; j < 4; ++j) { const int n = (lane >> 3) + 8 * j; const LAS float* s = scr + (8 * c) * 33 + n;
        u32x2 o; o.x = pk_i8x4(s[0 * 33], s[1 * 33], s[2 * 33], s[3 * 33]); o.y = pk_i8x4(s[4 * 33], s[5 * 33], s[6 * 33], s[7 * 33]);
        *(u32x2*)(WT + (size_t)(orow0 + n) * ldk + k0 + 8 * c) = o; }
    LDS_WAIT(); asm volatile("" ::: "memory");
}
__device__ __forceinline__ void transpose_item_fp8(const float* W, int N, int k0, int n0, unsigned char* WT, int ldk, long orow0, float scale, LAS float* scr, int lane) {
#pragma unroll 8
    for (int i = 0; i < 32; ++i) { const int kk = 2 * i + (lane >> 5); scr[kk * 33 + (lane & 31)] = W[(size_t)(k0 + kk) * N + n0 + (lane & 31)] * scale; }
    LDS_WAIT(); asm volatile("" ::: "memory");
    const int c = lane & 7;
#pragma unroll
    for (int j = 0; j < 4; ++j) { const int n = (lane >> 3) + 8 * j; const LAS float* s = scr + (8 * c) * 33 + n;
        u32x2 o; o.x = pk_fp8x4(s[0 * 33], s[1 * 33], s[2 * 33], s[3 * 33]); o.y = pk_fp8x4(s[4 * 33], s[5 * 33], s[6 * 33], s[7 * 33]);
        *(u32x2*)(WT + (size_t)(orow0 + n) * ldk + k0 + 8 * c) = o; }
    LDS_WAIT(); asm volatile("" ::: "memory");
}

__global__ void __launch_bounds__(NWAVES * 64, 2) mk_fwd(Args args) {
    extern __shared__ __attribute__((aligned(16))) unsigned char lds_raw[];
    LAS unsigned char* lds = (LAS unsigned char*)lds_raw;
    volatile LAS unsigned* MISC = (volatile LAS unsigned*)(lds + MISC_OFF);
    const int wave = __builtin_amdgcn_readfirstlane((int)threadIdx.x >> 6);
#define PHASE_IDS const int lane = lane_fresh(), tid = wave * 64 + lane; (void)tid; (void)lane
    PHASE_IDS;
    const int G = gridDim.x, bx = blockIdx.x;
    const int vcu = (G % 8 == 0) ? (bx % 8) * (G / 8) + bx / 8 : bx;
    unsigned char* ws = args.ws;
    gu32* ctl = (gu32*)(ws + WS_CTL);
    for (int u = tid; u < (LDS_BYTES - RING_BYTES) / 4; u += NWAVES * 64) ((LAS unsigned*)(lds + RING_BYTES))[u] = 0u;
    __syncthreads();
    XcdBarrier bar; bar.bar = (unsigned*)ctl + CW_BAR; bar.x = 0; bar.st = nullptr;
    if (MK_N_LAUNCHES == 1 && !MK_DEBUG) bar = xcd_barrier_post((unsigned*)ctl + CW_BAR, MISC + 8);
    const int lo = args.ph_lo, hi_ph = args.ph_hi;
#define IN(k) (lo <= (k) && (k) < hi_ph)
#define SEAM(k) do { if (IN(k) && IN((k) + 1)) xcd_barrier(bar); } while (0)
    const int gw = vcu * NWAVES + wave, NGW = G * NWAVES;

    const float* x = args.in[0];
    bf16* Hb = (bf16*)(ws + WS_H);
    bf16* QM = (bf16*)(ws + WS_QM); bf16* KM = (bf16*)(ws + WS_KM); bf16* VM = (bf16*)(ws + WS_VM);
    bf16* QD = (bf16*)(ws + WS_QD); bf16* KD = (bf16*)(ws + WS_KD); bf16* VD = (bf16*)(ws + WS_VD);
    bf16* PM = (bf16*)(ws + WS_PM); bf16* PD = (bf16*)(ws + WS_PD);
    float* LM = (float*)(ws + WS_LM); float* LD = (float*)(ws + WS_LD); float* SM = (float*)(ws + WS_SM); float* SD = (float*)(ws + WS_SD);
    float* kmean = (float*)(ws + WS_KMEAN);
    unsigned* buck = (unsigned*)(ws + WS_BUCK);
    bf16* GATES = (bf16*)(ws + WS_GATES); bf16* MIX = (bf16*)(ws + WS_MIX); bf16* GINV = (bf16*)(ws + WS_GINV);
    float* X1 = (float*)(ws + WS_X1);
    int* EID = (int*)(ws + WS_EID); float* EW = (float*)(ws + WS_EW); float* RMS = (float*)(ws + WS_RMS); int* POS = (int*)(ws + WS_POS);
    int* ROWTOK = (int*)(ws + WS_ROWTOK); float* ROWW = (float*)(ws + WS_ROWW);
    bf16* WR = (bf16*)(ws + WS_WR);

    if (IN(0)) {
        PHASE_IDS;
        LAS float* scr = (LAS float*)(lds + wave * 16384);
        constexpr int I_IN = 32 * 320, I_OM = 16 * 64, I_O = 32 * 64;
        constexpr int NIT = I_IN + 2 * I_OM; (void)I_O;
        for (int it = gw; it < NIT; it += NGW) {
            int r = it;
            if (r < I_IN) { const int kb = r / 320, nb = r % 320;
                if (32 * nb < NBF) transpose_item(args.in[2], 10240, 64 * kb, 32 * nb, (bf16*)(ws + WS_WIN), 2048, 32 * nb, scr, lane);
                continue; } r -= I_IN;
            if (r < I_OM) { const int kb = r / 64, nb = r % 64; transpose_item(args.in[4], 2048, 64 * kb, 32 * nb, (bf16*)(ws + WS_WOM), 2048, 32 * nb, scr, lane); continue; } r -= I_OM;
            if (r < I_OM) { const int kb = r / 64, nb = r % 64; transpose_item(args.in[5], 2048, 64 * kb, 32 * nb, (bf16*)(ws + WS_WOM) + 1024, 2048, 32 * nb, scr, lane); continue; } r -= I_OM;
            (void)r;
        }
        {
            LAS float* cmax = (LAS float*)(lds + 136 * 1024);
            float* colsc = (float*)(ws + WS_CS8);
            constexpr int NG_IN = (10240 - NBF) / 32, NG_WO = 2048 / 32;
            for (int grp = vcu; grp < NG_IN + NG_WO; grp += G) {
                const bool is_wo = grp >= NG_IN;
                const int lane = lane_fresh();
                const float* Wsrc = is_wo ? args.in[6] : args.in[2]; const int Nsrc = is_wo ? 2048 : 10240;
                const int n0 = is_wo ? 32 * (grp - NG_IN) : NBF + 32 * grp;
                float mx = 0.f;
                float vv[4][32];
#pragma unroll
                for (int q4 = 0; q4 < 4; ++q4) { const int kb = wave * 4 + q4;
#pragma unroll
                    for (int i = 0; i < 32; ++i) vv[q4][i] = Wsrc[(size_t)(64 * kb + 2 * i + (lane >> 5)) * Nsrc + n0 + (lane & 31)]; }
#pragma unroll
                for (int q4 = 0; q4 < 4; ++q4)
#pragma unroll
                    for (int i = 0; i < 32; ++i) mx = fmaxf(mx, fabsf(vv[q4][i]));
                mx = fmaxf(mx, __shfl_xor(mx, 32));
                __syncthreads();
                if (lane < 32) cmax[wave * 32 + lane] = mx;
                __syncthreads();
                float cm = 0.f;
#pragma unroll
                for (int w8 = 0; w8 < 8; ++w8) cm = fmaxf(cm, cmax[w8 * 32 + (lane & 31)]);
                int drow = is_wo ? n0 : n0 - NBF;
                if (!is_wo && n0 >= NQKV) { const int c = n0 - NQKV, which = c >> 11, cc = c & 2047; drow = (NQKV - NBF) + (cc >> 7) * 256 + which * 128 + (cc & 127); }
                if (wave == 0 && lane < 32) (is_wo ? (float*)(ws + WS_CSWO) : colsc)[drow + lane] = cm * (1.f / 127.f);
                const float cscale = cm > 0.f ? 127.f / cm : 0.f;
#pragma unroll
                for (int q4 = 0; q4 < 4; ++q4) transpose_regs_i8(vv[q4], 64 * (wave * 4 + q4), is_wo ? ws + WS_WO : ws + WS_WIN8, 2048, drow, cscale, scr, lane);
            }
        }
        for (int i = (bx * NWAVES * 64 + tid); i < 64 * 2048; i += G * NWAVES * 64) {
            const int row = i >> 11, k = i & 2047;
            float w = 0.f;
            if (row < 32) w = args.in[10][(size_t)k * 32 + row]; else if (row < 36) w = args.in[8][(size_t)k * 4 + (row - 32)];
            const unsigned h = cvt_pk_bf16(w, 0.f) & 0xffffu; const float lo_f = w - bf_lo(h);
            WR[i] = (bf16)h; WR[64 * 2048 + i] = (bf16)(cvt_pk_bf16(lo_f, 0.f) & 0xffffu);
        }
        const float* g1 = args.in[1];
        for (int m = gw; m < NTOK; m += NGW) {
            const float* xr = x + (size_t)m * DM;
            f32x4 v[8]; float s = 0.f;
#pragma unroll
            for (int j = 0; j < 4; ++j) { v[2 * j] = *(const f32x4*)(xr + j * 512 + lane * 8); v[2 * j + 1] = *(const f32x4*)(xr + j * 512 + lane * 8 + 4); }
#pragma unroll
            for (int j = 0; j < 8; ++j) s += (v[j].x * v[j].x + v[j].y * v[j].y) + (v[j].z * v[j].z + v[j].w * v[j].w);
            const float rs = 1.0f / sqrtf(wave_sum(s) * (1.f / DM) + RMS_EPS);
            float amax = 0.f;
#pragma unroll
            for (int j = 0; j < 4; ++j) { const f32x4 ga = *(const f32x4*)(g1 + j * 512 + lane * 8), gb = *(const f32x4*)(g1 + j * 512 + lane * 8 + 4);
                v[2 * j] = v[2 * j] * rs * ga; v[2 * j + 1] = v[2 * j + 1] * rs * gb;
                if (NBF > 0) *(u32x4*)(Hb + (size_t)m * DM + j * 512 + lane * 8) = pg8::pack8(v[2 * j], v[2 * j + 1]);
#pragma unroll
                for (int e = 0; e < 4; ++e) amax = fmaxf(amax, fmaxf(fabsf(v[2 * j][e]), fabsf(v[2 * j + 1][e]))); }
#pragma unroll
            for (int o = 1; o < 64; o <<= 1) amax = fmaxf(amax, __shfl_xor(amax, o));
            const float qs = amax > 0.f ? 127.f / amax : 0.f;
            if (lane == 0) ((float*)(ws + WS_RS8))[m] = amax * (1.f / 127.f);
#pragma unroll
            for (int j = 0; j < 4; ++j) { const f32x4 ha = v[2 * j] * qs, hb4 = v[2 * j + 1] * qs;
                u32x2 h8; h8.x = pk_i8x4(ha.x, ha.y, ha.z, ha.w); h8.y = pk_i8x4(hb4.x, hb4.y, hb4.z, hb4.w);
                *(u32x2*)(ws + WS_H8 + (size_t)m * DM + j * 512 + lane * 8) = h8; }
        }
    }
    if (IN(0) && IN(1)) xcd_barrier(bar);

    if (IN(1)) {
        { pg8::Gemm g{Hb, (const bf16*)(ws + WS_WIN), DM, nullptr, DM, Hb, 1 << 30}; pg8::StaticOrder S; S.init(NTOK, NBF, G, bx);
          pg8::EpiQKV E{QM, 0, nullptr, nullptr, nullptr};
          pg8::gemm_phase<pg8::EpiQKV, pg8::StaticOrder, true>(lds, g, S, E); }
        { pg8::Gemm g{(const bf16*)(ws + WS_H8), (const bf16*)(ws + WS_WIN8), DM / 2, nullptr, DM / 2, (const bf16*)(ws + WS_H8), 1 << 30}; pg8::StaticOrder S; S.init(NTOK, NQKV - NBF, G, bx);
          pg8::EpiQKV E{QM, NBF / 256, (const float*)(ws + WS_RS8), (const float*)(ws + WS_CS8), kmean};
          pg8::gemm_phase<pg8::EpiQKV, pg8::StaticOrder, true, false, QIN>(lds, g, S, E); }
    }
    if (IN(1) && IN(3)) xcd_barrier(bar);


    if (IN(3)) {
        PHASE_IDS;
        LAS int* hist = (LAS int*)lds;
        const int r32 = lane & 31, hi = lane >> 5;
        for (int u = bx; u < NB * NH * 32; u += G) {
            const int b = u >> 8, h = (u >> 5) & 7, qb = u & 31;
            if (qb == 0) continue;
            __syncthreads();
            if (tid < 64) hist[tid] = 0;
            __syncthreads();
            const int tq = qb * 256 + wave * 32 + r32;
            const bf16* qrow = QM + (size_t)(b * SEQ + tq) * WQ + h * HD;
            const float* km = kmean + (size_t)((b * NH + h) * 32 + r32) * HD;
            f32x16 acc = {};
#pragma unroll
            for (int s = 0; s < 8; ++s) {
                const bf16x8 qf = *(const bf16x8*)(qrow + s * 16 + hi * 8);
                const f32x4 ka = *(const f32x4*)(km + s * 16 + hi * 8), kb2 = *(const f32x4*)(km + s * 16 + hi * 8 + 4);
                const u32x4 kh = pg8::pack8(ka, kb2);
                f32x4 ha, hb; pg8::unpack8(kh, ha, hb);
                const u32x4 kl = pg8::pack8(ka - ha, kb2 - hb);
                acc = __builtin_amdgcn_mfma_f32_32x32x16_bf16(__builtin_bit_cast(bf16x8, kh), qf, acc, 0, 0, 0);
                acc = __builtin_amdgcn_mfma_f32_32x32x16_bf16(__builtin_bit_cast(bf16x8, kl), qf, acc, 0, 0, 0);
            }
            float t0 = -__builtin_inff(), t1 = t0, t2 = t0; int i0 = 64, i1 = 64, i2 = 64;
#define INS3(v_, j_) do { const float _iv = (v_); const int _ij = (j_); \
                if (_iv > t0 || (_iv == t0 && _ij < i0)) { t2 = t1; i2 = i1; t1 = t0; i1 = i0; t0 = _iv; i0 = _ij; } \
                else if (_iv > t1 || (_iv == t1 && _ij < i1)) { t2 = t1; i2 = i1; t1 = _iv; i1 = _ij; } \
                else if (_iv > t2 || (_iv == t2 && _ij < i2)) { t2 = _iv; i2 = _ij; } } while (0)
#pragma unroll
            for (int r = 0; r < 16; ++r) { const int j = att::crow(r, hi); const float v = (j < qb) ? acc[r] : -__builtin_inff(); INS3(v, j); }
            { const float o0 = __shfl_xor(t0, 32), o1 = __shfl_xor(t1, 32), o2 = __shfl_xor(t2, 32); const int j0 = __shfl_xor(i0, 32), j1 = __shfl_xor(i1, 32), j2 = __shfl_xor(i2, 32);
              INS3(o0, j0); INS3(o1, j1); INS3(o2, j2); }
#undef INS3
            int rk0 = 0, rk1 = 0, rk2 = 0;
            const bool v0 = t0 > -__builtin_inff() && i0 < qb, v1 = t1 > -__builtin_inff() && i1 < qb, v2 = t2 > -__builtin_inff() && i2 < qb;
            if (hi == 0) {
                if (v0) rk0 = __hip_atomic_fetch_add(&hist[i0], 1, __ATOMIC_RELAXED, __HIP_MEMORY_SCOPE_WORKGROUP);
                if (v1) rk1 = __hip_atomic_fetch_add(&hist[i1], 1, __ATOMIC_RELAXED, __HIP_MEMORY_SCOPE_WORKGROUP);
                if (v2) rk2 = __hip_atomic_fetch_add(&hist[i2], 1, __ATOMIC_RELAXED, __HIP_MEMORY_SCOPE_WORKGROUP);
            }
            __syncthreads();
            if (tid < 32 && hist[tid] > 0) hist[32 + tid] = (int)__hip_atomic_fetch_add((unsigned*)ctl + CW_BCNT + 64 * (((b * NH + h) << 5) + tid), (unsigned)hist[tid], RLX_AGENT);
            __syncthreads();
            if (hi == 0) {
                unsigned* bb = buck + (size_t)(b * NH + h) * BUCK_PER_BH;
                if (v0) bb[buck_off(i0) + hist[32 + i0] + rk0] = (unsigned)tq | (0u << 16);
                if (v1) bb[buck_off(i1) + hist[32 + i1] + rk1] = (unsigned)tq | (1u << 16);
                if (v2) bb[buck_off(i2) + hist[32 + i2] + rk2] = (unsigned)tq | (2u << 16);
            }
        }
    }
    SEAM(3);

    if (IN(4)) {
        PHASE_IDS;
        LAS int* pfx = (LAS int*)(lds + att::L_SELPFX);
        __syncthreads();
        for (int k = tid; k < 1024; k += NWAVES * 64) { const unsigned c = __hip_atomic_load((unsigned*)ctl + CW_BCNT + 64 * k, RLX_AGENT); pfx[k + 1] = (int)((c + 255u) >> 8); }
        if (tid == 0) pfx[0] = 0;
        __syncthreads();
        if (tid == 0) { int s = 0; for (int k = 1; k <= 1024; ++k) { s += pfx[k]; pfx[k] = s; } }
        __syncthreads();
        const int nsel = pfx[1024];
        constexpr int NDIL = 2 * 1024;
        const int total = nsel + NDIL;
        att::Parts noparts{};
        const int r32 = lane & 31;
#define DECODE4(u_, D) do { const int uu = (u_); \
            if (uu < NDIL) {     \
                const int p = uu >> 10, v = uu & 1023, bh = v >> 5, w5 = v & 31; \
                const int dd = p ? 4 : 1, res = p ? (w5 >> 3) : 0, l0 = p ? (w5 & 7) * 256 : w5 * 256, b = bh >> 3, h = bh & 7; \
                const int hb = (b * SEQ) * WQ + h * HD; \
                D.Q = QD + hb; D.K = KD + hb; D.V = VD + hb; D.qpos = (l0 + wave * 32 + r32) * dd + res; D.qoff = D.qpos * WQ; \
                D.kp0 = (l0 - 128) * dd + res; D.kst = dd; D.t_lo = l0 == 0 ? 2 : 0; D.t_hi = 6; D.w_lo = wave >> 1; D.w_hi = (wave >> 1) + 2; D.W = 128 * dd; \
                D.sl2 = __builtin_amdgcn_exp2f(-(float)(h + 1)) * LOG2E; \
                D.ro = p * (NTOK * WQ) + hb + D.qpos * WQ; D.li = p * (NTOK * 8) + (b * SEQ + D.qpos) * 8 + h; D.nparts = 0; \
            } else {             \
                const int su = uu - NDIL; int klo = 0, khi = 1024; \
                while (khi - klo > 1) { const int mid = (klo + khi) >> 1; if (pfx[mid] <= su) klo = mid; else khi = mid; } \
                const int bk = klo, chunk = su - pfx[bk], bh = bk >> 5, j = bk & 31, b = bh >> 3, h = bh & 7; \
                const int cnt = (int)__hip_atomic_load((unsigned*)ctl + CW_BCNT + 64 * bk, RLX_AGENT); \
                const int idx = chunk * 256 + wave * 32 + r32; const bool valid = idx < cnt; \
                unsigned e = 0; if (valid) e = buck[(size_t)bh * BUCK_PER_BH + buck_off(j) + idx]; \
                const int slot = (int)(e >> 16), hb = (b * SEQ) * WQ + h * HD; \
                D.Q = QM + hb; D.K = KM + hb; D.V = VM + hb; D.qpos = valid ? (int)(e & 0xffffu) : (j + 1) * 256; D.qoff = D.qpos * WQ; \
                D.kp0 = j * 256; D.kst = 1; D.t_lo = 0; D.t_hi = 4; D.w_lo = 0; D.w_hi = 3; D.W = 1 << 20; \
                D.sl2 = __builtin_amdgcn_exp2f(-0.5f * (float)(2 * h + 1)) * LOG2E; \
                D.ro = valid ? slot * (NTOK * WQ) + hb + D.qpos * WQ : -1; D.li = slot * (NTOK * 8) + (b * SEQ + D.qpos) * 8 + h; D.nparts = 0; \
            } } while (0)
        att::UD cur; att::ND nd; att::PF pf;
#define TO_ND(D, N) do { N.Q = D.Q; N.K = D.K; N.V = D.V; N.qoff = D.qoff; N.kp0 = D.kp0; N.kst = D.kst; N.t_lo = D.t_lo; } while (0)
        if (bx < NDIL) { DECODE4(bx, cur); TO_ND(cur, nd); att::attn_prefetch(nd, pf); att::attn_prime((LAS char*)lds, nd, pf); }
        for (int u = bx; u < NDIL; u += G) {
            const bool has_next = u + G < NDIL;
            { att::UD tmp; DECODE4(has_next ? u + G : u, tmp); TO_ND(tmp, nd); }
            DECODE4(u, cur);
            att::attn_unit<0, 2>((LAS char*)lds, cur, PD, LD, SD, noparts, pf, has_next, nd);
        }
#undef DECODE4
        { const int c0 = (int)(((long)nsel * bx) / G), c1 = (int)(((long)nsel * (bx + 1)) / G);
          att::attn_sel_chunks((LAS char*)lds, c0, c1, pfx, (const unsigned*)ctl + CW_BCNT, buck, QM, KM, VM, PM, LM, SM); }
    }
    SEAM(4);
    if (IN(5)) {
        PHASE_IDS;
        const int r32 = lane & 31;
        att::Parts PMp, PDp;
#pragma unroll
        for (int s3 = 0; s3 < 3; ++s3) { PMp.pbase[s3] = (const bf16*)((const unsigned char*)PM + (size_t)s3 * NTOK * WQ); PMp.plse[s3] = LM + (size_t)s3 * NTOK * 8; PMp.psc[s3] = SM + (size_t)s3 * NTOK * 8;
            PDp.pbase[s3] = (const bf16*)((const unsigned char*)PD + (size_t)(s3 < 2 ? s3 : 0) * NTOK * WQ); PDp.plse[s3] = LD + (size_t)(s3 < 2 ? s3 : 0) * NTOK * 8; PDp.psc[s3] = SD + (size_t)(s3 < 2 ? s3 : 0) * NTOK * 8; }
#define DECODE5(u_, D) do { const int uu = (u_); \
            if (uu < 1024) {     \
                const int bh = uu >> 5, qb = uu & 31, b = bh >> 3, h = bh & 7, hb = (b * SEQ) * WQ + h * HD; \
                D.Q = QM + hb; D.K = KM + hb; D.V = VM + hb; D.qpos = qb * 256 + wave * 32 + r32; D.qoff = D.qpos * WQ; \
                D.kp0 = qb * 256; D.kst = 1; D.t_lo = 0; D.t_hi = 4; D.w_lo = 0; D.w_hi = wave >> 1; D.W = 1 << 20; \
                D.sl2 = __builtin_amdgcn_exp2f(-0.5f * (float)(2 * h + 1)) * LOG2E; \
                D.ro = hb + D.qpos * WQ; D.li = (b * SEQ + D.qpos) * 8 + h; D.nparts = qb < 3 ? qb : 3; \
            } else {             \
                const int v = uu - 1024, bh = v >> 5, w5 = v & 31, res = w5 >> 1, l0 = (w5 & 1) * 256, b = bh >> 3, h = bh & 7, hb = (b * SEQ) * WQ + h * HD; \
                D.Q = QD + hb; D.K = KD + hb; D.V = VD + hb; D.qpos = (l0 + wave * 32 + r32) * 16 + res; D.qoff = D.qpos * WQ; \
                D.kp0 = (l0 - 128) * 16 + res; D.kst = 16; D.t_lo = l0 == 0 ? 2 : 0; D.t_hi = 6; D.w_lo = wave >> 1; D.w_hi = (wave >> 1) + 2; D.W = 128 * 16; \
                D.sl2 = __builtin_amdgcn_exp2f(-(float)(h + 1)) * LOG2E; \
                D.ro = hb + D.qpos * WQ; D.li = (b * SEQ + D.qpos) * 8 + h; D.nparts = 2; \
            } } while (0)
        att::UD cur; att::ND nd; att::PF pf;
        if (bx < 2048) { DECODE5(bx, cur); TO_ND(cur, nd); att::attn_prefetch(nd, pf); att::attn_prime((LAS char*)lds, nd, pf); }
        for (int u = bx; u < 2048; u += G) {
            const bool has_next = u + G < 2048;
            { att::UD tmp; DECODE5(has_next ? u + G : u, tmp); TO_ND(tmp, nd); }
            DECODE5(u, cur);
            if (u < 1024) att::attn_unit<3, 1>((LAS char*)lds, cur, MK_DEBUG ? Hb : QM, nullptr, nullptr, PMp, pf, has_next, nd);
            else att::attn_unit<2, 2>((LAS char*)lds, cur, MK_DEBUG ? Hb + (size_t)NTOK * WQ : QD, nullptr, nullptr, PDp, pf, has_next, nd);
        }
#undef DECODE5
#undef TO_ND
    }
    SEAM(5);

    if (IN(6)) {
        pg8::Gemm g{(const bf16*)(ws + WS_H8), (const bf16*)(ws + WS_WIN8 + (size_t)(NQKV - NBF) * DM), DM / 2, nullptr, DM / 2, (const bf16*)(ws + WS_H8), 1 << 30}; pg8::StaticOrder S; S.init(NTOK, NGATE, G, bx);
        pg8::EpiGates E{GATES, GATES + (size_t)NTOK * DM, args.in[3], (const float*)(ws + WS_RS8), (const float*)(ws + WS_CS8) + (NQKV - NBF)};
        pg8::gemm_phase<pg8::EpiGates, pg8::StaticOrder, true, false, QIN>(lds, g, S, E);
    }
    SEAM(6);
    if (IN(7)) {
        pg8::Gemm g{QM, (const bf16*)(ws + WS_WOM), DM, nullptr, WQ, QD, 16}; pg8::StaticOrder S; S.init(NTOK, DM, G, bx);
        pg8::EpiMix2 E{MIX, GATES, GATES + (size_t)NTOK * DM, (unsigned*)ctl + CW_MMAX};
        pg8::gemm_phase<pg8::EpiMix2, pg8::StaticOrder, true>(lds, g, S, E);
    }
    SEAM(7);
    if (IN(8)) {
        PHASE_IDS;
        unsigned char* M8 = ws + WS_MIX8; float* rsm = (float*)(ws + WS_RSM);
        for (int m = gw; m < NTOK; m += NGW) {
            const float mx = __uint_as_float(__hip_atomic_load((unsigned*)ctl + CW_MMAX + m, RLX_AGENT));
            const float qs = mx > 0.f ? 127.f / mx : 0.f;
            if (lane == 0) rsm[m] = mx * (1.f / 127.f);
#pragma unroll
            for (int j = 0; j < 4; ++j) { f32x4 a, b; pg8::unpack8(*(const u32x4*)(MIX + (size_t)m * DM + j * 512 + lane * 8), a, b);
                u32x2 q; q.x = pk_i8x4(a.x * qs, a.y * qs, a.z * qs, a.w * qs); q.y = pk_i8x4(b.x * qs, b.y * qs, b.z * qs, b.w * qs);
                *(u32x2*)(M8 + (size_t)m * DM + j * 512 + lane * 8) = q; }
        }
    }
    SEAM(8);
    if (IN(9)) {
        pg8::Gemm g{(const bf16*)(ws + WS_MIX8), (const bf16*)(ws + WS_WO), DM / 2, nullptr, DM / 2, (const bf16*)(ws + WS_MIX8), 1 << 30}; pg8::StaticOrder S; S.init(NTOK, DM, G, bx);
        pg8::EpiResid E{x, X1, args.in[7], (unsigned*)ctl + CW_UMAX, (const float*)(ws + WS_RSM), (const float*)(ws + WS_CSWO)};
        pg8::gemm_phase<pg8::EpiResid, pg8::StaticOrder, true, false, 2>(lds, g, S, E);
    }
    SEAM(9);

    if (IN(10)) {
        PHASE_IDS;
        const int r32 = lane & 31, hi = lane >> 5;
        constexpr int RSTR = 1040;
        LAS unsigned char* UH = lds; LAS unsigned char* UL = lds + 32 * RSTR;
        LAS float* part = (LAS float*)(lds + 2 * 32 * RSTR);
        LAS float* ssl = (LAS float*)(lds + 2 * 32 * RSTR + 40960);
        LAS int* ecnt = (LAS int*)(lds + 2 * 32 * RSTR + 40960 + 256);
        LAS f32x4* gsum = (LAS f32x4*)(lds + 2 * 32 * RSTR + 40960 + 512);
        LAS f32x4* G2L = (LAS f32x4*)(lds + 2 * 32 * RSTR + 40960 + 1024);
        LAS unsigned char* WGL = lds + 2 * 32 * RSTR + 40960 + 1024 + 8192;
        if (tid < 32) ecnt[tid] = 0;
        { const float* wgrp = args.in[8];
          for (int i = tid; i < DM; i += 512) *(LAS f32x4*)(WGL + i * 16 + (i >> 5) * 16) = *(const f32x4*)(wgrp + 4 * i);
          G2L[tid] = *(const f32x4*)(args.in[7] + 4 * tid); }
        __syncthreads();
        const float* bgrp = args.in[9]; const float* bexp = args.in[11];
        const int tok = tid >> 4, part16 = tid & 15;
        LAS float* scr = (LAS float*)(lds + wave * 8704);
        LAS float* cmax = (LAS float*)(lds + 152 * 1024);
        LAS int* qslot = (LAS int*)(lds + 156 * 1024);
        float* csgu = (float*)(ws + WS_CSGU);
        unsigned* qctr = (unsigned*)ctl + CW_Q10 + (args.dry ? 64 : 0);
        constexpr int NTILE = NTOK / 32, NJOB = 1024, NSLOT = NTILE + NJOB;
        for (;;) {
            __syncthreads();
            if (tid == 0) *qslot = (int)__hip_atomic_fetch_add(qctr, 1u, RLX_AGENT);
            __syncthreads();
            const int slot = *qslot;
            if (slot >= NSLOT) break;
            if (slot >= 2 * NTILE || (slot & 1)) {
                const int gg = slot >= 2 * NTILE ? slot - NTILE : slot >> 1;
{
                const int which = gg & 1, r = gg >> 1, e = r >> 4, nb = r & 15, n0 = 32 * nb;
                const int lane = lane_fresh();
                const float* W = args.in[12 + which] + (size_t)e * DM * DEXP;
                float mx = 0.f;
                float vv[4][32];
#pragma unroll
                for (int q4 = 0; q4 < 4; ++q4) { const int kb = wave * 4 + q4;
#pragma unroll
                    for (int i = 0; i < 32; ++i) vv[q4][i] = W[(size_t)(64 * kb + 2 * i + (lane >> 5)) * DEXP + n0 + (lane & 31)]; }
#pragma unroll
                for (int q4 = 0; q4 < 4; ++q4)
#pragma unroll
                    for (int i = 0; i < 32; ++i) mx = fmaxf(mx, fabsf(vv[q4][i]));
                mx = fmaxf(mx, __shfl_xor(mx, 32));
                __syncthreads();
                if (lane < 32) cmax[wave * 32 + lane] = mx;
                __syncthreads();
                float cm = 0.f;
#pragma unroll
                for (int w8 = 0; w8 < 8; ++w8) cm = fmaxf(cm, cmax[w8 * 32 + (lane & 31)]);
                const long orow0 = (long)e * 1024 + (n0 >> 7) * 256 + which * 128 + (n0 & 127);
                if (wave == 0 && lane < 32) csgu[orow0 + lane] = cm * (1.f / 127.f);
                const float cscale = cm > 0.f ? 127.f / cm : 0.f;
#pragma unroll
                for (int q4 = 0; q4 < 4; ++q4) transpose_regs_i8(vv[q4], 64 * (wave * 4 + q4), ws + WS_WGU, DM, orow0, cscale, scr, lane);
#pragma unroll 1
                for (int r2 = 0; r2 < 2; ++r2) { const int it = gg * 16 + wave * 2 + r2; const int e2 = it >> 9, kb = (it >> 6) & 7, nb2 = it & 63;
                    transpose_item_fp8(args.in[14] + (size_t)e2 * DEXP * DM, DM, 64 * kb, 32 * nb2, ws + WS_WDN, DEXP, (long)e2 * 2048 + 32 * nb2, WD8_SCALE, scr, lane); }
                }
                continue;
            }
            const int tile = slot >> 1;
            const int t0 = tile * 32;
            f32x16 accE = {};
            float ss = 0.f; f32x4 gacc = {0.f, 0.f, 0.f, 0.f};
            f32x4 xv[8];
            const float* xr = X1 + (size_t)(t0 + tok) * DM + part16 * 32;
            const float umx = __uint_as_float(__hip_atomic_load((unsigned*)ctl + CW_UMAX + t0 + tok, RLX_AGENT));
            const float uq = umx > 0.f ? 127.f / umx : 0.f;
            if (part16 == 0) ((float*)(ws + WS_RSU))[t0 + tok] = umx * (1.f / 127.f);
#pragma unroll
            for (int i = 0; i < 8; ++i) xv[i] = *(const f32x4*)(xr + 4 * i);
#pragma unroll 1
            for (int c = 0; c < 4; ++c) {
                const int kc = c * 512 + part16 * 32;
                bf16x8 wEh[4], wEl[4];
#pragma unroll
                for (int s4 = 0; s4 < 4; ++s4) { const int k = c * 512 + (wave * 4 + s4) * 16 + hi * 8; wEh[s4] = *(const bf16x8*)(WR + (size_t)r32 * DM + k); wEl[s4] = *(const bf16x8*)(WR + (size_t)(64 + r32) * DM + k); }
                u32x4 uh[4], ul[4]; u32x2 u8[4];
#pragma unroll
                for (int i = 0; i < 4; ++i) {
                    const f32x4 ga = G2L[(kc >> 2) + 2 * i], gb = G2L[(kc >> 2) + 2 * i + 1];
                    const f32x4 xa = xv[2 * i], xb = xv[2 * i + 1];
                    ss += (xa.x * xa.x + xa.y * xa.y) + (xa.z * xa.z + xa.w * xa.w) + (xb.x * xb.x + xb.y * xb.y) + (xb.z * xb.z + xb.w * xb.w);
                    const f32x4 ua = xa * ga, ub = xb * gb;
                    { LAS const unsigned char* wg = WGL + (kc + 8 * i) * 16 + (kc >> 5) * 16;
                      gacc += ua.x * *(LAS const f32x4*)(wg) + ua.y * *(LAS const f32x4*)(wg + 16) + ua.z * *(LAS const f32x4*)(wg + 32) + ua.w * *(LAS const f32x4*)(wg + 48);
                      asm volatile("" : "+v"(gacc) :: "memory");
                      gacc += ub.x * *(LAS const f32x4*)(wg + 64) + ub.y * *(LAS const f32x4*)(wg + 80) + ub.z * *(LAS const f32x4*)(wg + 96) + ub.w * *(LAS const f32x4*)(wg + 112);
                      asm volatile("" : "+v"(gacc) :: "memory"); }
                    uh[i] = pg8::pack8(ua, ub);
                    f32x4 ha, hb2; pg8::unpack8(uh[i], ha, hb2);
                    ul[i] = pg8::pack8(ua - ha, ub - hb2);
                    const f32x4 qa = ua * uq, qb = ub * uq;
                    u8[i].x = pk_i8x4(qa.x, qa.y, qa.z, qa.w); u8[i].y = pk_i8x4(qb.x, qb.y, qb.z, qb.w);
                }
                if (c < 3) {
#pragma unroll
                    for (int i = 0; i < 8; ++i) xv[i] = *(const f32x4*)(xr + (c + 1) * 512 + 4 * i);
                }
#pragma unroll
                for (int i = 0; i < 4; ++i) *(u32x2*)((unsigned char*)Hb + (size_t)(t0 + tok) * DM + kc + 8 * i) = u8[i];
                __syncthreads();
#pragma unroll
                for (int i = 0; i < 4; ++i) {
                    *(LAS u32x4*)(UH + tok * RSTR + part16 * 64 + 16 * i) = uh[i];
                    *(LAS u32x4*)(UL + tok * RSTR + part16 * 64 + 16 * i) = ul[i];
                }
                __syncthreads();
#pragma unroll
                for (int s = 0; s < 4; ++s) {
                    const int kl = (wave * 4 + s) * 16 + hi * 8;
                    const bf16x8 uhv = *(const LAS bf16x8*)(UH + r32 * RSTR + kl * 2), ulv = *(const LAS bf16x8*)(UL + r32 * RSTR + kl * 2);
                    accE = __builtin_amdgcn_mfma_f32_32x32x16_bf16(wEh[s], uhv, accE, 0, 0, 0);
                    accE = __builtin_amdgcn_mfma_f32_32x32x16_bf16(wEh[s], ulv, accE, 0, 0, 0);
                    accE = __builtin_amdgcn_mfma_f32_32x32x16_bf16(wEl[s], uhv, accE, 0, 0, 0);
                }
            }
            ss += __shfl_xor(ss, 1); ss += __shfl_xor(ss, 2); ss += __shfl_xor(ss, 4); ss += __shfl_xor(ss, 8);
#pragma unroll
            for (int g = 0; g < 4; ++g) { float v = gacc[g]; v += __shfl_xor(v, 1); v += __shfl_xor(v, 2); v += __shfl_xor(v, 4); v += __shfl_xor(v, 8); gacc[g] = v; }
            __syncthreads();
            if (part16 == 0) { ssl[tok] = ss; gsum[tok] = gacc; }
            LAS float* pw = part + wave * (32 * 40);
#pragma unroll
            for (int r = 0; r < 16; ++r) pw[r32 * 40 + att::crow(r, hi)] = accE[r];
            __syncthreads();
            if (tid < 32) {
                const int t = t0 + tid;
                const float rs = 1.0f / sqrtf(ssl[tid] * (1.f / DM) + RMS_EPS);
                float gl[4];
#pragma unroll
                for (int g = 0; g < 4; ++g) gl[g] = gsum[tid][g] * rs + bgrp[g];
                float gm = gl[0]; int gi = 0;
#pragma unroll
                for (int g = 1; g < 4; ++g) if (gl[g] > gm) { gm = gl[g]; gi = g; }
                float gs = 0.f;
#pragma unroll
                for (int g = 0; g < 4; ++g) gs += __expf(gl[g] - gm);
                const float gp = 1.0f / gs;
                float le[8];
#pragma unroll
                for (int e = 0; e < 8; ++e) { float a = 0.f;
#pragma unroll
                    for (int w8 = 0; w8 < 8; ++w8) a += part[w8 * (32 * 40) + tid * 40 + gi * 8 + e];
                    le[e] = a * rs + bexp[gi * 8 + e]; }
                float m0 = le[0]; int i0 = 0;
#pragma unroll
                for (int e = 1; e < 8; ++e) if (le[e] > m0) { m0 = le[e]; i0 = e; }
                float m1 = -__builtin_inff(); int i1 = 0;
#pragma unroll
                for (int e = 0; e < 8; ++e) if (e != i0 && le[e] > m1) { m1 = le[e]; i1 = e; }
                const float p1 = __expf(m1 - m0);
                const int e0 = gi * 8 + i0, e1 = gi * 8 + i1;
                EID[t * 2] = e0; EID[t * 2 + 1] = e1;
                EW[t * 2] = gp / (1.f + p1); EW[t * 2 + 1] = gp * p1 / (1.f + p1);
                RMS[t] = rs;
                __hip_atomic_fetch_add(&ecnt[e0], 1, __ATOMIC_RELAXED, __HIP_MEMORY_SCOPE_WORKGROUP); __hip_atomic_fetch_add(&ecnt[e1], 1, __ATOMIC_RELAXED, __HIP_MEMORY_SCOPE_WORKGROUP);
            }
        }
        __syncthreads();
        if (tid < 32 && ecnt[tid] > 0 && !args.dry) __hip_atomic_fetch_add((unsigned*)ctl + CW_ECNT + 64 * tid, (unsigned)ecnt[tid], RLX_AGENT);
    }
    SEAM(10);

    if (IN(11)) {
        PHASE_IDS;
        LAS int* pst = (LAS int*)(lds + 131072 - 1024);
        LAS int* ehist = pst + 64; LAS int* ebase = pst + 96;
        __syncthreads();
        if (tid == 0) { int s = 0; for (int e = 0; e < 32; ++e) { pst[e] = s; const int c = (int)__hip_atomic_load((unsigned*)ctl + CW_ECNT + 64 * e, RLX_AGENT); s += ((c + 255) >> 8) << 8; } pst[32] = s; }
        if (tid < 32) ehist[tid] = 0;
        __syncthreads();
        for (int t0 = bx * 128; t0 < NTOK && !args.dry; t0 += G * 128) {
            int e = 0, rk = 0;
            if (tid < 256) { e = EID[t0 * 2 + tid]; rk = __hip_atomic_fetch_add(&ehist[e], 1, __ATOMIC_RELAXED, __HIP_MEMORY_SCOPE_WORKGROUP); }
            __syncthreads();
            if (tid < 32) { const int c = ehist[tid]; ebase[tid] = c > 0 ? (int)__hip_atomic_fetch_add((unsigned*)ctl + CW_EFILL + 64 * tid, (unsigned)c, RLX_AGENT) : 0; }
            __syncthreads();
            if (tid < 256) { const int pos = pst[e] + ebase[e] + rk; ROWTOK[pos] = t0 + (tid >> 1); ROWW[pos] = EW[t0 * 2 + tid]; POS[t0 * 2 + tid] = pos; }
            __syncthreads();
            if (tid < 32) ehist[tid] = 0;
            __syncthreads();
        }
        if (bx < 32 && !args.dry) { const int c = (int)__hip_atomic_load((unsigned*)ctl + CW_ECNT + 64 * bx, RLX_AGENT); for (int r = pst[bx] + c + tid; r < pst[bx + 1]; r += NWAVES * 64) { ROWTOK[r] = 0; ROWW[r] = 0.f; } }
    }
    SEAM(11);

    if (IN(12) || IN(13)) {
        PHASE_IDS;
        LAS int* tst = (LAS int*)(lds + RING_BYTES + 64);
        __syncthreads();
        if (tid == 0) { int s = 0; for (int e = 0; e < 32; ++e) { tst[e] = s; const int c = (int)__hip_atomic_load((unsigned*)ctl + CW_ECNT + 64 * e, RLX_AGENT); s += (c + 255) >> 8; } tst[32] = s; }
        __syncthreads();
        const int ntiles = tst[32];
        if (IN(12)) {
            pg8::Gemm g{Hb, (const bf16*)(ws + WS_WGU), DM / 2, ROWTOK, DM / 2, Hb, 1 << 30}; pg8::GroupedOrder S{tst, 4, G, bx, ntiles};
            pg8::EpiMoe1 E{(bf16*)(ws + WS_HMOE), RMS, ROWTOK, (const float*)(ws + WS_RSU), (const float*)(ws + WS_CSGU)};
            pg8::gemm_phase<pg8::EpiMoe1, pg8::GroupedOrder, true, true, 2>(lds, g, S, E);
        }
        SEAM(12);
        if (IN(13)) {
            pg8::Gemm g{(const bf16*)(ws + WS_HMOE), (const bf16*)(ws + WS_WDN), DEXP / 2, nullptr, DEXP / 2, (const bf16*)(ws + WS_HMOE), 1 << 30}; pg8::GroupedOrder S{tst, 8, G, bx, ntiles};
            pg8::EpiMoe2 E{(bf16*)(ws + WS_YMOE), ROWW};
            pg8::gemm_phase<pg8::EpiMoe2, pg8::GroupedOrder, true, false, 1>(lds, g, S, E);
        }
    }
    SEAM(13);

    if (IN(14)) {
        PHASE_IDS;
        const float* gf = args.in[15]; const bf16* Y = (const bf16*)(ws + WS_YMOE);
        const unsigned tmo = __hip_atomic_load((unsigned*)ctl + CW_BAR + XB_TMO, RLX_AGENT);
        for (int m = gw; m < NTOK; m += NGW) {
            const float* xr = X1 + (size_t)m * DM; const int p0 = POS[m * 2], p1 = POS[m * 2 + 1];
            f32x4 v[8]; float s = 0.f;
#pragma unroll
            for (int j = 0; j < 4; ++j) { const int c = j * 512 + lane * 8;
                f32x4 a0, a1, b0, b1; pg8::unpack8(*(const u32x4*)(Y + (size_t)p0 * DM + c), a0, a1); pg8::unpack8(*(const u32x4*)(Y + (size_t)p1 * DM + c), b0, b1);
                v[2 * j] = *(const f32x4*)(xr + c) + a0 + b0; v[2 * j + 1] = *(const f32x4*)(xr + c + 4) + a1 + b1; }
#pragma unroll
            for (int j = 0; j < 8; ++j) s += (v[j].x * v[j].x + v[j].y * v[j].y) + (v[j].z * v[j].z + v[j].w * v[j].w);
            float rs = 1.0f / sqrtf(wave_sum(s) * (1.f / DM) + RMS_EPS);
            if (tmo) rs = __builtin_nanf("");
#pragma unroll
            for (int j = 0; j < 4; ++j) { const int c = j * 512 + lane * 8;
                *(f32x4*)(args.out + (size_t)m * DM + c) = v[2 * j] * rs * *(const f32x4*)(gf + c);
                *(f32x4*)(args.out + (size_t)m * DM + c + 4) = v[2 * j + 1] * rs * *(const f32x4*)(gf + c + 4); }
        }
    }
#undef IN
#undef SEAM
}

#if MK_DEBUG
namespace dbg {
__device__ __forceinline__ float b2f(bf16 v) { return __uint_as_float((unsigned)v << 16); }
__device__ __forceinline__ float wmax(float v) {
#pragma unroll
    for (int o = 1; o < 64; o <<= 1) v = fmaxf(v, __shfl_xor(v, o));
    return v;
}
__device__ __forceinline__ void wave_attend(const bf16* Q, const bf16* K, const bf16* V, int b, int h, int t, float slope, const int* kpos, int nk, float* qs, float* sc, float& o0, float& o1) {
    const int lane = threadIdx.x & 63;
    const size_t hb = (size_t)b * SEQ * WQ + h * HD;
    qs[lane] = b2f(Q[hb + (size_t)t * WQ + lane]); qs[lane + 64] = b2f(Q[hb + (size_t)t * WQ + lane + 64]);
    __builtin_amdgcn_s_waitcnt(0); __builtin_amdgcn_wave_barrier();
    float m = -INFINITY;
    for (int n = lane; n < nk; n += 64) { const int kp = kpos[n]; const bf16* kr = K + hb + (size_t)kp * WQ; float s = 0.f;
        for (int d = 0; d < HD; ++d) s = fmaf(qs[d], b2f(kr[d]), s);
        s = s * 0.08838834764831845f - slope * (float)(t - kp); sc[n] = s; m = fmaxf(m, s); }
    m = wmax(m);
    float l = 0.f;
    for (int n = lane; n < nk; n += 64) { const float p = expf(sc[n] - m); sc[n] = p; l += p; }
    l = wave_sum(l);
    __builtin_amdgcn_s_waitcnt(0); __builtin_amdgcn_wave_barrier();
    o0 = 0.f; o1 = 0.f;
    for (int n = 0; n < nk; ++n) { const float p = sc[n]; const bf16* vr = V + hb + (size_t)kpos[n] * WQ; o0 = fmaf(p, b2f(vr[lane]), o0); o1 = fmaf(p, b2f(vr[lane + 64]), o1); }
    o0 /= l; o1 /= l;
    __builtin_amdgcn_wave_barrier();
}
__global__ void __launch_bounds__(256) k_check(unsigned char* ws, int mode) {
    __shared__ int kpos_s[4][1024];
    __shared__ float sc_s[4][1024];
    __shared__ float qs_s[4][128];
    const int w = threadIdx.x >> 6, lane = threadIdx.x & 63;
    const unsigned sidx = blockIdx.x * 4 + w;
    const unsigned hsh = sidx * 2654435761u;
    const int b = (hsh >> 28) & 3, h = (hsh >> 24) & 7; int t = (hsh >> 8) & 8191;
    if ((sidx & 7) == 0) t = (sidx >> 3) & 511;
    const bf16* QM = (const bf16*)(ws + WS_QM); const bf16* KM = (const bf16*)(ws + WS_KM); const bf16* VM = (const bf16*)(ws + WS_VM);
    const bf16* QD = (const bf16*)(ws + WS_QD); const bf16* KD = (const bf16*)(ws + WS_KD); const bf16* VD = (const bf16*)(ws + WS_VD);
    const float* kmean = (const float*)(ws + WS_KMEAN);
    const bf16* OM = (const bf16*)(ws + WS_H); const bf16* OD = OM + (size_t)NTOK * WQ;
    float* accum = (float*)(ws + WS_CTL) + 200000;
    int* kp = kpos_s[w]; int nk = 0; float o0, o1; const bf16* O;
    const size_t hb = (size_t)b * SEQ * WQ + h * HD;
    if (mode == 1) {
        const int qblk = t >> 8;
        float g = -INFINITY;
        if (lane < qblk) { float s = 0.f; for (int d = 0; d < HD; ++d) s = fmaf(b2f(QM[hb + (size_t)t * WQ + d]), kmean[(size_t)((b * NH + h) * 32 + lane) * HD + d], s); g = s; }
        int s0 = -1, s1 = -1, s2 = -1; float g3 = 0.f, g4 = -INFINITY;
        { float mx = wmax(g);
          if (mx != -INFINITY) { s0 = __ffsll((long long)__ballot(g == mx)) - 1; if (lane == s0) g = -INFINITY; }
          mx = wmax(g);
          if (s0 >= 0 && mx != -INFINITY) { s1 = __ffsll((long long)__ballot(g == mx)) - 1; if (lane == s1) g = -INFINITY; }
          mx = wmax(g);
          if (s1 >= 0 && mx != -INFINITY) { s2 = __ffsll((long long)__ballot(g == mx)) - 1; g3 = mx; if (lane == s2) g = -INFINITY; }
          g4 = wmax(g); }
        if (s2 >= 0 && g4 != -INFINITY && g3 - g4 < 2e-3f) return;
        if (s0 >= 0) { for (int i = lane; i < 256; i += 64) kp[nk + i] = s0 * 256 + i; nk += 256; }
        if (s1 >= 0) { for (int i = lane; i < 256; i += 64) kp[nk + i] = s1 * 256 + i; nk += 256; }
        if (s2 >= 0) { for (int i = lane; i < 256; i += 64) kp[nk + i] = s2 * 256 + i; nk += 256; }
        const int own = t - qblk * 256 + 1;
        for (int i = lane; i < own; i += 64) kp[nk + i] = qblk * 256 + i;
        nk += own;
        __builtin_amdgcn_s_waitcnt(0); __builtin_amdgcn_wave_barrier();
        wave_attend(QM, KM, VM, b, h, t, exp2f(-0.5f * (float)(2 * h + 1)), kp, nk, qs_s[w], sc_s[w], o0, o1); O = OM;
    } else {
#pragma unroll
        for (int p = 0; p < 3; ++p) { const int d = (p == 0) ? 1 : (p == 1 ? 4 : 16); int cnt = t / d + 1; if (cnt > 129) cnt = 129;
            for (int i = lane; i < cnt; i += 64) kp[nk + i] = t - i * d; nk += cnt; }
        __builtin_amdgcn_s_waitcnt(0); __builtin_amdgcn_wave_barrier();
        wave_attend(QD, KD, VD, b, h, t, exp2f(-(float)(h + 1)), kp, nk, qs_s[w], sc_s[w], o0, o1); O = OD;
    }
    const float a0 = b2f(O[hb + (size_t)t * WQ + lane]), a1 = b2f(O[hb + (size_t)t * WQ + lane + 64]);
    float d2 = (a0 - o0) * (a0 - o0) + (a1 - o1) * (a1 - o1), r2 = o0 * o0 + o1 * o1;
    d2 = wave_sum(d2); r2 = wave_sum(r2);
    if (lane == 0) { atomicAdd(&accum[0], d2); atomicAdd(&accum[64], r2); }
}
__global__ void __launch_bounds__(256) k_report(unsigned char* ws, float* out, int n) {
    const int i = blockIdx.x * 256 + threadIdx.x;
    const float* accum = (const float*)(ws + WS_CTL) + 200000;
    if (i < n) out[i] = (i == 0) ? 1e4f * sqrtf(accum[0] / accum[64]) : 0.f;
}
}
#endif

extern "C" void kernel_launch(void* const* d_in, const int* in_sizes, int n_in, void* d_out, int out_size, void* d_ws, size_t ws_size, hipStream_t stream) {
    static int grid = 0;
    if (grid == 0) {
        if (n_in != 16 || ws_size < WS_END) { fprintf(stderr, "kernel_launch: need 16 inputs and %zu B of workspace (got %d, %zu)\n", (size_t)WS_END, n_in, ws_size); grid = -1; return; }
        int dev = 0, cus = 0, per_cu = 0;
        if (hipGetDevice(&dev) != hipSuccess || hipDeviceGetAttribute(&cus, hipDeviceAttributeMultiprocessorCount, dev) != hipSuccess) { grid = -1; return; }
        if (hipFuncSetAttribute((const void*)mk_fwd, hipFuncAttributeMaxDynamicSharedMemorySize, LDS_BYTES) != hipSuccess) { fprintf(stderr, "kernel_launch: hipFuncSetAttribute failed\n"); grid = -1; return; }
        if (hipOccupancyMaxActiveBlocksPerMultiprocessor(&per_cu, (const void*)mk_fwd, NWAVES * 64, LDS_BYTES) != hipSuccess || per_cu < 1) fprintf(stderr, "kernel_launch: occupancy query says %d\n", per_cu);
        (void)hipGetLastError();
        grid = cus;
    }
    if (grid < 0) return;
    (void)hipMemsetAsync((char*)d_ws + WS_CTL, 0, CTL_ZERO_BYTES, stream);
    (void)hipMemsetAsync((char*)d_ws + WS_KMEAN, 0, (size_t)NB * NH * 32 * HD * 4, stream);
    Args a{};
    for (int i = 0; i < 16; ++i) a.in[i] = (const float*)d_in[i];
    a.out = (float*)d_out; a.ws = (unsigned char*)d_ws;
    constexpr int NPH = 15;
#if MK_DEBUG
    for (int p = 0; p < 6; ++p) { a.ph_lo = p; a.ph_hi = p + 1; hipLaunchKernelGGL(mk_fwd, dim3(grid), dim3(NWAVES * 64), LDS_BYTES, stream, a); }
    hipLaunchKernelGGL(dbg::k_check, dim3(4096), dim3(256), 0, stream, (unsigned char*)d_ws, (int)MK_DEBUG);
    hipLaunchKernelGGL(dbg::k_report, dim3((out_size + 255) / 256), dim3(256), 0, stream, (unsigned char*)d_ws, (float*)d_out, out_size);
    return;
#endif
    if (MK_N_LAUNCHES == 1) { a.ph_lo = 0; a.ph_hi = NPH; hipLaunchKernelGGL(mk_fwd, dim3(grid), dim3(NWAVES * 64), LDS_BYTES, stream, a); }
    else { for (int p = 0; p < NPH; ++p) { const int reps = ((MK_REP_MASK >> p) & 1) ? 2 : 1; if (p == 2) continue;
            for (int r = 0; r < reps; ++r) { a.ph_lo = p; a.ph_hi = p + 1; a.dry = ((p == 10 || p == 11) && reps == 2 && r == 0) ? 1 : ((p == 4 && reps == 2 && r == 0) ? MK_DRY4 : 0); hipLaunchKernelGGL(mk_fwd, dim3(grid), dim3(NWAVES * 64), LDS_BYTES, stream, a);
            } } }
}
```

```cpp
#include <hip/hip_runtime.h>
#include <cstdio>
#include <cstdint>

#ifndef MK_N_LAUNCHES
#define MK_N_LAUNCHES 1
#endif

#ifndef MK_REP_MASK
#define MK_REP_MASK 0
#endif
#ifndef MK_DRY4
#define MK_DRY4 0
#endif
#ifndef MK_DEBUG
#define MK_DEBUG 0
#endif
#define LAS __attribute__((address_space(3)))
#define GAS __attribute__((address_space(1)))
typedef unsigned short bf16;
typedef short bf16x8 __attribute__((ext_vector_type(8)));
typedef short s16x4 __attribute__((ext_vector_type(4)));
typedef float f32x2 __attribute__((ext_vector_type(2)));
typedef float f32x4 __attribute__((ext_vector_type(4)));
typedef float f32x16 __attribute__((ext_vector_type(16)));
typedef unsigned u32x2 __attribute__((ext_vector_type(2)));
typedef unsigned u32x4 __attribute__((ext_vector_type(4)));
typedef int i32x4 __attribute__((ext_vector_type(4)));
typedef int i32x8 __attribute__((ext_vector_type(8)));
typedef GAS unsigned gu32;

constexpr int DM = 2048, NB = 4, SEQ = 8192, NTOK = NB * SEQ, HD = 128, NH = 8, WQ = 1024;
constexpr int NQKV = 6144, NGATE = 4096, NEXP = 32, DEXP = 512;
constexpr int NBF = 0;
constexpr int QIN = 2;
constexpr int RMAX = 73728;
constexpr float RMS_EPS = 1e-6f;
constexpr float LOG2E = 1.4426950408889634f;
constexpr float SM_C2 = 0.08838834764831845f * LOG2E;

constexpr size_t MiB = 1u << 20;
constexpr size_t WS_CTL = 0, CTL_ZERO_BYTES = 1 * MiB;
constexpr size_t WS_WOM = 1 * MiB, WS_WOD = 5 * MiB, WS_WO = 9 * MiB, WS_WIN = 17 * MiB;
constexpr size_t WS_WIN8 = 25 * MiB;
constexpr size_t WS_H8 = 912 * MiB;
constexpr size_t WS_BUCK = 57 * MiB;
constexpr size_t WS_CS8 = 73 * MiB;
constexpr size_t WS_RS8 = 73 * MiB + 64 * 1024;
constexpr size_t WS_KMEAN = 74 * MiB;
constexpr size_t WS_WR = 74 * MiB + 512 * 1024;
constexpr size_t WS_H = 75 * MiB;
constexpr size_t WS_QM = 203 * MiB, WS_KM = 267 * MiB, WS_VM = 331 * MiB, WS_QD = 395 * MiB, WS_KD = 459 * MiB, WS_VD = 523 * MiB;
constexpr size_t WS_PM = 587 * MiB;
constexpr size_t WS_PD = 779 * MiB;
constexpr size_t WS_LM = 907 * MiB, WS_LD = 910 * MiB;
constexpr size_t WS_SM = 976 * MiB, WS_SD = 980 * MiB;
constexpr size_t WS_GATES = 587 * MiB;
constexpr size_t WS_GINV = 75 * MiB;
constexpr size_t WS_MIX = 267 * MiB;
constexpr size_t WS_X1 = 768 * MiB;
constexpr size_t WS_WGU = 203 * MiB, WS_WDN = 331 * MiB;
constexpr size_t WS_HMOE = 395 * MiB;
constexpr size_t WS_YMOE = 467 * MiB;
constexpr size_t WS_END = 1024 * MiB;
constexpr size_t WS_RSM = WS_BUCK + 2560 * 1024, WS_CSWO = 73 * MiB + 48 * 1024;
constexpr size_t WS_MIX8 = 75 * MiB;
constexpr size_t WS_RSU = WS_BUCK + 2048 * 1024, WS_CSGU = WS_BUCK + 2304 * 1024;
constexpr size_t WS_EID = WS_BUCK, WS_EW = WS_BUCK + 256 * 1024, WS_RMS = WS_BUCK + 512 * 1024, WS_POS = WS_BUCK + 768 * 1024, WS_ROWTOK = WS_BUCK + 1024 * 1024, WS_ROWW = WS_BUCK + 1536 * 1024;
static_assert(WS_YMOE + (size_t)RMAX * 2048 * 2 <= WS_X1 && WS_HMOE + (size_t)RMAX * 512 * 2 <= WS_YMOE && WS_LD + 2 * (size_t)NTOK * 8 * 4 <= WS_END, "ws map");

constexpr int CW_TMO = 0;
constexpr int CW_BAR = 4096;
constexpr int CW_BCNT = 8192;
constexpr int CW_ECNT = 8192 + 65536;
constexpr int CW_EFILL = CW_ECNT + 64 * 32;
constexpr int CW_MMAX = 163840;
constexpr int CW_UMAX = 131072;
constexpr int CW_Q10 = 200000;
constexpr int CW_CMAX = 81920;
static_assert(CW_EFILL + 64 * 32 <= CW_CMAX && CW_CMAX + 8192 <= CW_UMAX && CW_UMAX + NTOK <= CW_MMAX && (CW_MMAX + NTOK) * 4 <= (int)CTL_ZERO_BYTES, "ctl");

constexpr int BUCK_PER_BH = 256 * 496;
__host__ __device__ __forceinline__ int buck_off(int j) { return 256 * (31 * j - (j * (j - 1)) / 2); }

constexpr int RING_BYTES = 131072, LDS_BYTES = 163840, MISC_OFF = LDS_BYTES - 512;
constexpr int NWAVES = 8;

#define LDS_WAIT() asm volatile("s_waitcnt lgkmcnt(0)" ::: "memory")
#define VM_WAIT() asm volatile("s_waitcnt vmcnt(0)" ::: "memory")
#define RLX_AGENT __ATOMIC_RELAXED, __HIP_MEMORY_SCOPE_AGENT

__device__ __forceinline__ unsigned cvt_pk_bf16(float lo, float hi) { unsigned r; asm volatile("v_cvt_pk_bf16_f32 %0, %1, %2" : "=v"(r) : "v"(lo), "v"(hi)); return r; }
__device__ __forceinline__ float bf_lo(unsigned w) { return __uint_as_float(w << 16); }
__device__ __forceinline__ float bf_hi(unsigned w) { return __uint_as_float(w & 0xffff0000u); }
__device__ __forceinline__ unsigned pk_fp8x4(float a, float b, float c, float d) {
    a = fminf(fmaxf(a, -448.f), 448.f); b = fminf(fmaxf(b, -448.f), 448.f); c = fminf(fmaxf(c, -448.f), 448.f); d = fminf(fmaxf(d, -448.f), 448.f);
    unsigned w = 0; w = __builtin_amdgcn_cvt_pk_fp8_f32(a, b, w, false); w = __builtin_amdgcn_cvt_pk_fp8_f32(c, d, w, true); return w; }
constexpr float H8_SCALE = 8.f, WD8_SCALE = 256.f;
__device__ __forceinline__ int lane_fresh() { int l = (int)__builtin_amdgcn_mbcnt_hi(~0u, __builtin_amdgcn_mbcnt_lo(~0u, 0u)); asm volatile("" : "+v"(l)); return l; }
__device__ __forceinline__ unsigned pk_i8x4(float a, float b, float c, float d) {
    const int ia = (int)fminf(fmaxf(__builtin_rintf(a), -127.f), 127.f), ib = (int)fminf(fmaxf(__builtin_rintf(b), -127.f), 127.f);
    const int ic = (int)fminf(fmaxf(__builtin_rintf(c), -127.f), 127.f), id = (int)fminf(fmaxf(__builtin_rintf(d), -127.f), 127.f);
    return (unsigned)(ia & 255) | ((unsigned)(ib & 255) << 8) | ((unsigned)(ic & 255) << 16) | ((unsigned)(id & 255) << 24); }
__device__ __forceinline__ float wave_sum(float v) {
#pragma unroll
    for (int o = 1; o < 64; o <<= 1) v += __shfl_xor(v, o);
    return v;
}

#define XB_TMO      128
#define XB_XCNT(j)  (256  + 64 * (j))
#define XB_XSUB(j)  (1280 + 64 * (j))
#define XB_XGEN(j)  (2304 + 64 * (j))
#define XB_TOP      3328
#define XB_TOPGEN   3392
#define XCD_BAR_WORDS 3456
#define XB_SPIN_CAP (1u << 22)
__device__ __forceinline__ unsigned xb_ld(unsigned* p)              { return __hip_atomic_load(p, __ATOMIC_RELAXED, __HIP_MEMORY_SCOPE_AGENT); }
__device__ __forceinline__ unsigned xb_add(unsigned* p, unsigned v) { return __hip_atomic_fetch_add(p, v, __ATOMIC_RELAXED, __HIP_MEMORY_SCOPE_AGENT); }
__device__ __forceinline__ unsigned xb_xcc_id() { return (unsigned)__builtin_amdgcn_s_getreg((3 << 11) | 20) & 0xFu; }
#define XB_SPIN(cond, bar) do { unsigned _sp = 0; while (cond) { __builtin_amdgcn_s_sleep(1); \
    if ((++_sp & 255u) == 0u) { if (xb_ld(&(bar)[XB_TMO])) break; if (_sp > XB_SPIN_CAP) { atomicAdd(&(bar)[XB_TMO], 1u); break; } } } } while (0)
struct XcdBarrier { unsigned* bar; unsigned x; volatile LAS unsigned* st; };
__device__ __forceinline__ XcdBarrier xcd_barrier_post(unsigned* bar, volatile LAS unsigned* st) {
    XcdBarrier b; b.bar = bar; b.x = xb_xcc_id(); b.st = st;
    if (threadIdx.x == 0) (void)xb_add(&bar[XB_XCNT(b.x)], 1u);
    return b;
}
__device__ __forceinline__ void xcd_barrier_complete(unsigned* bar, unsigned x, unsigned& nloc, unsigned& nx) {
    const unsigned G = gridDim.x * gridDim.y * gridDim.z;
    unsigned sum, cnt, mine, sp = 0u;
    for (;;) {
        sum = 0u; cnt = 0u; mine = 0u;
#pragma unroll
        for (unsigned j = 0; j < 16; ++j) { const unsigned c = xb_ld(&bar[XB_XCNT(j)]); sum += c; cnt += (c > 0u) ? 1u : 0u; mine = (j == x) ? c : mine; }
        if (sum == G) break;
        __builtin_amdgcn_s_sleep(1);
        if ((++sp & 255u) == 0u) { if (xb_ld(&bar[XB_TMO])) break; if (sp > XB_SPIN_CAP) { atomicAdd(&bar[XB_TMO], 1u); break; } }
    }
    nloc = mine > 0u ? mine : 1u; nx = cnt > 0u ? cnt : 1u;
}
__device__ __forceinline__ void xcd_barrier(const XcdBarrier& b) {
    asm volatile("s_waitcnt vmcnt(0)" ::: "memory");
    __syncthreads();
    if (threadIdx.x == 0) {
        unsigned* bar = b.bar;
        __builtin_amdgcn_s_waitcnt(0);
        unsigned nloc = b.st[0], nx = b.st[1];
        if (nloc == 0u) { xcd_barrier_complete(bar, b.x, nloc, nx); b.st[0] = nloc; b.st[1] = nx; }
        const unsigned old = xb_add(&bar[XB_XSUB(b.x)], 1u);
        const unsigned gen = old / nloc;
        if (old + 1u == (gen + 1u) * nloc) {
            __builtin_amdgcn_fence(__ATOMIC_RELEASE, "agent");
            asm volatile("s_waitcnt vmcnt(0)" ::: "memory");
            const unsigned og = xb_add(&bar[XB_TOP], 1u);
            const unsigned tg = og / nx;
            if (og + 1u == (tg + 1u) * nx) xb_add(&bar[XB_TOPGEN], 1u);
            else XB_SPIN(xb_ld(&bar[XB_TOPGEN]) == tg, bar);
            __builtin_amdgcn_fence(__ATOMIC_ACQUIRE, "agent");
            xb_add(&bar[XB_XGEN(b.x)], 1u);
            asm volatile("s_waitcnt vmcnt(0)" ::: "memory");
        } else {
            XB_SPIN(xb_ld(&bar[XB_XGEN(b.x)]) == gen, bar);
            __builtin_amdgcn_fence(__ATOMIC_ACQUIRE, "agent");
            asm volatile("s_waitcnt vmcnt(0)" ::: "memory");
        }
    }
    __syncthreads();
}

namespace pg8 {
constexpr int BM = 256, BK = 64, HALF = 128, HTB = HALF * BK * 2, NXCD = 8, WGM = 8;
__host__ __device__ __forceinline__ int lds_byte(int r, int c) { const int st = (r >> 4) * 2 + (c >> 5), rr = r & 15, cc = c & 31, ob = rr * 64 + cc * 2; return st * 1024 + (ob ^ (((ob >> 9) & 1) << 5)); }
__host__ __device__ __forceinline__ void stage_rc(int b, int& R, int& C) { const int st = b / 1024, sb = b % 1024, swz = sb ^ (((sb >> 9) & 1) << 5); R = (st >> 1) * 16 + swz / 64; C = (st & 1) * 32 + (swz % 64) / 2; }
__host__ __device__ __forceinline__ int perm32(int rho) { const int n = rho >> 4, i = rho & 15; return 8 * (i >> 2) + 4 * n + (i & 3); }

struct Unit { int pm, pn, pb, ex; };
struct Gemm { const bf16* A; const bf16* Bt; int K; const int* rowidx; int lda; const bf16* A1; int ksplit; };

struct StaticOrder {
    int nM, nN, nwg, G, c;
    __device__ void init(int M, int N, int G_, int c_) { nM = M / BM; nN = N / BM; nwg = nM * nN; G = G_; c = c_; }
    __device__ bool next(int i, Unit& u) const {
        const long L = (long)i * G + c; if (L >= nwg) return false;
        int wgid = (int)L; { const int q = nwg / NXCD, r = nwg % NXCD, xcd = wgid % NXCD, off = wgid / NXCD; wgid = (xcd < r ? xcd * (q + 1) : r * (q + 1) + (xcd - r) * q) + off; }
        const int nig = WGM * nN, gid = wgid / nig, fm = gid * WGM, gsz = (nM - fm) < WGM ? (nM - fm) : WGM;
        u.pm = fm + ((wgid % nig) % gsz); u.pn = (wgid % nig) / gsz; u.pb = u.pn; u.ex = 0; return true;
    }
};
struct GroupedOrder {
    const LAS int* tstart;
    int nN, G, c, ntiles;
    __device__ bool next(int i, Unit& u) const {
        const long L = (long)i * G + c; if (L >= (long)ntiles * nN) return false;
        const int ti = (int)(L / nN), pn = (int)(L % nN);
        int e = 0;
#pragma unroll 1
        for (int k = 1; k < 32; ++k) e += (tstart[k] <= ti) ? 1 : 0;
        u.pm = ti; u.pn = pn; u.pb = e * nN + pn; u.ex = e; return true;
    }
};
struct MoeOrder {
    const LAS int* tstart; int nN, G, c; long j0, jend; int A, ratio;
    __device__ __forceinline__ bool next(int i, Unit& u) const {
        const int L = G - A; long k;
        if (ratio == 0 || A == 0) k = (long)i * G + c;
        else if (c >= A) k = i < ratio ? (long)i * L + (c - A) : (long)ratio * L + (long)(i - ratio) * G + c;
        else k = (long)ratio * L + (long)i * G + c;
        const long j = j0 + k; if (j >= jend) return false;
        const int ti = (int)(j / nN), pn = (int)(j % nN);
        int e = 0;
#pragma unroll 1
        for (int q = 1; q < 32; ++q) e += (tstart[q] <= ti) ? 1 : 0;
        u.pm = ti; u.pn = pn; u.pb = e * nN + pn; u.ex = e; return true;
    }
};

template <class Epi, class Sched, bool ALIGN_EPI, bool GATHER = false, int QMODE = 0>
__device__ __forceinline__ void gemm_phase(LAS unsigned char* lds, const Gemm g, const Sched& S, const Epi& E) {
    const int lane = lane_fresh(), wid = __builtin_amdgcn_readfirstlane((int)threadIdx.x >> 6), tid = wid * 64 + lane, wr = wid >> 2, wc = wid & 3, fr = lane & 15, fq = lane >> 4;
    const int K = g.K, nt = K / BK;
    int RA[2], CA[2]; unsigned voffB[2];
#pragma unroll
    for (int i = 0; i < 2; ++i) { int R, C; stage_rc(tid * 16 + i * 8192, R, C); const int Rb = Epi::PERM ? ((R & ~31) + perm32(R & 31)) : R;
        RA[i] = R; CA[i] = C; voffB[i] = (unsigned)(Rb * K + C) * 2u; }
    const size_t kstep = (size_t)(BK * 2);
    const size_t hstep = (size_t)HALF * K * 2;
    const size_t tstep = 2 * hstep;
    const unsigned ldsw = (unsigned)wid * 1024u;
    const int aoff = lds_byte(wr * 64 + fr, fq * 8), boff = lds_byte(wc * 32 + fr, fq * 8);
#define PG8_SA(b, h) (((b) * 2 + (h)) * HTB)
#define PG8_SB(b, h) ((4 + (b) * 2 + (h)) * HTB)
#define PG8_STAGEB(bufoff, gbase) do { _Pragma("unroll") for (int _i = 0; _i < 2; ++_i) \
        __builtin_amdgcn_global_load_lds((const unsigned*)((const char*)(gbase) + voffB[_i]), (LAS unsigned*)(lds + (bufoff) + ldsw + _i * 8192), 16, 0, 0); } while (0)
#define PG8_STAGEA(bufoff, gbase, vo, h) do { _Pragma("unroll") for (int _i = 0; _i < 2; ++_i) \
        __builtin_amdgcn_global_load_lds((const unsigned*)((const char*)(gbase) + (vo)[h][_i]), (LAS unsigned*)(lds + (bufoff) + ldsw + _i * 8192), 16, 0, 0); } while (0)
#define PG8_LDA(dst, b, h) do { _Pragma("unroll") for (int m = 0; m < 4; ++m) _Pragma("unroll") for (int k = 0; k < 2; ++k) dst[m][k] = *(const LAS bf16x8*)(lds + PG8_SA(b, h) + aoff + m * 2048 + k * 1024); } while (0)
#define PG8_LDB(dst, b, h) do { _Pragma("unroll") for (int n = 0; n < 2; ++n) _Pragma("unroll") for (int k = 0; k < 2; ++k) dst[n][k] = *(const LAS bf16x8*)(lds + PG8_SB(b, h) + boff + n * 2048 + k * 1024); } while (0)
#define PG8_CAT(x0, x1) __builtin_shufflevector(__builtin_bit_cast(i32x4, x0), __builtin_bit_cast(i32x4, x1), 0, 1, 2, 3, 4, 5, 6, 7)
#define PG8_MMA(ai, bj, At, Bt) do { __builtin_amdgcn_s_setprio(1); _Pragma("unroll") for (int m = 0; m < 4; ++m) _Pragma("unroll") for (int n = 0; n < 2; ++n) { \
        if constexpr (QMODE == 1) asm volatile("v_mfma_scale_f32_16x16x128_f8f6f4 %0, %1, %2, %0, %3, %3 op_sel_hi:[0,0,0]" : "+v"(acc[ai][bj][m][n]) : "v"(PG8_CAT(Bt[n][0], Bt[n][1])), "v"(PG8_CAT(At[m][0], At[m][1])), "v"(sc1)); \
        else if constexpr (QMODE == 2) { _Pragma("unroll") for (int k = 0; k < 2; ++k) acc[ai][bj][m][n] = __builtin_bit_cast(f32x4, __builtin_amdgcn_mfma_i32_16x16x64_i8(__builtin_bit_cast(i32x4, Bt[n][k]), __builtin_bit_cast(i32x4, At[m][k]), __builtin_bit_cast(i32x4, acc[ai][bj][m][n]), 0, 0, 0)); } \
        else { _Pragma("unroll") for (int k = 0; k < 2; ++k) acc[ai][bj][m][n] = __builtin_amdgcn_mfma_f32_16x16x32_bf16(Bt[n][k], At[m][k], acc[ai][bj][m][n], 0, 0, 0); } } __builtin_amdgcn_s_setprio(0); } while (0)
#define PG8_WAIT_V(n) asm volatile("s_waitcnt vmcnt(" #n ")" ::: "memory")
#define PG8_WAIT_L(n) asm volatile("s_waitcnt lgkmcnt(" #n ")" ::: "memory")
#define PG8_BAR __builtin_amdgcn_s_barrier()
#define PG8_SCHED __builtin_amdgcn_sched_barrier(0)
#define PG8_AOFF(vo, u) do { _Pragma("unroll") for (int _h = 0; _h < 2; ++_h) _Pragma("unroll") for (int _i = 0; _i < 2; ++_i) { \
        const int _r = (GATHER ? (u).pm * BM : 0) + _h * HALF + RA[_i]; const int _row = GATHER ? g.rowidx[_r] : _r; (vo)[_h][_i] = (unsigned)(_row * g.lda + CA[_i]) * 2u; } } while (0)
    Unit cur, nxt; int ui = 0;
    if (!S.next(0, cur)) return;
    int sc1 = 0x7f7f7f7f; asm volatile("" : "+v"(sc1));
    f32x4 acc[2][2][4][2];
#pragma unroll
    for (int a = 0; a < 2; ++a)
#pragma unroll
        for (int b = 0; b < 2; ++b)
#pragma unroll
            for (int m = 0; m < 4; ++m)
#pragma unroll
                for (int n = 0; n < 2; ++n) acc[a][b][m][n] = (f32x4){0.f, 0.f, 0.f, 0.f};
    bf16x8 At[4][2], B0[2][2], B1[2][2];
    unsigned voC[2][2], voN[2][2];
    PG8_AOFF(voC, cur);
    const size_t tstepA = (size_t)BM * g.lda * 2;
    const char* cA = (const char*)g.A + (GATHER ? 0 : (size_t)cur.pm * tstepA); const char* cA1 = (const char*)g.A1 - (size_t)g.ksplit * kstep + (GATHER ? 0 : (size_t)cur.pm * tstepA);
#define PG8_AP(t_) (((t_) < g.ksplit ? cA : cA1) + (size_t)(t_) * kstep)
    const char* cB = (const char*)g.Bt + (size_t)cur.pb * tstep;
    PG8_STAGEB(PG8_SB(0, 0), cB); PG8_STAGEB(PG8_SB(0, 1), cB + hstep); PG8_STAGEA(PG8_SA(0, 0), cA, voC, 0); PG8_STAGEA(PG8_SA(0, 1), cA, voC, 1);
    if (wr == 1) PG8_BAR;
    PG8_WAIT_V(2); PG8_BAR;
    PG8_STAGEB(PG8_SB(1, 0), cB + kstep); PG8_STAGEA(PG8_SA(1, 0), PG8_AP(1), voC, 0); PG8_STAGEB(PG8_SB(1, 1), cB + hstep + kstep);
    PG8_WAIT_V(6); PG8_BAR;
    for (;;) {
        const bool has_next = S.next(ui + 1, nxt);
        if constexpr (GATHER) { if (has_next) { PG8_AOFF(voN, nxt); } else {
#pragma unroll
            for (int _h = 0; _h < 2; ++_h)
#pragma unroll
                for (int _i = 0; _i < 2; ++_i) voN[_h][_i] = voC[_h][_i]; } }
        const char* nB = has_next ? (const char*)g.Bt + (size_t)nxt.pb * tstep : cB;
        const char* nA = (GATHER || !has_next) ? cA : (const char*)g.A + (size_t)nxt.pm * tstepA;
        const char* nA1 = (GATHER || !has_next) ? cA1 : (const char*)g.A1 - (size_t)g.ksplit * kstep + (size_t)nxt.pm * tstepA;
        for (int t = 0; t < nt; t += 2) {
            const bool last = (t == nt - 2);
            const char* a1 = PG8_AP(t + 1);
            const char* a2 = last ? nA : PG8_AP(t + 2); const char* b2 = last ? nB : cB + (size_t)(t + 2) * kstep;
            const char* a3 = last ? nA + kstep : PG8_AP(t + 3); const char* b3 = b2 + kstep;
            if constexpr (Epi::MIDHOOK) { if (t == g.ksplit) E.mid(acc, cur, wr, wc, fr, fq); }
            unsigned vo2[2][2];
#pragma unroll
            for (int _h = 0; _h < 2; ++_h)
#pragma unroll
                for (int _i = 0; _i < 2; ++_i) { if constexpr (GATHER) vo2[_h][_i] = last ? voN[_h][_i] : voC[_h][_i]; else vo2[_h][_i] = voC[_h][_i]; }
            PG8_LDB(B0, 0, 0); PG8_LDB(B1, 0, 1); PG8_SCHED; PG8_LDA(At, 0, 0); PG8_STAGEA(PG8_SA(1, 1), a1, voC, 1);
            PG8_WAIT_V(8); PG8_WAIT_L(0); PG8_BAR; PG8_MMA(0, 0, At, B0); PG8_MMA(0, 1, At, B1); PG8_BAR; PG8_SCHED;
            PG8_LDA(At, 0, 1); PG8_STAGEB(PG8_SB(0, 0), b2); PG8_STAGEB(PG8_SB(0, 1), b2 + hstep); PG8_STAGEA(PG8_SA(0, 0), a2, vo2, 0);
            PG8_WAIT_V(8); PG8_WAIT_L(0); PG8_BAR; PG8_MMA(1, 0, At, B0); PG8_MMA(1, 1, At, B1); PG8_BAR; PG8_SCHED;
            PG8_LDB(B0, 1, 0); PG8_LDB(B1, 1, 1); PG8_SCHED; PG8_LDA(At, 1, 0); PG8_STAGEA(PG8_SA(0, 1), a2, vo2, 1);
            PG8_WAIT_V(8); PG8_WAIT_L(0); PG8_BAR; PG8_MMA(0, 0, At, B0); PG8_MMA(0, 1, At, B1); PG8_BAR; PG8_SCHED;
            PG8_LDA(At, 1, 1); PG8_STAGEB(PG8_SB(1, 0), b3); PG8_STAGEB(PG8_SB(1, 1), b3 + hstep); PG8_STAGEA(PG8_SA(1, 0), a3, vo2, 0);
            PG8_WAIT_V(8); PG8_WAIT_L(0); PG8_BAR; PG8_MMA(1, 0, At, B0); PG8_MMA(1, 1, At, B1); PG8_BAR; PG8_SCHED;
        }
        if constexpr (ALIGN_EPI) { if (wr == 0) PG8_BAR; }
        if constexpr (QMODE == 1) asm volatile("s_nop 15\n\ts_nop 15\n\ts_nop 15\n\ts_nop 15\n\ts_nop 15" ::: "memory");
        if constexpr (QMODE == 2) {
#pragma unroll
            for (int a = 0; a < 2; ++a)
#pragma unroll
                for (int b = 0; b < 2; ++b)
#pragma unroll
                    for (int m = 0; m < 4; ++m)
#pragma unroll
                        for (int n = 0; n < 2; ++n) acc[a][b][m][n] = __builtin_convertvector(__builtin_bit_cast(i32x4, acc[a][b][m][n]), f32x4); }
        E(acc, cur, wr, wc, fr, fq);
        if (!has_next) break;
#pragma unroll
        for (int a = 0; a < 2; ++a)
#pragma unroll
            for (int b = 0; b < 2; ++b)
#pragma unroll
                for (int m = 0; m < 4; ++m)
#pragma unroll
                    for (int n = 0; n < 2; ++n) acc[a][b][m][n] = (f32x4){0.f, 0.f, 0.f, 0.f};
        cur = nxt; cB = nB; cA = nA; cA1 = nA1; ++ui;
        if constexpr (GATHER) {
#pragma unroll
            for (int _h = 0; _h < 2; ++_h)
#pragma unroll
                for (int _i = 0; _i < 2; ++_i) voC[_h][_i] = voN[_h][_i]; }
        if constexpr (ALIGN_EPI) { if (wr == 1) PG8_BAR; }
    }
    PG8_WAIT_V(0);
    if constexpr (!ALIGN_EPI) { if (wr == 0) PG8_BAR; }
    PG8_BAR;
#undef PG8_SA
#undef PG8_SB
#undef PG8_STAGEA
#undef PG8_STAGEB
#undef PG8_LDA
#undef PG8_LDB
#undef PG8_MMA
#undef PG8_WAIT_V
#undef PG8_WAIT_L
#undef PG8_BAR
#undef PG8_SCHED
#undef PG8_AOFF
#undef PG8_AP
#undef PG8_CAT
}

#define EPI_LOOP_BEGIN _Pragma("unroll") for (int ai = 0; ai < 2; ++ai) _Pragma("unroll") for (int m = 0; m < 4; ++m) { const int row = u.pm * BM + ai * HALF + wr * 64 + m * 16 + fr; _Pragma("unroll") for (int bj = 0; bj < 2; ++bj) { const int colt = bj * HALF + wc * 32 + 8 * fq;
#define EPI_LOOP_END } }
__device__ __forceinline__ int opaque0() { int z = 0; asm volatile("" : "+v"(z)); return z; }
__device__ __forceinline__ u32x4 pack8(f32x4 v0, f32x4 v1) { u32x4 w; w.x = cvt_pk_bf16(v0[0], v0[1]); w.y = cvt_pk_bf16(v0[2], v0[3]); w.z = cvt_pk_bf16(v1[0], v1[1]); w.w = cvt_pk_bf16(v1[2], v1[3]); return w; }
__device__ __forceinline__ void unpack8(u32x4 w, f32x4& a, f32x4& b) { a = (f32x4){bf_lo(w.x), bf_hi(w.x), bf_lo(w.y), bf_hi(w.y)}; b = (f32x4){bf_lo(w.z), bf_hi(w.z), bf_lo(w.w), bf_hi(w.w)}; }

struct EpiQKV {
    static constexpr bool PERM = true, MIDHOOK = false;
    bf16* O; int pn0; const float* rsc; const float* csc;
    float* kmean;
    __device__ __forceinline__ void operator()(const f32x4 (&acc)[2][2][4][2], const Unit& u, int wr, int wc, int fr_, int fq_) const {
        const int fr = fr_ + opaque0(), fq = fq_ + opaque0();
        const int pn = u.pn + pn0;
        if (kmean != nullptr && (pn >> 2) == 1) {
#pragma unroll
            for (int bj = 0; bj < 2; ++bj)
#pragma unroll
                for (int n = 0; n < 2; ++n) { f32x4 sm = (f32x4){0.f, 0.f, 0.f, 0.f};
#pragma unroll
                    for (int ai = 0; ai < 2; ++ai)
#pragma unroll
                        for (int m = 0; m < 4; ++m) sm += rsc ? acc[ai][bj][m][n] * rsc[u.pm * BM + ai * HALF + wr * 64 + m * 16 + fr] : acc[ai][bj][m][n];
                    if (rsc) sm = sm * *(const f32x4*)(csc + u.pn * BM + bj * HALF + wc * 32 + 8 * fq + 4 * n);
#pragma unroll
                    for (int e = 0; e < 4; ++e) { float v = sm[e]; v += __shfl_xor(v, 1); v += __shfl_xor(v, 2); v += __shfl_xor(v, 4); v += __shfl_xor(v, 8); sm[e] = v; }
                    if ((fr_ & 15) == 0) { float* dst = kmean + ((size_t)((u.pm >> 5) * NH + (pn & 3) * 2 + bj) * 32 + (u.pm & 31)) * HD + wc * 32 + 8 * fq + 4 * n;
#pragma unroll
                        for (int e = 0; e < 4; ++e) atomicAdd(dst + e, sm[e] * (1.f / 256.f)); } }
        }
        bf16* base = O + (size_t)(pn >> 2) * ((size_t)NTOK * WQ) + (pn & 3) * 256;
        EPI_LOOP_BEGIN
            f32x4 v0 = acc[ai][bj][m][0], v1 = acc[ai][bj][m][1];
            if (rsc) { const float r = rsc[row]; v0 = v0 * r * *(const f32x4*)(csc + u.pn * BM + colt); v1 = v1 * r * *(const f32x4*)(csc + u.pn * BM + colt + 4); }
            *(u32x4*)(base + (size_t)row * WQ + colt) = pack8(v0, v1);
        EPI_LOOP_END
    }
};
struct EpiGates {
    static constexpr bool PERM = true, MIDHOOK = false;
    bf16* GD; bf16* R; const float* bias; const float* rsc; const float* csc;
    __device__ __forceinline__ void operator()(const f32x4 (&acc)[2][2][4][2], const Unit& u, int wr, int wc, int fr_, int fq_) const {
        const int fr = fr_ + opaque0(), fq = fq_ + opaque0();
        const int cl = wc * 32 + 8 * fq, col = u.pn * HALF + cl;
        const f32x4 cm0 = *(const f32x4*)(csc + u.pn * BM + cl), cm1 = *(const f32x4*)(csc + u.pn * BM + cl + 4), cd0 = *(const f32x4*)(csc + u.pn * BM + HALF + cl), cd1 = *(const f32x4*)(csc + u.pn * BM + HALF + cl + 4);
        const f32x4 bm0 = *(const f32x4*)(bias + col), bm1 = *(const f32x4*)(bias + col + 4), bd0 = *(const f32x4*)(bias + DM + col), bd1 = *(const f32x4*)(bias + DM + col + 4);
#pragma unroll
        for (int ai = 0; ai < 2; ++ai)
#pragma unroll
            for (int m = 0; m < 4; ++m) { const int row = u.pm * BM + ai * HALF + wr * 64 + m * 16 + fr; const float r = rsc[row];
                f32x4 am0 = acc[ai][0][m][0] * r * cm0 + bm0, am1 = acc[ai][0][m][1] * r * cm1 + bm1, ad0 = acc[ai][1][m][0] * r * cd0 + bd0, ad1 = acc[ai][1][m][1] * r * cd1 + bd1;
                f32x4 gd0, gd1, rr0, rr1;
#pragma unroll
                for (int e = 0; e < 4; ++e) { const float im0 = 1.f + __builtin_amdgcn_exp2f(-LOG2E * am0[e]), im1 = 1.f + __builtin_amdgcn_exp2f(-LOG2E * am1[e]);
                    const float id0 = 1.f + __builtin_amdgcn_exp2f(-LOG2E * ad0[e]), id1 = 1.f + __builtin_amdgcn_exp2f(-LOG2E * ad1[e]);
                    gd0[e] = __builtin_amdgcn_rcpf(id0); gd1[e] = __builtin_amdgcn_rcpf(id1); rr0[e] = id0 * __builtin_amdgcn_rcpf(im0); rr1[e] = id1 * __builtin_amdgcn_rcpf(im1); }
                *(u32x4*)(GD + (size_t)row * DM + col) = pack8(gd0, gd1); *(u32x4*)(R + (size_t)row * DM + col) = pack8(rr0, rr1); }
    }
};
template <bool ADD> struct EpiMix {
    static constexpr bool PERM = true, MIDHOOK = false;
    bf16* MIX; const bf16* G; int goff;
    __device__ __forceinline__ void operator()(const f32x4 (&acc)[2][2][4][2], const Unit& u, int wr, int wc, int fr_, int fq_) const {
        const int fr = fr_ + opaque0(), fq = fq_ + opaque0();
        EPI_LOOP_BEGIN
            const int col = u.pn * BM + colt;
            f32x4 g0, g1; unpack8(*(const u32x4*)(G + (size_t)row * NGATE + goff + col), g0, g1);
            f32x4 v0 = acc[ai][bj][m][0] * g0, v1 = acc[ai][bj][m][1] * g1;
            if (ADD) { f32x4 t0, t1; unpack8(*(const u32x4*)(MIX + (size_t)row * DM + col), t0, t1); v0 += t0; v1 += t1; }
            *(u32x4*)(MIX + (size_t)row * DM + col) = pack8(v0, v1);
        EPI_LOOP_END
    }
};
struct EpiMix2 {
    static constexpr bool PERM = true, MIDHOOK = true;
    bf16* MIX; const bf16* GD; const bf16* R; unsigned* mmax;
    __device__ __forceinline__ void mid(f32x4 (&acc)[2][2][4][2], const Unit& u, int wr, int wc, int fr_, int fq_) const {
        const int fr = fr_ + opaque0(), fq = fq_ + opaque0();
#pragma unroll
        for (int ai = 0; ai < 2; ++ai) {
            u32x4 rw[4][2];
#pragma unroll
            for (int m = 0; m < 4; ++m) { const int row = u.pm * BM + ai * HALF + wr * 64 + m * 16 + fr;
#pragma unroll
                for (int bj = 0; bj < 2; ++bj) rw[m][bj] = *(const u32x4*)(R + (size_t)row * DM + u.pn * BM + bj * HALF + wc * 32 + 8 * fq); }
#pragma unroll
            for (int m = 0; m < 4; ++m)
#pragma unroll
                for (int bj = 0; bj < 2; ++bj) { f32x4 r0, r1; unpack8(rw[m][bj], r0, r1); acc[ai][bj][m][0] *= r0; acc[ai][bj][m][1] *= r1; }
#pragma unroll
            for (int m = 0; m < 4; ++m) asm volatile("" : "+v"(acc[ai][0][m][0]), "+v"(acc[ai][0][m][1]), "+v"(acc[ai][1][m][0]), "+v"(acc[ai][1][m][1]) :: "memory");
        }
    }
    __device__ __forceinline__ void operator()(const f32x4 (&acc)[2][2][4][2], const Unit& u, int wr, int wc, int fr_, int fq_) const {
        const int fr = fr_ + opaque0(), fq = fq_ + opaque0();
#pragma unroll
        for (int ai = 0; ai < 2; ++ai)
#pragma unroll
            for (int m = 0; m < 4; ++m) { const int row = u.pm * BM + ai * HALF + wr * 64 + m * 16 + fr; float mx = 0.f;
#pragma unroll
                for (int bj = 0; bj < 2; ++bj) { const int col = u.pn * BM + bj * HALF + wc * 32 + 8 * fq;
                    f32x4 g0, g1; unpack8(*(const u32x4*)(GD + (size_t)row * DM + col), g0, g1);
                    const f32x4 v0 = acc[ai][bj][m][0] * g0, v1 = acc[ai][bj][m][1] * g1;
                    *(u32x4*)(MIX + (size_t)row * DM + col) = pack8(v0, v1);
#pragma unroll
                    for (int e = 0; e < 4; ++e) mx = fmaxf(mx, fmaxf(fabsf(v0[e]), fabsf(v1[e]))); }
                mx = fmaxf(mx, __shfl_xor(mx, 16)); mx = fmaxf(mx, __shfl_xor(mx, 32));
                if (fq == 0) __hip_atomic_fetch_max(mmax + row, __float_as_uint(mx), RLX_AGENT); }
    }
};
struct EpiResid {
    static constexpr bool PERM = true, MIDHOOK = false;
    const float* X; float* X1; const float* g2; unsigned* umax;
    const float* rsc; const float* csc;
    __device__ __forceinline__ void operator()(const f32x4 (&acc)[2][2][4][2], const Unit& u, int wr, int wc, int fr_, int fq_) const {
        const int fr = fr_ + opaque0(), fq = fq_ + opaque0();
        f32x4 gg[2][2];
#pragma unroll
        for (int bj = 0; bj < 2; ++bj) { const int c = u.pn * BM + bj * HALF + wc * 32 + 8 * fq; gg[bj][0] = *(const f32x4*)(g2 + c); gg[bj][1] = *(const f32x4*)(g2 + c + 4); }
#pragma unroll
        for (int ai = 0; ai < 2; ++ai)
#pragma unroll
            for (int m = 0; m < 4; ++m) { const int row = u.pm * BM + ai * HALF + wr * 64 + m * 16 + fr; float mx = 0.f;
#pragma unroll
                for (int bj = 0; bj < 2; ++bj) { const size_t o = (size_t)row * DM + u.pn * BM + bj * HALF + wc * 32 + 8 * fq;
                    const int colx = u.pn * BM + bj * HALF + wc * 32 + 8 * fq; const float rs_ = rsc[row];
                    const f32x4 v0 = *(const f32x4*)(X + o) + acc[ai][bj][m][0] * rs_ * *(const f32x4*)(csc + colx), v1 = *(const f32x4*)(X + o + 4) + acc[ai][bj][m][1] * rs_ * *(const f32x4*)(csc + colx + 4);
                    *(f32x4*)(X1 + o) = v0; *(f32x4*)(X1 + o + 4) = v1;
                    const f32x4 a0 = v0 * gg[bj][0], a1 = v1 * gg[bj][1];
#pragma unroll
                    for (int e = 0; e < 4; ++e) mx = fmaxf(mx, fmaxf(fabsf(a0[e]), fabsf(a1[e]))); }
                mx = fmaxf(mx, __shfl_xor(mx, 16)); mx = fmaxf(mx, __shfl_xor(mx, 32));
                if (fq == 0) __hip_atomic_fetch_max(umax + row, __float_as_uint(mx), RLX_AGENT); }
    }
};
struct EpiMoe1 {
    static constexpr bool PERM = true, MIDHOOK = false;
    bf16* H; const float* rms; const int* rowtok; const float* rsu; const float* csgu;
    __device__ __forceinline__ void operator()(const f32x4 (&acc)[2][2][4][2], const Unit& u, int wr, int wc, int fr_, int fq_) const {
        const int fr = fr_ + opaque0(), fq = fq_ + opaque0();
        const float* cg = csgu + (size_t)u.ex * 1024 + u.pn * BM + wc * 32 + 8 * fq;
        const f32x4 cg0 = *(const f32x4*)cg, cg1 = *(const f32x4*)(cg + 4), cu0 = *(const f32x4*)(cg + HALF), cu1 = *(const f32x4*)(cg + HALF + 4);
#pragma unroll
        for (int ai = 0; ai < 2; ++ai)
#pragma unroll
            for (int m = 0; m < 4; ++m) { const int row = u.pm * BM + ai * HALF + wr * 64 + m * 16 + fr; const int tok = rowtok[row]; const float rs = rms[tok] * rsu[tok];
                f32x4 o[2];
#pragma unroll
                for (int n = 0; n < 2; ++n)
#pragma unroll
                    for (int e = 0; e < 4; ++e) { const float gt = acc[ai][0][m][n][e] * rs * (n ? cg1[e] : cg0[e]), up = acc[ai][1][m][n][e] * rs * (n ? cu1[e] : cu0[e]);
                        o[n][e] = gt * __builtin_amdgcn_rcpf(1.f + __builtin_amdgcn_exp2f(-LOG2E * gt)) * up; }
                u32x2 h8; h8.x = pk_fp8x4(o[0][0] * H8_SCALE, o[0][1] * H8_SCALE, o[0][2] * H8_SCALE, o[0][3] * H8_SCALE); h8.y = pk_fp8x4(o[1][0] * H8_SCALE, o[1][1] * H8_SCALE, o[1][2] * H8_SCALE, o[1][3] * H8_SCALE);
                *(u32x2*)((unsigned char*)H + (size_t)row * DEXP + u.pn * HALF + wc * 32 + 8 * fq) = h8; }
    }
};
struct EpiMoe2 {
    static constexpr bool PERM = true, MIDHOOK = false;
    bf16* Y; const float* roww;
    __device__ __forceinline__ void operator()(const f32x4 (&acc)[2][2][4][2], const Unit& u, int wr, int wc, int fr_, int fq_) const {
        const int fr = fr_ + opaque0(), fq = fq_ + opaque0();
        EPI_LOOP_BEGIN
            const float w = roww[row] * (1.f / (H8_SCALE * WD8_SCALE));
            *(u32x4*)(Y + (size_t)row * DM + u.pn * BM + colt) = pack8(acc[ai][bj][m][0] * w, acc[ai][bj][m][1] * w);
        EPI_LOOP_END
    }
};
}

namespace att {
constexpr int SHM_K = 16384, SHM_V = 16384;
constexpr int L_V = 0, L_K = 2 * SHM_V;
constexpr int OST_STRIDE = 68, OST_WAVE = 32 * OST_STRIDE * 4;
constexpr int L_OST = 65536;
constexpr int L_TAB = 136 * 1024;
constexpr int L_SELPFX = 148 * 1024;
#define KSWZ(row, colB) ((row) * 256 + ((colB) ^ (((row) & 7) << 4)))
#define SBAR() __builtin_amdgcn_sched_barrier(0)
__device__ __forceinline__ int v_st(int k, int c) { const int kk = (k & ~0xC) | ((k & 4) << 1) | ((k & 8) >> 1); return ((kk >> 3) * 4 + (c >> 5)) * 512 + ((kk & 7) * 32 + (c & 31)) * 2; }
__device__ __forceinline__ int v_rd_base(int lane) { return ((lane & 3) << 3) | (((lane >> 2) & 3) << 6) | (((lane >> 4) & 1) << 5) | (((lane >> 5) & 1) << 8); }
constexpr int v_rd_off(int d0, int ks, int half) { return d0 * 512 + ks * 4096 + half * 2048; }
__device__ __forceinline__ int crow(int r, int hi) { return (r & 3) + 8 * (r >> 2) + 4 * hi; }

template <int KB>
__device__ __forceinline__ void qkt(f32x16& p0, f32x16& p1, const LAS char* K_lds, int r32, int hi, const bf16x8* qr, float bkc) {
#pragma unroll
    for (int r = 0; r < 16; ++r) { const float c_ = (float)((r & 3) + 8 * (r >> 2)); p0[r] = c_ * bkc; p1[r] = c_ * bkc; }
    const LAS char* kb[4];
#pragma unroll
    for (int dd = 0; dd < 4; ++dd) kb[dd] = K_lds + KB * SHM_K + KSWZ(r32, (dd * 16 + hi * 8) * 2);
#pragma unroll
    for (int d0 = 0; d0 < 8; ++d0) { const LAS char* a = kb[d0 & 3] + (d0 >> 2) * 128;
        bf16x8 b0 = *reinterpret_cast<const LAS bf16x8*>(a);
        bf16x8 b1 = *reinterpret_cast<const LAS bf16x8*>(a + 32 * 256);
        p0 = __builtin_amdgcn_mfma_f32_32x32x16_bf16(b0, qr[d0], p0, 0, 0, 0);
        p1 = __builtin_amdgcn_mfma_f32_32x32x16_bf16(b1, qr[d0], p1, 0, 0, 0); }
}
template <int VB>
__device__ __forceinline__ void pv_tile(f32x16* o, int vb0, bf16x8 pa0, bf16x8 pa1, bf16x8 pa2, bf16x8 pa3) {
#define TRRD(dst, off) asm volatile("ds_read_b64_tr_b16 %0, %1 offset:%2" : "=&v"(dst) : "v"(vb0), "i"(off) : "memory")
#define PV_D0(d0) do { s16x4 l0, l1, l2, l3, h0, h1, h2, h3; constexpr int b_ = VB * SHM_V + v_rd_off(d0, 0, 0); \
        TRRD(l0, b_); TRRD(h0, b_ + 2048); TRRD(l1, b_ + 4096); TRRD(h1, b_ + 6144); TRRD(l2, b_ + 8192); TRRD(h2, b_ + 10240); TRRD(l3, b_ + 12288); TRRD(h3, b_ + 14336); \
        asm volatile("s_waitcnt lgkmcnt(0)" ::: "memory"); SBAR(); \
        o[d0] = __builtin_amdgcn_mfma_f32_32x32x16_bf16((bf16x8){l0[0], l0[1], l0[2], l0[3], h0[0], h0[1], h0[2], h0[3]}, pa0, o[d0], 0, 0, 0); \
        o[d0] = __builtin_amdgcn_mfma_f32_32x32x16_bf16((bf16x8){l1[0], l1[1], l1[2], l1[3], h1[0], h1[1], h1[2], h1[3]}, pa1, o[d0], 0, 0, 0); \
        o[d0] = __builtin_amdgcn_mfma_f32_32x32x16_bf16((bf16x8){l2[0], l2[1], l2[2], l2[3], h2[0], h2[1], h2[2], h2[3]}, pa2, o[d0], 0, 0, 0); \
        o[d0] = __builtin_amdgcn_mfma_f32_32x32x16_bf16((bf16x8){l3[0], l3[1], l3[2], l3[3], h3[0], h3[1], h3[2], h3[3]}, pa3, o[d0], 0, 0, 0); } while (0)
    PV_D0(0); PV_D0(1); PV_D0(2); PV_D0(3);
#undef PV_D0
#undef TRRD
}

struct Parts { const bf16* pbase[3]; const float* plse[3]; const float* psc[3]; };
template <int NMERGE>
__device__ __forceinline__ void row_epilogue(f32x16 (&o)[4], float m_reg, float l_reg, int hi, bf16* dstb, long ro, float* lseb, float* scb, int li, int nparts, const Parts& P) {
    const bool ok = ro >= 0; const long rr = ok ? ro : 0; const int lj = ok ? li : 0;
    float M = (l_reg > 0.f) ? m_reg : -__builtin_inff();
    float L[3] = {-__builtin_inff(), -__builtin_inff(), -__builtin_inff()};
    if constexpr (NMERGE > 0) {
#pragma unroll
        for (int s = 0; s < NMERGE; ++s) if (s < nparts) { L[s] = P.plse[s][lj]; M = fmaxf(M, L[s]); }
    }
    const float f_own = (l_reg > 0.f) ? __builtin_amdgcn_exp2f(m_reg - M) : 0.f;
    float tot = l_reg * f_own; float fs[3] = {0.f, 0.f, 0.f};
    if constexpr (NMERGE > 0) {
#pragma unroll
        for (int s = 0; s < NMERGE; ++s) if (s < nparts) { fs[s] = (L[s] > -__builtin_inff()) ? __builtin_amdgcn_exp2f(L[s] - M) : 0.f; tot += fs[s]; }
    }
    const float inv = tot > 0.f ? 1.f / tot : 0.f, sc = f_own * inv;
    if (lseb != nullptr && ok && hi == 0) lseb[li] = (l_reg > 0.f) ? (m_reg + __builtin_log2f(l_reg)) : -__builtin_inff();
    if constexpr (NMERGE > 0) {
#pragma unroll
        for (int s = 0; s < NMERGE; ++s) fs[s] = (s < nparts) ? fs[s] * inv * P.psc[s][lj] : 0.f;
#pragma unroll
        for (int d0 = 0; d0 < 4; ++d0) {
#pragma unroll
            for (int r = 0; r < 16; ++r) o[d0][r] *= sc;
#pragma unroll
            for (int s = 0; s < NMERGE; ++s) if (s < nparts) { const float f = fs[s];
#pragma unroll
                for (int p = 0; p < 2; ++p) { const u32x2 w = *(const u32x2*)((const unsigned char*)P.pbase[s] + rr + 32 * d0 + 16 * p + 8 * hi);
                    auto q2 = __builtin_amdgcn_permlane32_swap(w.x, w.y, false, false);
#pragma unroll
                    for (int e = 0; e < 4; ++e) { o[d0][8 * p + e] += f * (float)(int)(signed char)((q2[0] >> (8 * e)) & 255u); o[d0][8 * p + 4 + e] += f * (float)(int)(signed char)((q2[1] >> (8 * e)) & 255u); } } }
#pragma unroll
            for (int p = 0; p < 2; ++p) {
                const unsigned ax = cvt_pk_bf16(o[d0][8 * p + 0], o[d0][8 * p + 1]), ay = cvt_pk_bf16(o[d0][8 * p + 2], o[d0][8 * p + 3]);
                const unsigned bx_ = cvt_pk_bf16(o[d0][8 * p + 4], o[d0][8 * p + 5]), by = cvt_pk_bf16(o[d0][8 * p + 6], o[d0][8 * p + 7]);
                auto r0 = __builtin_amdgcn_permlane32_swap(ax, bx_, false, false); auto r1 = __builtin_amdgcn_permlane32_swap(ay, by, false, false);
                const u32x4 w = {r0[0], r1[0], r0[1], r1[1]};
                if (ok) *(u32x4*)(dstb + rr + 32 * d0 + 16 * p + 8 * hi) = w;
            }
        }
    } else {
        float mx = 0.f;
#pragma unroll
        for (int d0 = 0; d0 < 4; ++d0)
#pragma unroll
            for (int r = 0; r < 16; ++r) { o[d0][r] *= sc; mx = fmaxf(mx, fabsf(o[d0][r])); }
        { auto rx = __builtin_amdgcn_permlane32_swap(__float_as_uint(mx), __float_as_uint(mx), false, false); mx = fmaxf(__uint_as_float(rx[0]), __uint_as_float(rx[1])); }
        const float qs = mx > 0.f ? 127.f / mx : 0.f;
        if (ok && hi == 0) scb[li] = mx * (1.f / 127.f);
#pragma unroll
        for (int d0 = 0; d0 < 4; ++d0)
#pragma unroll
            for (int p = 0; p < 2; ++p) {
                const unsigned a = pk_i8x4(o[d0][8 * p + 0] * qs, o[d0][8 * p + 1] * qs, o[d0][8 * p + 2] * qs, o[d0][8 * p + 3] * qs);
                const unsigned b = pk_i8x4(o[d0][8 * p + 4] * qs, o[d0][8 * p + 5] * qs, o[d0][8 * p + 6] * qs, o[d0][8 * p + 7] * qs);
                auto q2 = __builtin_amdgcn_permlane32_swap(a, b, false, false);
                const u32x2 w = {q2[0], q2[1]};
                if (ok) *(u32x2*)((unsigned char*)dstb + rr + 32 * d0 + 16 * p + 8 * hi) = w;
            }
    }
}
struct UD { const bf16* Q; const bf16* K; const bf16* V; int qoff, qpos, kp0, kst, t_lo, t_hi, w_lo, w_hi, W; float sl2; int ro, li, nparts; };
struct ND { const bf16* Q; const bf16* K; const bf16* V; int qoff, kp0, kst, t_lo; };
struct PF { bf16x8 qr[8]; bf16x8 k0, k1, v0, v1; };
__device__ __forceinline__ void attn_prefetch(const ND& d, PF& pf) {
    const int hi = lane_fresh() >> 5;
#pragma unroll
    for (int d0 = 0; d0 < 8; ++d0) pf.qr[d0] = *(const bf16x8*)(d.Q + d.qoff + d0 * 16 + hi * 8);
}
__device__ __forceinline__ void attn_prime(LAS char* lds, const ND& d, PF& pf) {
    const int tid = __builtin_amdgcn_readfirstlane((int)threadIdx.x >> 6) * 64 + lane_fresh(), sr = tid >> 4, sc = (tid & 15) * 8;
    const int p0_ = (d.kp0 + (64 * d.t_lo + sr) * d.kst) * WQ + sc, p1_ = p0_ + 32 * d.kst * WQ, p2_ = p0_ + 64 * d.kst * WQ, p3_ = p0_ + 96 * d.kst * WQ;
    const bf16x8 k0 = *(const bf16x8*)(d.K + p0_), k1 = *(const bf16x8*)(d.K + p1_), v0 = *(const bf16x8*)(d.V + p0_), v1 = *(const bf16x8*)(d.V + p1_);

    pf.k0 = *(const bf16x8*)(d.K + p2_); pf.k1 = *(const bf16x8*)(d.K + p3_); pf.v0 = *(const bf16x8*)(d.V + p2_); pf.v1 = *(const bf16x8*)(d.V + p3_);
    __syncthreads();
    *(LAS bf16x8*)(lds + L_K + KSWZ(sr, sc * 2)) = k0; *(LAS bf16x8*)(lds + L_K + KSWZ(sr, sc * 2) + 32 * 256) = k1;
    *(LAS bf16x8*)(lds + L_V + v_st(sr, sc)) = v0; *(LAS bf16x8*)(lds + L_V + v_st(32 + sr, sc)) = v1;
    __syncthreads();
}
template <int NMERGE, int MASKMODE>
__device__ __forceinline__ void attn_unit(LAS char* lds, const UD& d, bf16* dstb, float* lseb, float* scb, const Parts& P, PF& pf, bool has_next, const ND& nd) {
    const int lane = lane_fresh(), wid = __builtin_amdgcn_readfirstlane((int)threadIdx.x >> 6), tid = wid * 64 + lane, r32 = lane & 31, hi = lane >> 5;
    LAS char* V_lds = lds + L_V; LAS char* K_lds = lds + L_K;
    LAS float* tab = (LAS float*)(lds + L_TAB + wid * 1024);
    LAS float* al_l = tab; LAS float* li_l = tab + 32; LAS float* fac = tab + 96;
    const bf16* Kh = d.K; const bf16* Vh = d.V;
    const int kp0 = d.kp0, kst = d.kst, t_lo = d.t_lo, t_hi = d.t_hi, w_lo = d.w_lo, w_hi = d.w_hi, W = d.W, qpos = d.qpos, li = d.li, nparts = d.nparts;
    const float sl2 = d.sl2; const long ro = (long)d.ro;
    bf16x8 (&qr)[8] = pf.qr;
    float m_reg = -1e30f, l_reg = 0.f; f32x16 o[4] = {};
    const float qposf = (float)qpos, kstf = (float)kst;
    const float bk = sl2 * kstf, bkc = bk * (1.f / SM_C2), Wf = (float)W;
    const int qlo = __builtin_amdgcn_readfirstlane(qpos), qhi = qlo + 31 * kst;
    const int sr = tid >> 4, sc = (tid & 15) * 8, vst0 = v_st(sr, sc), vst1 = v_st(32 + sr, sc), kws = KSWZ(sr, sc * 2);
    const int vb0 = (int)(uintptr_t)V_lds + v_rd_base(lane);
    bf16x8 s0_k0, s0_k1, s0_v0, s0_v1;
    bf16x8 &s1_k0 = pf.k0, &s1_k1 = pf.k1, &s1_v0 = pf.v0, &s1_v1 = pf.v1;
#define A_LOAD2(SET, tt) do { const bool own_ = (tt) < t_hi; const bf16* Kp_ = own_ ? Kh : nd.K; const bf16* Vp_ = own_ ? Vh : nd.V; \
        const int kp_ = own_ ? kp0 : nd.kp0, ks_ = own_ ? kst : nd.kst, ti_ = own_ ? (tt) : (tt) - t_hi + nd.t_lo; \
        const int p0_ = (kp_ + (64 * ti_ + sr) * ks_) * WQ + sc, p1_ = p0_ + 32 * ks_ * WQ; \
        s##SET##_k0 = *(const bf16x8*)(Kp_ + p0_); s##SET##_k1 = *(const bf16x8*)(Kp_ + p1_); s##SET##_v0 = *(const bf16x8*)(Vp_ + p0_); s##SET##_v1 = *(const bf16x8*)(Vp_ + p1_); } while (0)
#define A_WRITE2(SET) do { *(LAS bf16x8*)(K_lds + (SET) * SHM_K + kws) = s##SET##_k0; *(LAS bf16x8*)(K_lds + (SET) * SHM_K + kws + 32 * 256) = s##SET##_k1; \
        *(LAS bf16x8*)(V_lds + (SET) * SHM_V + vst0) = s##SET##_v0; *(LAS bf16x8*)(V_lds + (SET) * SHM_V + vst1) = s##SET##_v1; } while (0)
#define A_STEP(KB, t) do { \
        if (KB == 0) A_LOAD2(0, (t) + 2); else A_LOAD2(1, (t) + 2);     \
        if ((t) >= w_lo && (t) <= w_hi) { \
            float bk_ = bk, bkc_ = bkc, kst_ = kstf; asm volatile("" : "+v"(bk_), "+v"(bkc_), "+v"(kst_));     \
            f32x16 p0, p1; SBAR(); qkt<KB>(p0, p1, K_lds, r32, hi, qr, bkc_); \
              \
            const float d0f = qposf - (float)(kp0 + (64 * (t) + 4 * hi) * kst); const float t0 = -sl2 * d0f, t1 = fmaf(32.f, bk_, t0); \
            bool needm = false; \
            if (MASKMODE != 0) { const int kfirst = kp0 + 64 * (t) * kst, klast = kfirst + 63 * kst; needm = !((qlo - klast >= 0) && (MASKMODE == 1 || qhi - kfirst <= W)); } \
            float pmax = -__builtin_inff(); \
            if (needm) { \
                _Pragma("unroll") for (int r = 0; r < 16; ++r) { const float c_ = (float)((r & 3) + 8 * (r >> 2)); \
                    const float a0 = fmaf(-c_, kst_, d0f), a1 = a0 - 32.f * kst_;        \
                    float z0 = fmaf(p0[r], SM_C2, t0), z1 = fmaf(p1[r], SM_C2, t1); \
                    const bool v0_ = (MASKMODE == 1) ? (a0 >= 0.f) : (__builtin_amdgcn_fmed3f(a0, 0.f, Wf) == a0), v1_ = (MASKMODE == 1) ? (a1 >= 0.f) : (__builtin_amdgcn_fmed3f(a1, 0.f, Wf) == a1); \
                    z0 = v0_ ? z0 : -__builtin_inff(); z1 = v1_ ? z1 : -__builtin_inff(); \
                    p0[r] = z0; p1[r] = z1; pmax = fmaxf(pmax, fmaxf(z0, z1)); } \
            } else { \
                _Pragma("unroll") for (int r = 0; r < 16; ++r) { const float z0 = fmaf(p0[r], SM_C2, t0), z1 = fmaf(p1[r], SM_C2, t1); p0[r] = z0; p1[r] = z1; pmax = fmaxf(pmax, fmaxf(z0, z1)); } \
            } \
            { auto rr = __builtin_amdgcn_permlane32_swap(__float_as_uint(pmax), __float_as_uint(pmax), false, false); pmax = fmaxf(__uint_as_float(rr[0]), __uint_as_float(rr[1])); } \
            float mn, alpha; \
            if (__all(pmax - m_reg <= 11.5f)) { mn = m_reg; alpha = 1.f; } \
            else { mn = fmaxf(m_reg, pmax); alpha = __builtin_amdgcn_exp2f(m_reg - mn); m_reg = mn; } \
            float ps = 0.f; \
            _Pragma("unroll") for (int r = 0; r < 16; ++r) { p0[r] = __builtin_amdgcn_exp2f(p0[r] - mn); p1[r] = __builtin_amdgcn_exp2f(p1[r] - mn); ps += p0[r] + p1[r]; } \
            { auto rr = __builtin_amdgcn_permlane32_swap(__float_as_uint(ps), __float_as_uint(ps), false, false); ps = __uint_as_float(rr[0]) + __uint_as_float(rr[1]); } \
            l_reg = l_reg * alpha + ps; \
            bf16x8 pa0, pa1, pa2, pa3; \
            A_PK4(p0, 0, pa0); A_PK4(p0, 8, pa1); A_PK4(p1, 0, pa2); A_PK4(p1, 8, pa3); \
            if (__any(alpha < 1.f)) { _Pragma("unroll") for (int d_ = 0; d_ < 4; ++d_) _Pragma("unroll") for (int r = 0; r < 16; ++r) o[d_][r] *= alpha; }     \
            SBAR(); pv_tile<KB>(o, vb0, pa0, pa1, pa2, pa3); \
        } \
        if (KB == 0) A_WRITE2(1); else A_WRITE2(0); \
        __syncthreads(); } while (0)
#define A_PK4(Pv, B_, OUT) do { unsigned a0 = cvt_pk_bf16(Pv[B_ + 0], Pv[B_ + 1]), a1 = cvt_pk_bf16(Pv[B_ + 2], Pv[B_ + 3]); \
        unsigned b0 = cvt_pk_bf16(Pv[B_ + 4], Pv[B_ + 5]), b1 = cvt_pk_bf16(Pv[B_ + 6], Pv[B_ + 7]); \
        auto r0 = __builtin_amdgcn_permlane32_swap(a0, b0, false, false); auto r1 = __builtin_amdgcn_permlane32_swap(a1, b1, false, false); \
        u32x4 w_ = {r0[0], r1[0], r0[1], r1[1]}; OUT = __builtin_bit_cast(bf16x8, w_); } while (0)
    for (int t = t_lo; t < t_hi; t += 2) {
        A_STEP(0, t);
        if (t + 1 < t_hi) A_STEP(1, t + 1);
    }
#undef A_STEP
#undef A_PK4
#undef A_LOAD2
#undef A_WRITE2
    if (has_next) attn_prefetch(nd, pf);
    row_epilogue<NMERGE>(o, m_reg, l_reg, hi, dstb, ro, lseb, scb, li, nparts, P);
}

__device__ __forceinline__ void attn_sel_chunks(LAS char* lds, int c0, int c1, const LAS int* pfx, const unsigned* cnts  , const unsigned* buck,
                                                const bf16* QM, const bf16* KM, const bf16* VM, bf16* PM, float* LM, float* SM) {
    const int lane = lane_fresh(), wid = __builtin_amdgcn_readfirstlane((int)threadIdx.x >> 6), tid = wid * 64 + lane, r32 = lane & 31, hi = lane >> 5;
    LAS char* V_lds = lds; LAS char* K_lds = lds + 65536;
    LAS float* tab = (LAS float*)(lds + L_TAB + wid * 1024);
    LAS float* al_l = tab; LAS float* fc_l = tab + 32; LAS int* ro_l = (LAS int*)(tab + 64);
    const int sr = tid >> 4, sc = (tid & 15) * 8, vst0 = v_st(sr, sc), vst1 = v_st(32 + sr, sc), kws = KSWZ(sr, sc * 2);
    const int vb0 = (int)(uintptr_t)V_lds + v_rd_base(lane);
    if (c0 >= c1) return;
    int bk = 0; { int klo = 0, khi = 1024; while (khi - klo > 1) { const int mid = (klo + khi) >> 1; if (pfx[mid] <= c0) klo = mid; else khi = mid; } bk = klo; }
    int cur_bk = -1;
#define S_QUERY(ch_, BK, E, QP, VALID, QF) do { int bk_ = (BK); while (pfx[bk_ + 1] <= (ch_)) ++bk_; (BK) = bk_; \
        const int chunk_ = (ch_) - pfx[bk_], bh_ = bk_ >> 5, j_ = bk_ & 31; \
        const int cnt_ = (int)__hip_atomic_load(cnts + 64 * bk_, RLX_AGENT); const int idx_ = chunk_ * 256 + wid * 32 + r32; \
        VALID = idx_ < cnt_; E = 0; if (VALID) E = buck[(size_t)bh_ * BUCK_PER_BH + buck_off(j_) + idx_]; \
        QP = VALID ? (int)(E & 0xffffu) : (j_ + 1) * 256; \
        const bf16* qrow_ = QM + ((bh_ >> 3) * SEQ) * WQ + (bh_ & 7) * HD + QP * WQ; \
        _Pragma("unroll") for (int d0 = 0; d0 < 8; ++d0) QF[d0] = *(const bf16x8*)(qrow_ + d0 * 16 + hi * 8); } while (0)
    bf16x8 qr[8], qn[8]; unsigned e = 0, en = 0; int qpos = 0, qposn = 0, bkn = bk; bool valid = false, validn = false;
    S_QUERY(c0, bkn, en, qposn, validn, qn);
#pragma unroll 1
    for (int ch = c0; ch < c1; ++ch) {
        while (pfx[bk + 1] <= ch) ++bk;
        const int bh = bk >> 5, j = bk & 31, b = bh >> 3, h = bh & 7;
        const int hb = (b * SEQ) * WQ + h * HD;
        e = en; qpos = qposn; valid = validn;
#pragma unroll
        for (int d0 = 0; d0 < 8; ++d0) qr[d0] = qn[d0];
        if (ch + 1 < c1) S_QUERY(ch + 1, bkn, en, qposn, validn, qn);
        if (bk != cur_bk) {
            cur_bk = bk;
            __syncthreads();
#pragma unroll
            for (int half = 0; half < 2; ++half) {
                bf16x8 k0[2], k1[2], v0[2], v1[2];
#pragma unroll
                for (int tt = 0; tt < 2; ++tt) { const int p0_ = hb + (j * 256 + 64 * (2 * half + tt) + sr) * WQ + sc, p1_ = p0_ + 32 * WQ;
                    k0[tt] = *(const bf16x8*)(KM + p0_); k1[tt] = *(const bf16x8*)(KM + p1_); v0[tt] = *(const bf16x8*)(VM + p0_); v1[tt] = *(const bf16x8*)(VM + p1_); }
#pragma unroll
                for (int tt = 0; tt < 2; ++tt) { const int T = 2 * half + tt;
                    *(LAS bf16x8*)(K_lds + T * SHM_K + kws) = k0[tt]; *(LAS bf16x8*)(K_lds + T * SHM_K + kws + 32 * 256) = k1[tt];
                    *(LAS bf16x8*)(V_lds + T * SHM_V + vst0) = v0[tt]; *(LAS bf16x8*)(V_lds + T * SHM_V + vst1) = v1[tt]; }
            }
            __syncthreads();
        }
        if (!__any(valid)) continue;
        const int slot = (int)(e >> 16);
        const float sl2 = __builtin_amdgcn_exp2f(-0.5f * (float)(2 * h + 1)) * LOG2E;
        const float bkc = sl2 * (1.f / SM_C2), qposf = (float)qpos;
        float m_reg = -1e30f, l_reg = 0.f; f32x16 o[4] = {};
#define S_TILE(KB) do { \
            float bkc_ = bkc; asm volatile("" : "+v"(bkc_)); \
            f32x16 p0, p1; SBAR(); qkt<KB>(p0, p1, K_lds, r32, hi, qr, bkc_); \
            const float t0 = -sl2 * (qposf - (float)(j * 256 + 64 * (KB) + 4 * hi)), t1 = fmaf(32.f, sl2, t0); \
            float pmax = -__builtin_inff(); \
            _Pragma("unroll") for (int r = 0; r < 16; ++r) { const float z0 = fmaf(p0[r], SM_C2, t0), z1 = fmaf(p1[r], SM_C2, t1); p0[r] = z0; p1[r] = z1; pmax = fmaxf(pmax, fmaxf(z0, z1)); } \
            { auto rr = __builtin_amdgcn_permlane32_swap(__float_as_uint(pmax), __float_as_uint(pmax), false, false); pmax = fmaxf(__uint_as_float(rr[0]), __uint_as_float(rr[1])); } \
            float mn, alpha; \
            if (__all(pmax - m_reg <= 11.5f)) { mn = m_reg; alpha = 1.f; } \
            else { mn = fmaxf(m_reg, pmax); alpha = __builtin_amdgcn_exp2f(m_reg - mn); m_reg = mn; } \
            float ps = 0.f; \
            _Pragma("unroll") for (int r = 0; r < 16; ++r) { p0[r] = __builtin_amdgcn_exp2f(p0[r] - mn); p1[r] = __builtin_amdgcn_exp2f(p1[r] - mn); ps += p0[r] + p1[r]; } \
            { auto rr = __builtin_amdgcn_permlane32_swap(__float_as_uint(ps), __float_as_uint(ps), false, false); ps = __uint_as_float(rr[0]) + __uint_as_float(rr[1]); } \
            l_reg = l_reg * alpha + ps; \
            bf16x8 pa0, pa1, pa2, pa3; \
            S_PK4(p0, 0, pa0); S_PK4(p0, 8, pa1); S_PK4(p1, 0, pa2); S_PK4(p1, 8, pa3); \
            if (__any(alpha < 1.f)) { _Pragma("unroll") for (int d_ = 0; d_ < 4; ++d_) _Pragma("unroll") for (int r = 0; r < 16; ++r) o[d_][r] *= alpha; } \
            SBAR(); pv_tile<KB>(o, vb0, pa0, pa1, pa2, pa3); } while (0)
#define S_PK4(Pv, B_, OUT) do { unsigned a0 = cvt_pk_bf16(Pv[B_ + 0], Pv[B_ + 1]), a1 = cvt_pk_bf16(Pv[B_ + 2], Pv[B_ + 3]); \
        unsigned b0 = cvt_pk_bf16(Pv[B_ + 4], Pv[B_ + 5]), b1 = cvt_pk_bf16(Pv[B_ + 6], Pv[B_ + 7]); \
        auto r0 = __builtin_amdgcn_permlane32_swap(a0, b0, false, false); auto r1 = __builtin_amdgcn_permlane32_swap(a1, b1, false, false); \
        u32x4 w_ = {r0[0], r1[0], r0[1], r1[1]}; OUT = __builtin_bit_cast(bf16x8, w_); } while (0)
        S_TILE(0); S_TILE(1); S_TILE(2); S_TILE(3);
#undef S_TILE
#undef S_PK4
        { const Parts nop{};
          row_epilogue<0>(o, m_reg, l_reg, hi, PM, valid ? (long)(slot * (NTOK * WQ) + hb + qpos * WQ) : -1L, LM, SM, slot * (NTOK * 8) + (b * SEQ + qpos) * 8 + h, 0, nop); }
    }
#undef S_QUERY
}
#undef SBAR
}

struct Args { const float* in[16]; float* out; unsigned char* ws; int ph_lo, ph_hi, dry, pad; };

__device__ __forceinline__ void transpose_item(const float* W, int N, int k0, int n0, bf16* WT, int ldk, long orow0, LAS float* scr, int lane) {
#pragma unroll 8
    for (int i = 0; i < 32; ++i) { const int kk = 2 * i + (lane >> 5); scr[kk * 33 + (lane & 31)] = W[(size_t)(k0 + kk) * N + n0 + (lane & 31)]; }
    LDS_WAIT(); asm volatile("" ::: "memory");
    const int c = lane & 7;
#pragma unroll
    for (int j = 0; j < 4; ++j) { const int n = (lane >> 3) + 8 * j; const LAS float* s = scr + (8 * c) * 33 + n;
        u32x4 o; o.x = cvt_pk_bf16(s[0 * 33], s[1 * 33]); o.y = cvt_pk_bf16(s[2 * 33], s[3 * 33]); o.z = cvt_pk_bf16(s[4 * 33], s[5 * 33]); o.w = cvt_pk_bf16(s[6 * 33], s[7 * 33]);
        *(u32x4*)(WT + (size_t)(orow0 + n) * ldk + k0 + 8 * c) = o; }
    LDS_WAIT(); asm volatile("" ::: "memory");
}

__device__ __forceinline__ void transpose_item_i8(const float* W, int N, int k0, int n0, unsigned char* WT, int ldk, long orow0, float cscale, LAS float* scr, int lane) {
#pragma unroll 8
    for (int i = 0; i < 32; ++i) { const int kk = 2 * i + (lane >> 5); scr[kk * 33 + (lane & 31)] = W[(size_t)(k0 + kk) * N + n0 + (lane & 31)] * cscale; }
    LDS_WAIT(); asm volatile("" ::: "memory");
    const int c = lane & 7;
#pragma unroll
    for (int j = 0; j < 4; ++j) { const int n = (lane >> 3) + 8 * j; const LAS float* s = scr + (8 * c) * 33 + n;
        u32x2 o; o.x = pk_i8x4(s[0 * 33], s[1 * 33], s[2 * 33], s[3 * 33]); o.y = pk_i8x4(s[4 * 33], s[5 * 33], s[6 * 33], s[7 * 33]);
        *(u32x2*)(WT + (size_t)(orow0 + n) * ldk + k0 + 8 * c) = o; }
    LDS_WAIT(); asm volatile("" ::: "memory");
}
__device__ __forceinline__ void transpose_regs_i8(const float (&v)[32], int k0, unsigned char* WT, int ldk, long orow0, float cscale, LAS float* scr, int lane) {
#pragma unroll
    for (int i = 0; i < 32; ++i) scr[(2 * i + (lane >> 5)) * 33 + (lane & 31)] = v[i] * cscale;
    LDS_WAIT(); asm volatile("" ::: "memory");
    const int c = lane & 7;
#pragma unroll
    for (int j = 0; j < 4; ++j) { const int n = (lane >> 3) + 8 * j; const LAS float* s = scr + (8 * c) * 33 + n;
        u32x2 o; o.x = pk_i8x4(s[0 * 33], s[1 * 33], s[2 * 33], s[3 * 33]); o.y = pk_i8x4(s[4 * 33], s[5 * 33], s[6 * 33], s[7 * 33]);
        *(u32x2*)(WT + (size_t)(orow0 + n) * ldk + k0 + 8 * c) = o; }
    LDS_WAIT(); asm volatile("" ::: "memory");
}
__device__ __forceinline__ void transpose_item_fp8(const float* W, int N, int k0, int n0, unsigned char* WT, int ldk, long orow0, float scale, LAS float* scr, int lane) {
#pragma unroll 8
    for (int i = 0; i < 32; ++i) { const int kk = 2 * i + (lane >> 5); scr[kk * 33 + (lane & 31)] = W[(size_t)(k0 + kk) * N + n0 + (lane & 31)] * scale; }
    LDS_WAIT(); asm volatile("" ::: "memory");
    const int c = lane & 7;
#pragma unroll
    for (int j = 0; j < 4; ++j) { const int n = (lane >> 3) + 8 * j; const LAS float* s = scr + (8 * c) * 33 + n;
        u32x2 o; o.x = pk_fp8x4(s[0 * 33], s[1 * 33], s[2 * 33], s[3 * 33]); o.y = pk_fp8x4(s[4 * 33], s[5 * 33], s[6 * 33], s[7 * 33]);
        *(u32x2*)(WT + (size_t)(orow0 + n) * ldk + k0 + 8 * c) = o; }
    LDS_WAIT(); asm volatile("" ::: "memory");
}

__global__ void __launch_bounds__(NWAVES * 64, 2) mk_fwd(Args args) {
    extern __shared__ __attribute__((aligned(16))) unsigned char lds_raw[];
    LAS unsigned char* lds = (LAS unsigned char*)lds_raw;
    volatile LAS unsigned* MISC = (volatile LAS unsigned*)(lds + MISC_OFF);
    const int wave = __builtin_amdgcn_readfirstlane((int)threadIdx.x >> 6);
#define PHASE_IDS const int lane = lane_fresh(), tid = wave * 64 + lane; (void)tid; (void)lane
    PHASE_IDS;
    const int G = gridDim.x, bx = blockIdx.x;
    const int vcu = (G % 8 == 0) ? (bx % 8) * (G / 8) + bx / 8 : bx;
    unsigned char* ws = args.ws;
    gu32* ctl = (gu32*)(ws + WS_CTL);
    for (int u = tid; u < (LDS_BYTES - RING_BYTES) / 4; u += NWAVES * 64) ((LAS unsigned*)(lds + RING_BYTES))[u] = 0u;
    __syncthreads();
    XcdBarrier bar; bar.bar = (unsigned*)ctl + CW_BAR; bar.x = 0; bar.st = nullptr;
    if (MK_N_LAUNCHES == 1 && !MK_DEBUG) bar = xcd_barrier_post((unsigned*)ctl + CW_BAR, MISC + 8);
    const int lo = args.ph_lo, hi_ph = args.ph_hi;
#define IN(k) (lo <= (k) && (k) < hi_ph)
#define SEAM(k) do { if (IN(k) && IN((k) + 1)) xcd_barrier(bar); } while (0)
    const int gw = vcu * NWAVES + wave, NGW = G * NWAVES;

    const float* x = args.in[0];
    bf16* Hb = (bf16*)(ws + WS_H);
    bf16* QM = (bf16*)(ws + WS_QM); bf16* KM = (bf16*)(ws + WS_KM); bf16* VM = (bf16*)(ws + WS_VM);
    bf16* QD = (bf16*)(ws + WS_QD); bf16* KD = (bf16*)(ws + WS_KD); bf16* VD = (bf16*)(ws + WS_VD);
    bf16* PM = (bf16*)(ws + WS_PM); bf16* PD = (bf16*)(ws + WS_PD);
    float* LM = (float*)(ws + WS_LM); float* LD = (float*)(ws + WS_LD); float* SM = (float*)(ws + WS_SM); float* SD = (float*)(ws + WS_SD);
    float* kmean = (float*)(ws + WS_KMEAN);
    unsigned* buck = (unsigned*)(ws + WS_BUCK);
    bf16* GATES = (bf16*)(ws + WS_GATES); bf16* MIX = (bf16*)(ws + WS_MIX); bf16* GINV = (bf16*)(ws + WS_GINV);
    float* X1 = (float*)(ws + WS_X1);
    int* EID = (int*)(ws + WS_EID); float* EW = (float*)(ws + WS_EW); float* RMS = (float*)(ws + WS_RMS); int* POS = (int*)(ws + WS_POS);
    int* ROWTOK = (int*)(ws + WS_ROWTOK); float* ROWW = (float*)(ws + WS_ROWW);
    bf16* WR = (bf16*)(ws + WS_WR);

    if (IN(0)) {
        PHASE_IDS;
        LAS float* scr = (LAS float*)(lds + wave * 16384);
        constexpr int I_IN = 32 * 320, I_OM = 16 * 64, I_O = 32 * 64;
        constexpr int NIT = I_IN + 2 * I_OM; (void)I_O;
        for (int it = gw; it < NIT; it += NGW) {
            int r = it;
            if (r < I_IN) { const int kb = r / 320, nb = r % 320;
                if (32 * nb < NBF) transpose_item(args.in[2], 10240, 64 * kb, 32 * nb, (bf16*)(ws + WS_WIN), 2048, 32 * nb, scr, lane);
                continue; } r -= I_IN;
            if (r < I_OM) { const int kb = r / 64, nb = r % 64; transpose_item(args.in[4], 2048, 64 * kb, 32 * nb, (bf16*)(ws + WS_WOM), 2048, 32 * nb, scr, lane); continue; } r -= I_OM;
            if (r < I_OM) { const int kb = r / 64, nb = r % 64; transpose_item(args.in[5], 2048, 64 * kb, 32 * nb, (bf16*)(ws + WS_WOM) + 1024, 2048, 32 * nb, scr, lane); continue; } r -= I_OM;
            (void)r;
        }
        {
            LAS float* cmax = (LAS float*)(lds + 136 * 1024);
            float* colsc = (float*)(ws + WS_CS8);
            constexpr int NG_IN = (10240 - NBF) / 32, NG_WO = 2048 / 32;
            for (int grp = vcu; grp < NG_IN + NG_WO; grp += G) {
                const bool is_wo = grp >= NG_IN;
                const int lane = lane_fresh();
                const float* Wsrc = is_wo ? args.in[6] : args.in[2]; const int Nsrc = is_wo ? 2048 : 10240;
                const int n0 = is_wo ? 32 * (grp - NG_IN) : NBF + 32 * grp;
                float mx = 0.f;
                float vv[4][32];
#pragma unroll
                for (int q4 = 0; q4 < 4; ++q4) { const int kb = wave * 4 + q4;
#pragma unroll
                    for (int i = 0; i < 32; ++i) vv[q4][i] = Wsrc[(size_t)(64 * kb + 2 * i + (lane >> 5)) * Nsrc + n0 + (lane & 31)]; }
#pragma unroll
                for (int q4 = 0; q4 < 4; ++q4)
#pragma unroll
                    for (int i = 0; i < 32; ++i) mx = fmaxf(mx, fabsf(vv[q4][i]));
                mx = fmaxf(mx, __shfl_xor(mx, 32));
                __syncthreads();
                if (lane < 32) cmax[wave * 32 + lane] = mx;
                __syncthreads();
                float cm = 0.f;
#pragma unroll
                for (int w8 = 0; w8 < 8; ++w8) cm = fmaxf(cm, cmax[w8 * 32 + (lane & 31)]);
                int drow = is_wo ? n0 : n0 - NBF;
                if (!is_wo && n0 >= NQKV) { const int c = n0 - NQKV, which = c >> 11, cc = c & 2047; drow = (NQKV - NBF) + (cc >> 7) * 256 + which * 128 + (cc & 127); }
                if (wave == 0 && lane < 32) (is_wo ? (float*)(ws + WS_CSWO) : colsc)[drow + lane] = cm * (1.f / 127.f);
                const float cscale = cm > 0.f ? 127.f / cm : 0.f;
#pragma unroll
                for (int q4 = 0; q4 < 4; ++q4) transpose_regs_i8(vv[q4], 64 * (wave * 4 + q4), is_wo ? ws + WS_WO : ws + WS_WIN8, 2048, drow, cscale, scr, lane);
            }
        }
        for (int i = (bx * NWAVES * 64 + tid); i < 64 * 2048; i += G * NWAVES * 64) {
            const int row = i >> 11, k = i & 2047;
            float w = 0.f;
            if (row < 32) w = args.in[10][(size_t)k * 32 + row]; else if (row < 36) w = args.in[8][(size_t)k * 4 + (row - 32)];
            const unsigned h = cvt_pk_bf16(w, 0.f) & 0xffffu; const float lo_f = w - bf_lo(h);
            WR[i] = (bf16)h; WR[64 * 2048 + i] = (bf16)(cvt_pk_bf16(lo_f, 0.f) & 0xffffu);
        }
        const float* g1 = args.in[1];
        for (int m = gw; m < NTOK; m += NGW) {
            const float* xr = x + (size_t)m * DM;
            f32x4 v[8]; float s = 0.f;
#pragma unroll
            for (int j = 0; j < 4; ++j) { v[2 * j] = *(const f32x4*)(xr + j * 512 + lane * 8); v[2 * j + 1] = *(const f32x4*)(xr + j * 512 + lane * 8 + 4); }
#pragma unroll
            for (int j = 0; j < 8; ++j) s += (v[j].x * v[j].x + v[j].y * v[j].y) + (v[j].z * v[j].z + v[j].w * v[j].w);
            const float rs = 1.0f / sqrtf(wave_sum(s) * (1.f / DM) + RMS_EPS);
            float amax = 0.f;
#pragma unroll
            for (int j = 0; j < 4; ++j) { const f32x4 ga = *(const f32x4*)(g1 + j * 512 + lane * 8), gb = *(const f32x4*)(g1 + j * 512 + lane * 8 + 4);
                v[2 * j] = v[2 * j] * rs * ga; v[2 * j + 1] = v[2 * j + 1] * rs * gb;
                if (NBF > 0) *(u32x4*)(Hb + (size_t)m * DM + j * 512 + lane * 8) = pg8::pack8(v[2 * j], v[2 * j + 1]);
#pragma unroll
                for (int e = 0; e < 4; ++e) amax = fmaxf(amax, fmaxf(fabsf(v[2 * j][e]), fabsf(v[2 * j + 1][e]))); }
#pragma unroll
            for (int o = 1; o < 64; o <<= 1) amax = fmaxf(amax, __shfl_xor(amax, o));
            const float qs = amax > 0.f ? 127.f / amax : 0.f;
            if (lane == 0) ((float*)(ws + WS_RS8))[m] = amax * (1.f / 127.f);
#pragma unroll
            for (int j = 0; j < 4; ++j) { const f32x4 ha = v[2 * j] * qs, hb4 = v[2 * j + 1] * qs;
                u32x2 h8; h8.x = pk_i8x4(ha.x, ha.y, ha.z, ha.w); h8.y = pk_i8x4(hb4.x, hb4.y, hb4.z, hb4.w);
                *(u32x2*)(ws + WS_H8 + (size_t)m * DM + j * 512 + lane * 8) = h8; }
        }
    }
    if (IN(0) && IN(1)) xcd_barrier(bar);

    if (IN(1)) {
        { pg8::Gemm g{Hb, (const bf16*)(ws + WS_WIN), DM, nullptr, DM, Hb, 1 << 30}; pg8::StaticOrder S; S.init(NTOK, NBF, G, bx);
          pg8::EpiQKV E{QM, 0, nullptr, nullptr, nullptr};
          pg8::gemm_phase<pg8::EpiQKV, pg8::StaticOrder, true>(lds, g, S, E); }
        { pg8::Gemm g{(const bf16*)(ws + WS_H8), (const bf16*)(ws + WS_WIN8), DM / 2, nullptr, DM / 2, (const bf16*)(ws + WS_H8), 1 << 30}; pg8::StaticOrder S; S.init(NTOK, NQKV - NBF, G, bx);
          pg8::EpiQKV E{QM, NBF / 256, (const float*)(ws + WS_RS8), (const float*)(ws + WS_CS8), kmean};
          pg8::gemm_phase<pg8::EpiQKV, pg8::StaticOrder, true, false, QIN>(lds, g, S, E); }
    }
    if (IN(1) && IN(3)) xcd_barrier(bar);


    if (IN(3)) {
        PHASE_IDS;
        LAS int* hist = (LAS int*)lds;
        const int r32 = lane & 31, hi = lane >> 5;
        for (int u = bx; u < NB * NH * 32; u += G) {
            const int b = u >> 8, h = (u >> 5) & 7, qb = u & 31;
            if (qb == 0) continue;
            __syncthreads();
            if (tid < 64) hist[tid] = 0;
            __syncthreads();
            const int tq = qb * 256 + wave * 32 + r32;
            const bf16* qrow = QM + (size_t)(b * SEQ + tq) * WQ + h * HD;
            const float* km = kmean + (size_t)((b * NH + h) * 32 + r32) * HD;
            f32x16 acc = {};
#pragma unroll
            for (int s = 0; s < 8; ++s) {
                const bf16x8 qf = *(const bf16x8*)(qrow + s * 16 + hi * 8);
                const f32x4 ka = *(const f32x4*)(km + s * 16 + hi * 8), kb2 = *(const f32x4*)(km + s * 16 + hi * 8 + 4);
                const u32x4 kh = pg8::pack8(ka, kb2);
                f32x4 ha, hb; pg8::unpack8(kh, ha, hb);
                const u32x4 kl = pg8::pack8(ka - ha, kb2 - hb);
                acc = __builtin_amdgcn_mfma_f32_32x32x16_bf16(__builtin_bit_cast(bf16x8, kh), qf, acc, 0, 0, 0);
                acc = __builtin_amdgcn_mfma_f32_32x32x16_bf16(__builtin_bit_cast(bf16x8, kl), qf, acc, 0, 0, 0);
            }
            float t0 = -__builtin_inff(), t1 = t0, t2 = t0; int i0 = 64, i1 = 64, i2 = 64;
#define INS3(v_, j_) do { const float _iv = (v_); const int _ij = (j_); \
                if (_iv > t0 || (_iv == t0 && _ij < i0)) { t2 = t1; i2 = i1; t1 = t0; i1 = i0; t0 = _iv; i0 = _ij; } \
                else if (_iv > t1 || (_iv == t1 && _ij < i1)) { t2 = t1; i2 = i1; t1 = _iv; i1 = _ij; } \
                else if (_iv > t2 || (_iv == t2 && _ij < i2)) { t2 = _iv; i2 = _ij; } } while (0)
#pragma unroll
            for (int r = 0; r < 16; ++r) { const int j = att::crow(r, hi); const float v = (j < qb) ? acc[r] : -__builtin_inff(); INS3(v, j); }
            { const float o0 = __shfl_xor(t0, 32), o1 = __shfl_xor(t1, 32), o2 = __shfl_xor(t2, 32); const int j0 = __shfl_xor(i0, 32), j1 = __shfl_xor(i1, 32), j2 = __shfl_xor(i2, 32);
              INS3(o0, j0); INS3(o1, j1); INS3(o2, j2); }
#undef INS3
            int rk0 = 0, rk1 = 0, rk2 = 0;
            const bool v0 = t0 > -__builtin_inff() && i0 < qb, v1 = t1 > -__builtin_inff() && i1 < qb, v2 = t2 > -__builtin_inff() && i2 < qb;
            if (hi == 0) {
                if (v0) rk0 = __hip_atomic_fetch_add(&hist[i0], 1, __ATOMIC_RELAXED, __HIP_MEMORY_SCOPE_WORKGROUP);
                if (v1) rk1 = __hip_atomic_fetch_add(&hist[i1], 1, __ATOMIC_RELAXED, __HIP_MEMORY_SCOPE_WORKGROUP);
                if (v2) rk2 = __hip_atomic_fetch_add(&hist[i2], 1, __ATOMIC_RELAXED, __HIP_MEMORY_SCOPE_WORKGROUP);
            }
            __syncthreads();
            if (tid < 32 && hist[tid] > 0) hist[32 + tid] = (int)__hip_atomic_fetch_add((unsigned*)ctl + CW_BCNT + 64 * (((b * NH + h) << 5) + tid), (unsigned)hist[tid], RLX_AGENT);
            __syncthreads();
            if (hi == 0) {
                unsigned* bb = buck + (size_t)(b * NH + h) * BUCK_PER_BH;
                if (v0) bb[buck_off(i0) + hist[32 + i0] + rk0] = (unsigned)tq | (0u << 16);
                if (v1) bb[buck_off(i1) + hist[32 + i1] + rk1] = (unsigned)tq | (1u << 16);
                if (v2) bb[buck_off(i2) + hist[32 + i2] + rk2] = (unsigned)tq | (2u << 16);
            }
        }
    }
    SEAM(3);

    if (IN(4)) {
        PHASE_IDS;
        LAS int* pfx = (LAS int*)(lds + att::L_SELPFX);
        __syncthreads();
        for (int k = tid; k < 1024; k += NWAVES * 64) { const unsigned c = __hip_atomic_load((unsigned*)ctl + CW_BCNT + 64 * k, RLX_AGENT); pfx[k + 1] = (int)((c + 255u) >> 8); }
        if (tid == 0) pfx[0] = 0;
        __syncthreads();
        if (tid == 0) { int s = 0; for (int k = 1; k <= 1024; ++k) { s += pfx[k]; pfx[k] = s; } }
        __syncthreads();
        const int nsel = pfx[1024];
        constexpr int NDIL = 2 * 1024;
        const int total = nsel + NDIL;
        att::Parts noparts{};
        const int r32 = lane & 31;
#define DECODE4(u_, D) do { const int uu = (u_); \
            if (uu < NDIL) {     \
                const int p = uu >> 10, v = uu & 1023, bh = v >> 5, w5 = v & 31; \
                const int dd = p ? 4 : 1, res = p ? (w5 >> 3) : 0, l0 = p ? (w5 & 7) * 256 : w5 * 256, b = bh >> 3, h = bh & 7; \
                const int hb = (b * SEQ) * WQ + h * HD; \
                D.Q = QD + hb; D.K = KD + hb; D.V = VD + hb; D.qpos = (l0 + wave * 32 + r32) * dd + res; D.qoff = D.qpos * WQ; \
                D.kp0 = (l0 - 128) * dd + res; D.kst = dd; D.t_lo = l0 == 0 ? 2 : 0; D.t_hi = 6; D.w_lo = wave >> 1; D.w_hi = (wave >> 1) + 2; D.W = 128 * dd; \
                D.sl2 = __builtin_amdgcn_exp2f(-(float)(h + 1)) * LOG2E; \
                D.ro = p * (NTOK * WQ) + hb + D.qpos * WQ; D.li = p * (NTOK * 8) + (b * SEQ + D.qpos) * 8 + h; D.nparts = 0; \
            } else {             \
                const int su = uu - NDIL; int klo = 0, khi = 1024; \
                while (khi - klo > 1) { const int mid = (klo + khi) >> 1; if (pfx[mid] <= su) klo = mid; else khi = mid; } \
                const int bk = klo, chunk = su - pfx[bk], bh = bk >> 5, j = bk & 31, b = bh >> 3, h = bh & 7; \
                const int cnt = (int)__hip_atomic_load((unsigned*)ctl + CW_BCNT + 64 * bk, RLX_AGENT); \
                const int idx = chunk * 256 + wave * 32 + r32; const bool valid = idx < cnt; \
                unsigned e = 0; if (valid) e = buck[(size_t)bh * BUCK_PER_BH + buck_off(j) + idx]; \
                const int slot = (int)(e >> 16), hb = (b * SEQ) * WQ + h * HD; \
                D.Q = QM + hb; D.K = KM + hb; D.V = VM + hb; D.qpos = valid ? (int)(e & 0xffffu) : (j + 1) * 256; D.qoff = D.qpos * WQ; \
                D.kp0 = j * 256; D.kst = 1; D.t_lo = 0; D.t_hi = 4; D.w_lo = 0; D.w_hi = 3; D.W = 1 << 20; \
                D.sl2 = __builtin_amdgcn_exp2f(-0.5f * (float)(2 * h + 1)) * LOG2E; \
                D.ro = valid ? slot * (NTOK * WQ) + hb + D.qpos * WQ : -1; D.li = slot * (NTOK * 8) + (b * SEQ + D.qpos) * 8 + h; D.nparts = 0; \
            } } while (0)
        att::UD cur; att::ND nd; att::PF pf;
#define TO_ND(D, N) do { N.Q = D.Q; N.K = D.K; N.V = D.V; N.qoff = D.qoff; N.kp0 = D.kp0; N.kst = D.kst; N.t_lo = D.t_lo; } while (0)
        if (bx < NDIL) { DECODE4(bx, cur); TO_ND(cur, nd); att::attn_prefetch(nd, pf); att::attn_prime((LAS char*)lds, nd, pf); }
        for (int u = bx; u < NDIL; u += G) {
            const bool has_next = u + G < NDIL;
            { att::UD tmp; DECODE4(has_next ? u + G : u, tmp); TO_ND(tmp, nd); }
            DECODE4(u, cur);
            att::attn_unit<0, 2>((LAS char*)lds, cur, PD, LD, SD, noparts, pf, has_next, nd);
        }
#undef DECODE4
        { const int c0 = (int)(((long)nsel * bx) / G), c1 = (int)(((long)nsel * (bx + 1)) / G);
          att::attn_sel_chunks((LAS char*)lds, c0, c1, pfx, (const unsigned*)ctl + CW_BCNT, buck, QM, KM, VM, PM, LM, SM); }
    }
    SEAM(4);
    if (IN(5)) {
        PHASE_IDS;
        const int r32 = lane & 31;
        att::Parts PMp, PDp;
#pragma unroll
        for (int s3 = 0; s3 < 3; ++s3) { PMp.pbase[s3] = (const bf16*)((const unsigned char*)PM + (size_t)s3 * NTOK * WQ); PMp.plse[s3] = LM + (size_t)s3 * NTOK * 8; PMp.psc[s3] = SM + (size_t)s3 * NTOK * 8;
            PDp.pbase[s3] = (const bf16*)((const unsigned char*)PD + (size_t)(s3 < 2 ? s3 : 0) * NTOK * WQ); PDp.plse[s3] = LD + (size_t)(s3 < 2 ? s3 : 0) * NTOK * 8; PDp.psc[s3] = SD + (size_t)(s3 < 2 ? s3 : 0) * NTOK * 8; }
#define DECODE5(u_, D) do { const int uu = (u_); \
            if (uu < 1024) {     \
                const int bh = uu >> 5, qb = uu & 31, b = bh >> 3, h = bh & 7, hb = (b * SEQ) * WQ + h * HD; \
                D.Q = QM + hb; D.K = KM + hb; D.V = VM + hb; D.qpos = qb * 256 + wave * 32 + r32; D.qoff = D.qpos * WQ; \
                D.kp0 = qb * 256; D.kst = 1; D.t_lo = 0; D.t_hi = 4; D.w_lo = 0; D.w_hi = wave >> 1; D.W = 1 << 20; \
                D.sl2 = __builtin_amdgcn_exp2f(-0.5f * (float)(2 * h + 1)) * LOG2E; \
                D.ro = hb + D.qpos * WQ; D.li = (b * SEQ + D.qpos) * 8 + h; D.nparts = qb < 3 ? qb : 3; \
            } else {             \
                const int v = uu - 1024, bh = v >> 5, w5 = v & 31, res = w5 >> 1, l0 = (w5 & 1) * 256, b = bh >> 3, h = bh & 7, hb = (b * SEQ) * WQ + h * HD; \
                D.Q = QD + hb; D.K = KD + hb; D.V = VD + hb; D.qpos = (l0 + wave * 32 + r32) * 16 + res; D.qoff = D.qpos * WQ; \
                D.kp0 = (l0 - 128) * 16 + res; D.kst = 16; D.t_lo = l0 == 0 ? 2 : 0; D.t_hi = 6; D.w_lo = wave >> 1; D.w_hi = (wave >> 1) + 2; D.W = 128 * 16; \
                D.sl2 = __builtin_amdgcn_exp2f(-(float)(h + 1)) * LOG2E; \
                D.ro = hb + D.qpos * WQ; D.li = (b * SEQ + D.qpos) * 8 + h; D.nparts = 2; \
            } } while (0)
        att::UD cur; att::ND nd; att::PF pf;
        if (bx < 2048) { DECODE5(bx, cur); TO_ND(cur, nd); att::attn_prefetch(nd, pf); att::attn_prime((LAS char*)lds, nd, pf); }
        for (int u = bx; u < 2048; u += G) {
            const bool has_next = u + G < 2048;
            { att::UD tmp; DECODE5(has_next ? u + G : u, tmp); TO_ND(tmp, nd); }
            DECODE5(u, cur);
            if (u < 1024) att::attn_unit<3, 1>((LAS char*)lds, cur, MK_DEBUG ? Hb : QM, nullptr, nullptr, PMp, pf, has_next, nd);
            else att::attn_unit<2, 2>((LAS char*)lds, cur, MK_DEBUG ? Hb + (size_t)NTOK * WQ : QD, nullptr, nullptr, PDp, pf, has_next, nd);
        }
#undef DECODE5
#undef TO_ND
    }
    SEAM(5);

    if (IN(6)) {
        pg8::Gemm g{(const bf16*)(ws + WS_H8), (const bf16*)(ws + WS_WIN8 + (size_t)(NQKV - NBF) * DM), DM / 2, nullptr, DM / 2, (const bf16*)(ws + WS_H8), 1 << 30}; pg8::StaticOrder S; S.init(NTOK, NGATE, G, bx);
        pg8::EpiGates E{GATES, GATES + (size_t)NTOK * DM, args.in[3], (const float*)(ws + WS_RS8), (const float*)(ws + WS_CS8) + (NQKV - NBF)};
        pg8::gemm_phase<pg8::EpiGates, pg8::StaticOrder, true, false, QIN>(lds, g, S, E);
    }
    SEAM(6);
    if (IN(7)) {
        pg8::Gemm g{QM, (const bf16*)(ws + WS_WOM), DM, nullptr, WQ, QD, 16}; pg8::StaticOrder S; S.init(NTOK, DM, G, bx);
        pg8::EpiMix2 E{MIX, GATES, GATES + (size_t)NTOK * DM, (unsigned*)ctl + CW_MMAX};
        pg8::gemm_phase<pg8::EpiMix2, pg8::StaticOrder, true>(lds, g, S, E);
    }
    SEAM(7);
    if (IN(8)) {
        PHASE_IDS;
        unsigned char* M8 = ws + WS_MIX8; float* rsm = (float*)(ws + WS_RSM);
        for (int m = gw; m < NTOK; m += NGW) {
            const float mx = __uint_as_float(__hip_atomic_load((unsigned*)ctl + CW_MMAX + m, RLX_AGENT));
            const float qs = mx > 0.f ? 127.f / mx : 0.f;
            if (lane == 0) rsm[m] = mx * (1.f / 127.f);
#pragma unroll
            for (int j = 0; j < 4; ++j) { f32x4 a, b; pg8::unpack8(*(const u32x4*)(MIX + (size_t)m * DM + j * 512 + lane * 8), a, b);
                u32x2 q; q.x = pk_i8x4(a.x * qs, a.y * qs, a.z * qs, a.w * qs); q.y = pk_i8x4(b.x * qs, b.y * qs, b.z * qs, b.w * qs);
                *(u32x2*)(M8 + (size_t)m * DM + j * 512 + lane * 8) = q; }
        }
    }
    SEAM(8);
    if (IN(9)) {
        pg8::Gemm g{(const bf16*)(ws + WS_MIX8), (const bf16*)(ws + WS_WO), DM / 2, nullptr, DM / 2, (const bf16*)(ws + WS_MIX8), 1 << 30}; pg8::StaticOrder S; S.init(NTOK, DM, G, bx);
        pg8::EpiResid E{x, X1, args.in[7], (unsigned*)ctl + CW_UMAX, (const float*)(ws + WS_RSM), (const float*)(ws + WS_CSWO)};
        pg8::gemm_phase<pg8::EpiResid, pg8::StaticOrder, true, false, 2>(lds, g, S, E);
    }
    SEAM(9);

    if (IN(10)) {
        PHASE_IDS;
        const int r32 = lane & 31, hi = lane >> 5;
        constexpr int RSTR = 1040;
        LAS unsigned char* UH = lds; LAS unsigned char* UL = lds + 32 * RSTR;
        LAS float* part = (LAS float*)(lds + 2 * 32 * RSTR);
        LAS float* ssl = (LAS float*)(lds + 2 * 32 * RSTR + 40960);
        LAS int* ecnt = (LAS int*)(lds + 2 * 32 * RSTR + 40960 + 256);
        LAS f32x4* gsum = (LAS f32x4*)(lds + 2 * 32 * RSTR + 40960 + 512);
        LAS f32x4* G2L = (LAS f32x4*)(lds + 2 * 32 * RSTR + 40960 + 1024);
        LAS unsigned char* WGL = lds + 2 * 32 * RSTR + 40960 + 1024 + 8192;
        if (tid < 32) ecnt[tid] = 0;
        { const float* wgrp = args.in[8];
          for (int i = tid; i < DM; i += 512) *(LAS f32x4*)(WGL + i * 16 + (i >> 5) * 16) = *(const f32x4*)(wgrp + 4 * i);
          G2L[tid] = *(const f32x4*)(args.in[7] + 4 * tid); }
        __syncthreads();
        const float* bgrp = args.in[9]; const float* bexp = args.in[11];
        const int tok = tid >> 4, part16 = tid & 15;
        LAS float* scr = (LAS float*)(lds + wave * 8704);
        LAS float* cmax = (LAS float*)(lds + 152 * 1024);
        LAS int* qslot = (LAS int*)(lds + 156 * 1024);
        float* csgu = (float*)(ws + WS_CSGU);
        unsigned* qctr = (unsigned*)ctl + CW_Q10 + (args.dry ? 64 : 0);
        constexpr int NTILE = NTOK / 32, NJOB = 1024, NSLOT = NTILE + NJOB;
        for (;;) {
            __syncthreads();
            if (tid == 0) *qslot = (int)__hip_atomic_fetch_add(qctr, 1u, RLX_AGENT);
            __syncthreads();
            const int slot = *qslot;
            if (slot >= NSLOT) break;
            if (slot >= 2 * NTILE || (slot & 1)) {
                const int gg = slot >= 2 * NTILE ? slot - NTILE : slot >> 1;
{
                const int which = gg & 1, r = gg >> 1, e = r >> 4, nb = r & 15, n0 = 32 * nb;
                const int lane = lane_fresh();
                const float* W = args.in[12 + which] + (size_t)e * DM * DEXP;
                float mx = 0.f;
                float vv[4][32];
#pragma unroll
                for (int q4 = 0; q4 < 4; ++q4) { const int kb = wave * 4 + q4;
#pragma unroll
                    for (int i = 0; i < 32; ++i) vv[q4][i] = W[(size_t)(64 * kb + 2 * i + (lane >> 5)) * DEXP + n0 + (lane & 31)]; }
#pragma unroll
                for (int q4 = 0; q4 < 4; ++q4)
#pragma unroll
                    for (int i = 0; i < 32; ++i) mx = fmaxf(mx, fabsf(vv[q4][i]));
                mx = fmaxf(mx, __shfl_xor(mx, 32));
                __syncthreads();
                if (lane < 32) cmax[wave * 32 + lane] = mx;
                __syncthreads();
                float cm = 0.f;
#pragma unroll
                for (int w8 = 0; w8 < 8; ++w8) cm = fmaxf(cm, cmax[w8 * 32 + (lane & 31)]);
                const long orow0 = (long)e * 1024 + (n0 >> 7) * 256 + which * 128 + (n0 & 127);
                if (wave == 0 && lane < 32) csgu[orow0 + lane] = cm * (1.f / 127.f);
                const float cscale = cm > 0.f ? 127.f / cm : 0.f;
#pragma unroll
                for (int q4 = 0; q4 < 4; ++q4) transpose_regs_i8(vv[q4], 64 * (wave * 4 + q4), ws + WS_WGU, DM, orow0, cscale, scr, lane);
#pragma unroll 1
                for (int r2 = 0; r2 < 2; ++r2) { const int it = gg * 16 + wave * 2 + r2; const int e2 = it >> 9, kb = (it >> 6) & 7, nb2 = it & 63;
                    transpose_item_fp8(args.in[14] + (size_t)e2 * DEXP * DM, DM, 64 * kb, 32 * nb2, ws + WS_WDN, DEXP, (long)e2 * 2048 + 32 * nb2, WD8_SCALE, scr, lane); }
                }
                continue;
            }
            const int tile = slot >> 1;
            const int t0 = tile * 32;
            f32x16 accE = {};
            float ss = 0.f; f32x4 gacc = {0.f, 0.f, 0.f, 0.f};
            f32x4 xv[8];
            const float* xr = X1 + (size_t)(t0 + tok) * DM + part16 * 32;
            const float umx = __uint_as_float(__hip_atomic_load((unsigned*)ctl + CW_UMAX + t0 + tok, RLX_AGENT));
            const float uq = umx > 0.f ? 127.f / umx : 0.f;
            if (part16 == 0) ((float*)(ws + WS_RSU))[t0 + tok] = umx * (1.f / 127.f);
#pragma unroll
            for (int i = 0; i < 8; ++i) xv[i] = *(const f32x4*)(xr + 4 * i);
#pragma unroll 1
            for (int c = 0; c < 4; ++c) {
                const int kc = c * 512 + part16 * 32;
                bf16x8 wEh[4], wEl[4];
#pragma unroll
                for (int s4 = 0; s4 < 4; ++s4) { const int k = c * 512 + (wave * 4 + s4) * 16 + hi * 8; wEh[s4] = *(const bf16x8*)(WR + (size_t)r32 * DM + k); wEl[s4] = *(const bf16x8*)(WR + (size_t)(64 + r32) * DM + k); }
                u32x4 uh[4], ul[4]; u32x2 u8[4];
#pragma unroll
                for (int i = 0; i < 4; ++i) {
                    const f32x4 ga = G2L[(kc >> 2) + 2 * i], gb = G2L[(kc >> 2) + 2 * i + 1];
                    const f32x4 xa = xv[2 * i], xb = xv[2 * i + 1];
                    ss += (xa.x * xa.x + xa.y * xa.y) + (xa.z * xa.z + xa.w * xa.w) + (xb.x * xb.x + xb.y * xb.y) + (xb.z * xb.z + xb.w * xb.w);
                    const f32x4 ua = xa * ga, ub = xb * gb;
                    { LAS const unsigned char* wg = WGL + (kc + 8 * i) * 16 + (kc >> 5) * 16;
                      gacc += ua.x * *(LAS const f32x4*)(wg) + ua.y * *(LAS const f32x4*)(wg + 16) + ua.z * *(LAS const f32x4*)(wg + 32) + ua.w * *(LAS const f32x4*)(wg + 48);
                      asm volatile("" : "+v"(gacc) :: "memory");
                      gacc += ub.x * *(LAS const f32x4*)(wg + 64) + ub.y * *(LAS const f32x4*)(wg + 80) + ub.z * *(LAS const f32x4*)(wg + 96) + ub.w * *(LAS const f32x4*)(wg + 112);
                      asm volatile("" : "+v"(gacc) :: "memory"); }
                    uh[i] = pg8::pack8(ua, ub);
                    f32x4 ha, hb2; pg8::unpack8(uh[i], ha, hb2);
                    ul[i] = pg8::pack8(ua - ha, ub - hb2);
                    const f32x4 qa = ua * uq, qb = ub * uq;
                    u8[i].x = pk_i8x4(qa.x, qa.y, qa.z, qa.w); u8[i].y = pk_i8x4(qb.x, qb.y, qb.z, qb.w);
                }
                if (c < 3) {
#pragma unroll
                    for (int i = 0; i < 8; ++i) xv[i] = *(const f32x4*)(xr + (c + 1) * 512 + 4 * i);
                }
#pragma unroll
                for (int i = 0; i < 4; ++i) *(u32x2*)((unsigned char*)Hb + (size_t)(t0 + tok) * DM + kc + 8 * i) = u8[i];
                __syncthreads();
#pragma unroll
                for (int i = 0; i < 4; ++i) {
                    *(LAS u32x4*)(UH + tok * RSTR + part16 * 64 + 16 * i) = uh[i];
                    *(LAS u32x4*)(UL + tok * RSTR + part16 * 64 + 16 * i) = ul[i];
                }
                __syncthreads();
#pragma unroll
                for (int s = 0; s < 4; ++s) {
                    const int kl = (wave * 4 + s) * 16 + hi * 8;
                    const bf16x8 uhv = *(const LAS bf16x8*)(UH + r32 * RSTR + kl * 2), ulv = *(const LAS bf16x8*)(UL + r32 * RSTR + kl * 2);
                    accE = __builtin_amdgcn_mfma_f32_32x32x16_bf16(wEh[s], uhv, accE, 0, 0, 0);
                    accE = __builtin_amdgcn_mfma_f32_32x32x16_bf16(wEh[s], ulv, accE, 0, 0, 0);
                    accE = __builtin_amdgcn_mfma_f32_32x32x16_bf16(wEl[s], uhv, accE, 0, 0, 0);
                }
            }
            ss += __shfl_xor(ss, 1); ss += __shfl_xor(ss, 2); ss += __shfl_xor(ss, 4); ss += __shfl_xor(ss, 8);
#pragma unroll
            for (int g = 0; g < 4; ++g) { float v = gacc[g]; v += __shfl_xor(v, 1); v += __shfl_xor(v, 2); v += __shfl_xor(v, 4); v += __shfl_xor(v, 8); gacc[g] = v; }
            __syncthreads();
            if (part16 == 0) { ssl[tok] = ss; gsum[tok] = gacc; }
            LAS float* pw = part + wave * (32 * 40);
#pragma unroll
            for (int r = 0; r < 16; ++r) pw[r32 * 40 + att::crow(r, hi)] = accE[r];
            __syncthreads();
            if (tid < 32) {
                const int t = t0 + tid;
                const float rs = 1.0f / sqrtf(ssl[tid] * (1.f / DM) + RMS_EPS);
                float gl[4];
#pragma unroll
                for (int g = 0; g < 4; ++g) gl[g] = gsum[tid][g] * rs + bgrp[g];
                float gm = gl[0]; int gi = 0;
#pragma unroll
                for (int g = 1; g < 4; ++g) if (gl[g] > gm) { gm = gl[g]; gi = g; }
                float gs = 0.f;
#pragma unroll
                for (int g = 0; g < 4; ++g) gs += __expf(gl[g] - gm);
                const float gp = 1.0f / gs;
                float le[8];
#pragma unroll
                for (int e = 0; e < 8; ++e) { float a = 0.f;
#pragma unroll
                    for (int w8 = 0; w8 < 8; ++w8) a += part[w8 * (32 * 40) + tid * 40 + gi * 8 + e];
                    le[e] = a * rs + bexp[gi * 8 + e]; }
                float m0 = le[0]; int i0 = 0;
#pragma unroll
                for (int e = 1; e < 8; ++e) if (le[e] > m0) { m0 = le[e]; i0 = e; }
                float m1 = -__builtin_inff(); int i1 = 0;
#pragma unroll
                for (int e = 0; e < 8; ++e) if (e != i0 && le[e] > m1) { m1 = le[e]; i1 = e; }
                const float p1 = __expf(m1 - m0);
                const int e0 = gi * 8 + i0, e1 = gi * 8 + i1;
                EID[t * 2] = e0; EID[t * 2 + 1] = e1;
                EW[t * 2] = gp / (1.f + p1); EW[t * 2 + 1] = gp * p1 / (1.f + p1);
                RMS[t] = rs;
                __hip_atomic_fetch_add(&ecnt[e0], 1, __ATOMIC_RELAXED, __HIP_MEMORY_SCOPE_WORKGROUP); __hip_atomic_fetch_add(&ecnt[e1], 1, __ATOMIC_RELAXED, __HIP_MEMORY_SCOPE_WORKGROUP);
            }
        }
        __syncthreads();
        if (tid < 32 && ecnt[tid] > 0 && !args.dry) __hip_atomic_fetch_add((unsigned*)ctl + CW_ECNT + 64 * tid, (unsigned)ecnt[tid], RLX_AGENT);
    }
    SEAM(10);

    if (IN(11)) {
        PHASE_IDS;
        LAS int* pst = (LAS int*)(lds + 131072 - 1024);
        LAS int* ehist = pst + 64; LAS int* ebase = pst + 96;
        __syncthreads();
        if (tid == 0) { int s = 0; for (int e = 0; e < 32; ++e) { pst[e] = s; const int c = (int)__hip_atomic_load((unsigned*)ctl + CW_ECNT + 64 * e, RLX_AGENT); s += ((c + 255) >> 8) << 8; } pst[32] = s; }
        if (tid < 32) ehist[tid] = 0;
        __syncthreads();
        for (int t0 = bx * 128; t0 < NTOK && !args.dry; t0 += G * 128) {
            int e = 0, rk = 0;
            if (tid < 256) { e = EID[t0 * 2 + tid]; rk = __hip_atomic_fetch_add(&ehist[e], 1, __ATOMIC_RELAXED, __HIP_MEMORY_SCOPE_WORKGROUP); }
            __syncthreads();
            if (tid < 32) { const int c = ehist[tid]; ebase[tid] = c > 0 ? (int)__hip_atomic_fetch_add((unsigned*)ctl + CW_EFILL + 64 * tid, (unsigned)c, RLX_AGENT) : 0; }
            __syncthreads();
            if (tid < 256) { const int pos = pst[e] + ebase[e] + rk; ROWTOK[pos] = t0 + (tid >> 1); ROWW[pos] = EW[t0 * 2 + tid]; POS[t0 * 2 + tid] = pos; }
            __syncthreads();
            if (tid < 32) ehist[tid] = 0;
            __syncthreads();
        }
        if (bx < 32 && !args.dry) { const int c = (int)__hip_atomic_load((unsigned*)ctl + CW_ECNT + 64 * bx, RLX_AGENT); for (int r = pst[bx] + c + tid; r < pst[bx + 1]; r += NWAVES * 64) { ROWTOK[r] = 0; ROWW[r] = 0.f; } }
    }
    SEAM(11);

    if (IN(12) || IN(13)) {
        PHASE_IDS;
        LAS int* tst = (LAS int*)(lds + RING_BYTES + 64);
        __syncthreads();
        if (tid == 0) { int s = 0; for (int e = 0; e < 32; ++e) { tst[e] = s; const int c = (int)__hip_atomic_load((unsigned*)ctl + CW_ECNT + 64 * e, RLX_AGENT); s += (c + 255) >> 8; } tst[32] = s; }
        __syncthreads();
        const int ntiles = tst[32];
        const long U1 = (long)ntiles * 4, n1 = U1 / G; const int A = (int)(U1 % G); const long tfull = (n1 * G) / 4;
        const pg8::Gemm g1{Hb, (const bf16*)(ws + WS_WGU), DM / 2, ROWTOK, DM / 2, Hb, 1 << 30};
        const pg8::EpiMoe1 E1{(bf16*)(ws + WS_HMOE), RMS, ROWTOK, (const float*)(ws + WS_RSU), (const float*)(ws + WS_CSGU)};
        const pg8::Gemm g2{(const bf16*)(ws + WS_HMOE), (const bf16*)(ws + WS_WDN), DEXP / 2, nullptr, DEXP / 2, (const bf16*)(ws + WS_HMOE), 1 << 30};
        const pg8::EpiMoe2 E2{(bf16*)(ws + WS_YMOE), ROWW};
        if (IN(12)) {
            pg8::MoeOrder S{tst, 4, G, bx, 0, n1 * G, 0, 0};
            pg8::gemm_phase<pg8::EpiMoe1, pg8::MoeOrder, true, true, 2>(lds, g1, S, E1);
        }
        SEAM(12);
        if (IN(13)) {
            { pg8::MoeOrder S{tst, 4, G, bx, n1 * G, U1, 0, 0};
              pg8::gemm_phase<pg8::EpiMoe1, pg8::MoeOrder, true, true, 2>(lds, g1, S, E1); }
            { pg8::MoeOrder S{tst, 8, G, bx, 0, tfull * 8, A, 3};
              pg8::gemm_phase<pg8::EpiMoe2, pg8::MoeOrder, true, false, 1>(lds, g2, S, E2); }
            if (tfull < ntiles) {
                xcd_barrier(bar);
                pg8::MoeOrder S{tst, 8, G, bx, tfull * 8, (long)ntiles * 8, 0, 0};
                pg8::gemm_phase<pg8::EpiMoe2, pg8::MoeOrder, true, false, 1>(lds, g2, S, E2);
            }
        }
    }
    SEAM(13);

    if (IN(14)) {
        PHASE_IDS;
        const float* gf = args.in[15]; const bf16* Y = (const bf16*)(ws + WS_YMOE);
        const unsigned tmo = __hip_atomic_load((unsigned*)ctl + CW_BAR + XB_TMO, RLX_AGENT);
        for (int m = gw; m < NTOK; m += NGW) {
            const float* xr = X1 + (size_t)m * DM; const int p0 = POS[m * 2], p1 = POS[m * 2 + 1];
            f32x4 v[8]; float s = 0.f;
#pragma unroll
            for (int j = 0; j < 4; ++j) { const int c = j * 512 + lane * 8;
                f32x4 a0, a1, b0, b1; pg8::unpack8(*(const u32x4*)(Y + (size_t)p0 * DM + c), a0, a1); pg8::unpack8(*(const u32x4*)(Y + (size_t)p1 * DM + c), b0, b1);
                v[2 * j] = *(const f32x4*)(xr + c) + a0 + b0; v[2 * j + 1] = *(const f32x4*)(xr + c + 4) + a1 + b1; }
#pragma unroll
            for (int j = 0; j < 8; ++j) s += (v[j].x * v[j].x + v[j].y * v[j].y) + (v[j].z * v[j].z + v[j].w * v[j].w);
            float rs = 1.0f / sqrtf(wave_sum(s) * (1.f / DM) + RMS_EPS);
            if (tmo) rs = __builtin_nanf("");
#pragma unroll
            for (int j = 0; j < 4; ++j) { const int c = j * 512 + lane * 8;
                *(f32x4*)(args.out + (size_t)m * DM + c) = v[2 * j] * rs * *(const f32x4*)(gf + c);
                *(f32x4*)(args.out + (size_t)m * DM + c + 4) = v[2 * j + 1] * rs * *(const f32x4*)(gf + c + 4); }
        }
    }
#undef IN
#undef SEAM
}

#if MK_DEBUG
namespace dbg {
__device__ __forceinline__ float b2f(bf16 v) { return __uint_as_float((unsigned)v << 16); }
__device__ __forceinline__ float wmax(float v) {
#pragma unroll
    for (int o = 1; o < 64; o <<= 1) v = fmaxf(v, __shfl_xor(v, o));
    return v;
}
__device__ __forceinline__ void wave_attend(const bf16* Q, const bf16* K, const bf16* V, int b, int h, int t, float slope, const int* kpos, int nk, float* qs, float* sc, float& o0, float& o1) {
    const int lane = threadIdx.x & 63;
    const size_t hb = (size_t)b * SEQ * WQ + h * HD;
    qs[lane] = b2f(Q[hb + (size_t)t * WQ + lane]); qs[lane + 64] = b2f(Q[hb + (size_t)t * WQ + lane + 64]);
    __builtin_amdgcn_s_waitcnt(0); __builtin_amdgcn_wave_barrier();
    float m = -INFINITY;
    for (int n = lane; n < nk; n += 64) { const int kp = kpos[n]; const bf16* kr = K + hb + (size_t)kp * WQ; float s = 0.f;
        for (int d = 0; d < HD; ++d) s = fmaf(qs[d], b2f(kr[d]), s);
        s = s * 0.08838834764831845f - slope * (float)(t - kp); sc[n] = s; m = fmaxf(m, s); }
    m = wmax(m);
    float l = 0.f;
    for (int n = lane; n < nk; n += 64) { const float p = expf(sc[n] - m); sc[n] = p; l += p; }
    l = wave_sum(l);
    __builtin_amdgcn_s_waitcnt(0); __builtin_amdgcn_wave_barrier();
    o0 = 0.f; o1 = 0.f;
    for (int n = 0; n < nk; ++n) { const float p = sc[n]; const bf16* vr = V + hb + (size_t)kpos[n] * WQ; o0 = fmaf(p, b2f(vr[lane]), o0); o1 = fmaf(p, b2f(vr[lane + 64]), o1); }
    o0 /= l; o1 /= l;
    __builtin_amdgcn_wave_barrier();
}
__global__ void __launch_bounds__(256) k_check(unsigned char* ws, int mode) {
    __shared__ int kpos_s[4][1024];
    __shared__ float sc_s[4][1024];
    __shared__ float qs_s[4][128];
    const int w = threadIdx.x >> 6, lane = threadIdx.x & 63;
    const unsigned sidx = blockIdx.x * 4 + w;
    const unsigned hsh = sidx * 2654435761u;
    const int b = (hsh >> 28) & 3, h = (hsh >> 24) & 7; int t = (hsh >> 8) & 8191;
    if ((sidx & 7) == 0) t = (sidx >> 3) & 511;
    const bf16* QM = (const bf16*)(ws + WS_QM); const bf16* KM = (const bf16*)(ws + WS_KM); const bf16* VM = (const bf16*)(ws + WS_VM);
    const bf16* QD = (const bf16*)(ws + WS_QD); const bf16* KD = (const bf16*)(ws + WS_KD); const bf16* VD = (const bf16*)(ws + WS_VD);
    const float* kmean = (const float*)(ws + WS_KMEAN);
    const bf16* OM = (const bf16*)(ws + WS_H); const bf16* OD = OM + (size_t)NTOK * WQ;
    float* accum = (float*)(ws + WS_CTL) + 200000;
    int* kp = kpos_s[w]; int nk = 0; float o0, o1; const bf16* O;
    const size_t hb = (size_t)b * SEQ * WQ + h * HD;
    if (mode == 1) {
        const int qblk = t >> 8;
        float g = -INFINITY;
        if (lane < qblk) { float s = 0.f; for (int d = 0; d < HD; ++d) s = fmaf(b2f(QM[hb + (size_t)t * WQ + d]), kmean[(size_t)((b * NH + h) * 32 + lane) * HD + d], s); g = s; }
        int s0 = -1, s1 = -1, s2 = -1; float g3 = 0.f, g4 = -INFINITY;
        { float mx = wmax(g);
          if (mx != -INFINITY) { s0 = __ffsll((long long)__ballot(g == mx)) - 1; if (lane == s0) g = -INFINITY; }
          mx = wmax(g);
          if (s0 >= 0 && mx != -INFINITY) { s1 = __ffsll((long long)__ballot(g == mx)) - 1; if (lane == s1) g = -INFINITY; }
          mx = wmax(g);
          if (s1 >= 0 && mx != -INFINITY) { s2 = __ffsll((long long)__ballot(g == mx)) - 1; g3 = mx; if (lane == s2) g = -INFINITY; }
          g4 = wmax(g); }
        if (s2 >= 0 && g4 != -INFINITY && g3 - g4 < 2e-3f) return;
        if (s0 >= 0) { for (int i = lane; i < 256; i += 64) kp[nk + i] = s0 * 256 + i; nk += 256; }
        if (s1 >= 0) { for (int i = lane; i < 256; i += 64) kp[nk + i] = s1 * 256 + i; nk += 256; }
        if (s2 >= 0) { for (int i = lane; i < 256; i += 64) kp[nk + i] = s2 * 256 + i; nk += 256; }
        const int own = t - qblk * 256 + 1;
        for (int i = lane; i < own; i += 64) kp[nk + i] = qblk * 256 + i;
        nk += own;
        __builtin_amdgcn_s_waitcnt(0); __builtin_amdgcn_wave_barrier();
        wave_attend(QM, KM, VM, b, h, t, exp2f(-0.5f * (float)(2 * h + 1)), kp, nk, qs_s[w], sc_s[w], o0, o1); O = OM;
    } else {
#pragma unroll
        for (int p = 0; p < 3; ++p) { const int d = (p == 0) ? 1 : (p == 1 ? 4 : 16); int cnt = t / d + 1; if (cnt > 129) cnt = 129;
            for (int i = lane; i < cnt; i += 64) kp[nk + i] = t - i * d; nk += cnt; }
        __builtin_amdgcn_s_waitcnt(0); __builtin_amdgcn_wave_barrier();
        wave_attend(QD, KD, VD, b, h, t, exp2f(-(float)(h + 1)), kp, nk, qs_s[w], sc_s[w], o0, o1); O = OD;
    }
    const float a0 = b2f(O[hb + (size_t)t * WQ + lane]), a1 = b2f(O[hb + (size_t)t * WQ + lane + 64]);
    float d2 = (a0 - o0) * (a0 - o0) + (a1 - o1) * (a1 - o1), r2 = o0 * o0 + o1 * o1;
    d2 = wave_sum(d2); r2 = wave_sum(r2);
    if (lane == 0) { atomicAdd(&accum[0], d2); atomicAdd(&accum[64], r2); }
}
__global__ void __launch_bounds__(256) k_report(unsigned char* ws, float* out, int n) {
    const int i = blockIdx.x * 256 + threadIdx.x;
    const float* accum = (const float*)(ws + WS_CTL) + 200000;
    if (i < n) out[i] = (i == 0) ? 1e4f * sqrtf(accum[0] / accum[64]) : 0.f;
}
}
#endif

extern "C" void kernel_launch(void* const* d_in, const int* in_sizes, int n_in, void* d_out, int out_size, void* d_ws, size_t ws_size, hipStream_t stream) {
    static int grid = 0;
    if (grid == 0) {
        if (n_in != 16 || ws_size < WS_END) { fprintf(stderr, "kernel_launch: need 16 inputs and %zu B of workspace (got %d, %zu)\n", (size_t)WS_END, n_in, ws_size); grid = -1; return; }
        int dev = 0, cus = 0, per_cu = 0;
        if (hipGetDevice(&dev) != hipSuccess || hipDeviceGetAttribute(&cus, hipDeviceAttributeMultiprocessorCount, dev) != hipSuccess) { grid = -1; return; }
        if (hipFuncSetAttribute((const void*)mk_fwd, hipFuncAttributeMaxDynamicSharedMemorySize, LDS_BYTES) != hipSuccess) { fprintf(stderr, "kernel_launch: hipFuncSetAttribute failed\n"); grid = -1; return; }
        if (hipOccupancyMaxActiveBlocksPerMultiprocessor(&per_cu, (const void*)mk_fwd, NWAVES * 64, LDS_BYTES) != hipSuccess || per_cu < 1) fprintf(stderr, "kernel_launch: occupancy query says %d\n", per_cu);
        (void)hipGetLastError();
        grid = cus;
    }
    if (grid < 0) return;
    (void)hipMemsetAsync((char*)d_ws + WS_CTL, 0, CTL_ZERO_BYTES, stream);
    (void)hipMemsetAsync((char*)d_ws + WS_KMEAN, 0, (size_t)NB * NH * 32 * HD * 4, stream);
    Args a{};
    for (int i = 0; i < 16; ++i) a.in[i] = (const float*)d_in[i];
    a.out = (float*)d_out; a.ws = (unsigned char*)d_ws;
    constexpr int NPH = 15;
#if MK_DEBUG
    for (int p = 0; p < 6; ++p) { a.ph_lo = p; a.ph_hi = p + 1; hipLaunchKernelGGL(mk_fwd, dim3(grid), dim3(NWAVES * 64), LDS_BYTES, stream, a); }
    hipLaunchKernelGGL(dbg::k_check, dim3(4096), dim3(256), 0, stream, (unsigned char*)d_ws, (int)MK_DEBUG);
    hipLaunchKernelGGL(dbg::k_report, dim3((out_size + 255) / 256), dim3(256), 0, stream, (unsigned char*)d_ws, (float*)d_out, out_size);
    return;
#endif
    if (MK_N_LAUNCHES == 1) { a.ph_lo = 0; a.ph_hi = NPH; hipLaunchKernelGGL(mk_fwd, dim3(grid), dim3(NWAVES * 64), LDS_BYTES, stream, a); }
    else { for (int p = 0; p < NPH; ++p) { const int reps = ((MK_REP_MASK >> p) & 1) ? 2 : 1; if (p == 2) continue;
            for (int r = 0; r < reps; ++r) { a.ph_lo = p; a.ph_hi = p + 1; a.dry = ((p == 10 || p == 11) && reps == 2 && r == 0) ? 1 : ((p == 4 && reps == 2 && r == 0) ? MK_DRY4 : 0); hipLaunchKernelGGL(mk_fwd, dim3(grid), dim3(NWAVES * 64), LDS_BYTES, stream, a);
            } } }
}
```

```cpp
#include <hip/hip_runtime.h>
#include <cstdio>
#include <cstdint>

#ifndef MK_N_LAUNCHES
#define MK_N_LAUNCHES 1
#endif

#ifndef MK_REP_MASK
#define MK_REP_MASK 0
#endif
#ifndef MK_DRY4
#define MK_DRY4 0
#endif
#ifndef MK_DEBUG
#define MK_DEBUG 0
#endif
#define LAS __attribute__((address_space(3)))
#define GAS __attribute__((address_space(1)))
typedef unsigned short bf16;
typedef short bf16x8 __attribute__((ext_vector_type(8)));
typedef short s16x4 __attribute__((ext_vector_type(4)));
typedef float f32x2 __attribute__((ext_vector_type(2)));
typedef float f32x4 __attribute__((ext_vector_type(4)));
typedef float f32x16 __attribute__((ext_vector_type(16)));
typedef unsigned u32x2 __attribute__((ext_vector_type(2)));
typedef unsigned u32x4 __attribute__((ext_vector_type(4)));
typedef int i32x4 __attribute__((ext_vector_type(4)));
typedef int i32x8 __attribute__((ext_vector_type(8)));
typedef GAS unsigned gu32;

constexpr int DM = 2048, NB = 4, SEQ = 8192, NTOK = NB * SEQ, HD = 128, NH = 8, WQ = 1024;
constexpr int NQKV = 6144, NGATE = 4096, NEXP = 32, DEXP = 512;
constexpr int NBF = 0;
constexpr int QIN = 2;
constexpr int RMAX = 73728;
constexpr float RMS_EPS = 1e-6f;
constexpr float LOG2E = 1.4426950408889634f;
constexpr float SM_C2 = 0.08838834764831845f * LOG2E;

constexpr size_t MiB = 1u << 20;
constexpr size_t WS_CTL = 0, CTL_ZERO_BYTES = 1 * MiB;
constexpr size_t WS_WOM = 1 * MiB, WS_WOD = 5 * MiB, WS_WO = 9 * MiB, WS_WIN = 17 * MiB;
constexpr size_t WS_WIN8 = 25 * MiB;
constexpr size_t WS_H8 = 912 * MiB;
constexpr size_t WS_BUCK = 57 * MiB;
constexpr size_t WS_CS8 = 73 * MiB;
constexpr size_t WS_RS8 = 73 * MiB + 64 * 1024;
constexpr size_t WS_KMEAN = 74 * MiB;
constexpr size_t WS_WR = 74 * MiB + 512 * 1024;
constexpr size_t WS_H = 75 * MiB;
constexpr size_t WS_QM = 203 * MiB, WS_KM = 267 * MiB, WS_VM = 331 * MiB, WS_QD = 395 * MiB, WS_KD = 459 * MiB, WS_VD = 523 * MiB;
constexpr size_t WS_PM = 587 * MiB;
constexpr size_t WS_PD = 779 * MiB;
constexpr size_t WS_LM = 907 * MiB, WS_LD = 910 * MiB;
constexpr size_t WS_SM = 976 * MiB, WS_SD = 980 * MiB;
constexpr size_t WS_GATES = 587 * MiB;
constexpr size_t WS_GINV = 75 * MiB;
constexpr size_t WS_MIX = 267 * MiB;
constexpr size_t WS_X1 = 768 * MiB;
constexpr size_t WS_WGU = 203 * MiB, WS_WDN = 331 * MiB;
constexpr size_t WS_HMOE = 395 * MiB;
constexpr size_t WS_YMOE = 467 * MiB;
constexpr size_t WS_YS = 467 * MiB + 144 * MiB;
constexpr size_t WS_END = 1024 * MiB;
constexpr size_t WS_RSM = WS_BUCK + 2560 * 1024, WS_CSWO = 73 * MiB + 48 * 1024;
constexpr size_t WS_MIX8 = 75 * MiB;
constexpr size_t WS_RSU = WS_BUCK + 2048 * 1024, WS_CSGU = WS_BUCK + 2304 * 1024;
constexpr size_t WS_EID = WS_BUCK, WS_EW = WS_BUCK + 256 * 1024, WS_RMS = WS_BUCK + 512 * 1024, WS_POS = WS_BUCK + 768 * 1024, WS_ROWTOK = WS_BUCK + 1024 * 1024, WS_ROWW = WS_BUCK + 1536 * 1024;
static_assert(WS_YMOE + (size_t)RMAX * 2048 * 2 <= WS_X1 && WS_HMOE + (size_t)RMAX * 512 * 2 <= WS_YMOE && WS_LD + 2 * (size_t)NTOK * 8 * 4 <= WS_END, "ws map");

constexpr int CW_TMO = 0;
constexpr int CW_BAR = 4096;
constexpr int CW_BCNT = 8192;
constexpr int CW_ECNT = 8192 + 65536;
constexpr int CW_EFILL = CW_ECNT + 64 * 32;
constexpr int CW_MMAX = 163840;
constexpr int CW_UMAX = 131072;
constexpr int CW_Q10 = 200000;
constexpr int CW_CMAX = 81920;
static_assert(CW_EFILL + 64 * 32 <= CW_CMAX && CW_CMAX + 8192 <= CW_UMAX && CW_UMAX + NTOK <= CW_MMAX && (CW_MMAX + NTOK) * 4 <= (int)CTL_ZERO_BYTES, "ctl");

constexpr int BUCK_PER_BH = 256 * 496;
__host__ __device__ __forceinline__ int buck_off(int j) { return 256 * (31 * j - (j * (j - 1)) / 2); }

constexpr int RING_BYTES = 131072, LDS_BYTES = 163840, MISC_OFF = LDS_BYTES - 512;
constexpr int NWAVES = 8;

#define LDS_WAIT() asm volatile("s_waitcnt lgkmcnt(0)" ::: "memory")
#define VM_WAIT() asm volatile("s_waitcnt vmcnt(0)" ::: "memory")
#define RLX_AGENT __ATOMIC_RELAXED, __HIP_MEMORY_SCOPE_AGENT

__device__ __forceinline__ unsigned cvt_pk_bf16(float lo, float hi) { unsigned r; asm volatile("v_cvt_pk_bf16_f32 %0, %1, %2" : "=v"(r) : "v"(lo), "v"(hi)); return r; }
__device__ __forceinline__ float bf_lo(unsigned w) { return __uint_as_float(w << 16); }
__device__ __forceinline__ float bf_hi(unsigned w) { return __uint_as_float(w & 0xffff0000u); }
__device__ __forceinline__ unsigned pk_fp8x4(float a, float b, float c, float d) {
    a = fminf(fmaxf(a, -448.f), 448.f); b = fminf(fmaxf(b, -448.f), 448.f); c = fminf(fmaxf(c, -448.f), 448.f); d = fminf(fmaxf(d, -448.f), 448.f);
    unsigned w = 0; w = __builtin_amdgcn_cvt_pk_fp8_f32(a, b, w, false); w = __builtin_amdgcn_cvt_pk_fp8_f32(c, d, w, true); return w; }
constexpr float H8_SCALE = 8.f, WD8_SCALE = 256.f;
__device__ __forceinline__ int lane_fresh() { int l = (int)__builtin_amdgcn_mbcnt_hi(~0u, __builtin_amdgcn_mbcnt_lo(~0u, 0u)); asm volatile("" : "+v"(l)); return l; }
__device__ __forceinline__ unsigned pk_i8x4(float a, float b, float c, float d) {
    const int ia = (int)fminf(fmaxf(__builtin_rintf(a), -127.f), 127.f), ib = (int)fminf(fmaxf(__builtin_rintf(b), -127.f), 127.f);
    const int ic = (int)fminf(fmaxf(__builtin_rintf(c), -127.f), 127.f), id = (int)fminf(fmaxf(__builtin_rintf(d), -127.f), 127.f);
    return (unsigned)(ia & 255) | ((unsigned)(ib & 255) << 8) | ((unsigned)(ic & 255) << 16) | ((unsigned)(id & 255) << 24); }
__device__ __forceinline__ float wave_sum(float v) {
#pragma unroll
    for (int o = 1; o < 64; o <<= 1) v += __shfl_xor(v, o);
    return v;
}

#define XB_TMO      128
#define XB_XCNT(j)  (256  + 64 * (j))
#define XB_XSUB(j)  (1280 + 64 * (j))
#define XB_XGEN(j)  (2304 + 64 * (j))
#define XB_TOP      3328
#define XB_TOPGEN   3392
#define XCD_BAR_WORDS 3456
#define XB_SPIN_CAP (1u << 22)
__device__ __forceinline__ unsigned xb_ld(unsigned* p)              { return __hip_atomic_load(p, __ATOMIC_RELAXED, __HIP_MEMORY_SCOPE_AGENT); }
__device__ __forceinline__ unsigned xb_add(unsigned* p, unsigned v) { return __hip_atomic_fetch_add(p, v, __ATOMIC_RELAXED, __HIP_MEMORY_SCOPE_AGENT); }
__device__ __forceinline__ unsigned xb_xcc_id() { return (unsigned)__builtin_amdgcn_s_getreg((3 << 11) | 20) & 0xFu; }
#define XB_SPIN(cond, bar) do { unsigned _sp = 0; while (cond) { __builtin_amdgcn_s_sleep(1); \
    if ((++_sp & 255u) == 0u) { if (xb_ld(&(bar)[XB_TMO])) break; if (_sp > XB_SPIN_CAP) { atomicAdd(&(bar)[XB_TMO], 1u); break; } } } } while (0)
struct XcdBarrier { unsigned* bar; unsigned x; volatile LAS unsigned* st; };
__device__ __forceinline__ XcdBarrier xcd_barrier_post(unsigned* bar, volatile LAS unsigned* st) {
    XcdBarrier b; b.bar = bar; b.x = xb_xcc_id(); b.st = st;
    if (threadIdx.x == 0) (void)xb_add(&bar[XB_XCNT(b.x)], 1u);
    return b;
}
__device__ __forceinline__ void xcd_barrier_complete(unsigned* bar, unsigned x, unsigned& nloc, unsigned& nx) {
    const unsigned G = gridDim.x * gridDim.y * gridDim.z;
    unsigned sum, cnt, mine, sp = 0u;
    for (;;) {
        sum = 0u; cnt = 0u; mine = 0u;
#pragma unroll
        for (unsigned j = 0; j < 16; ++j) { const unsigned c = xb_ld(&bar[XB_XCNT(j)]); sum += c; cnt += (c > 0u) ? 1u : 0u; mine = (j == x) ? c : mine; }
        if (sum == G) break;
        __builtin_amdgcn_s_sleep(1);
        if ((++sp & 255u) == 0u) { if (xb_ld(&bar[XB_TMO])) break; if (sp > XB_SPIN_CAP) { atomicAdd(&bar[XB_TMO], 1u); break; } }
    }
    nloc = mine > 0u ? mine : 1u; nx = cnt > 0u ? cnt : 1u;
}
__device__ __forceinline__ void xcd_barrier(const XcdBarrier& b) {
    asm volatile("s_waitcnt vmcnt(0)" ::: "memory");
    __syncthreads();
    if (threadIdx.x == 0) {
        unsigned* bar = b.bar;
        __builtin_amdgcn_s_waitcnt(0);
        unsigned nloc = b.st[0], nx = b.st[1];
        if (nloc == 0u) { xcd_barrier_complete(bar, b.x, nloc, nx); b.st[0] = nloc; b.st[1] = nx; }
        const unsigned old = xb_add(&bar[XB_XSUB(b.x)], 1u);
        const unsigned gen = old / nloc;
        if (old + 1u == (gen + 1u) * nloc) {
            __builtin_amdgcn_fence(__ATOMIC_RELEASE, "agent");
            asm volatile("s_waitcnt vmcnt(0)" ::: "memory");
            const unsigned og = xb_add(&bar[XB_TOP], 1u);
            const unsigned tg = og / nx;
            if (og + 1u == (tg + 1u) * nx) xb_add(&bar[XB_TOPGEN], 1u);
            else XB_SPIN(xb_ld(&bar[XB_TOPGEN]) == tg, bar);
            __builtin_amdgcn_fence(__ATOMIC_ACQUIRE, "agent");
            xb_add(&bar[XB_XGEN(b.x)], 1u);
            asm volatile("s_waitcnt vmcnt(0)" ::: "memory");
        } else {
            XB_SPIN(xb_ld(&bar[XB_XGEN(b.x)]) == gen, bar);
            __builtin_amdgcn_fence(__ATOMIC_ACQUIRE, "agent");
            asm volatile("s_waitcnt vmcnt(0)" ::: "memory");
        }
    }
    __syncthreads();
}

namespace pg8 {
constexpr int BM = 256, BK = 64, HALF = 128, HTB = HALF * BK * 2, NXCD = 8, WGM = 8;
__host__ __device__ __forceinline__ int lds_byte(int r, int c) { const int st = (r >> 4) * 2 + (c >> 5), rr = r & 15, cc = c & 31, ob = rr * 64 + cc * 2; return st * 1024 + (ob ^ (((ob >> 9) & 1) << 5)); }
__host__ __device__ __forceinline__ void stage_rc(int b, int& R, int& C) { const int st = b / 1024, sb = b % 1024, swz = sb ^ (((sb >> 9) & 1) << 5); R = (st >> 1) * 16 + swz / 64; C = (st & 1) * 32 + (swz % 64) / 2; }
__host__ __device__ __forceinline__ int perm32(int rho) { const int n = rho >> 4, i = rho & 15; return 8 * (i >> 2) + 4 * n + (i & 3); }

struct Unit { int pm, pn, pb, ex; };
struct Gemm { const bf16* A; const bf16* Bt; int K; const int* rowidx; int lda; const bf16* A1; int ksplit; };

struct StaticOrder {
    int nM, nN, nwg, G, c;
    __device__ void init(int M, int N, int G_, int c_) { nM = M / BM; nN = N / BM; nwg = nM * nN; G = G_; c = c_; }
    __device__ bool next(int i, Unit& u) const {
        const long L = (long)i * G + c; if (L >= nwg) return false;
        int wgid = (int)L; { const int q = nwg / NXCD, r = nwg % NXCD, xcd = wgid % NXCD, off = wgid / NXCD; wgid = (xcd < r ? xcd * (q + 1) : r * (q + 1) + (xcd - r) * q) + off; }
        const int nig = WGM * nN, gid = wgid / nig, fm = gid * WGM, gsz = (nM - fm) < WGM ? (nM - fm) : WGM;
        u.pm = fm + ((wgid % nig) % gsz); u.pn = (wgid % nig) / gsz; u.pb = u.pn; u.ex = 0; return true;
    }
};
struct GroupedOrder {
    const LAS int* tstart;
    int nN, G, c, ntiles;
    __device__ bool next(int i, Unit& u) const {
        const long L = (long)i * G + c; if (L >= (long)ntiles * nN) return false;
        const int ti = (int)(L / nN), pn = (int)(L % nN);
        int e = 0;
#pragma unroll 1
        for (int k = 1; k < 32; ++k) e += (tstart[k] <= ti) ? 1 : 0;
        u.pm = ti; u.pn = pn; u.pb = e * nN + pn; u.ex = e; return true;
    }
};
struct MoeOrder {
    const LAS int* tstart; int nN, G, c; long j0, jend; int A, ratio;
    __device__ __forceinline__ bool next(int i, Unit& u) const {
        const int L = G - A; long k;
        if (ratio == 0 || A == 0) k = (long)i * G + c;
        else if (c >= A) k = i < ratio ? (long)i * L + (c - A) : (long)ratio * L + (long)(i - ratio) * G + c;
        else k = (long)ratio * L + (long)i * G + c;
        const long j = j0 + k; if (j >= jend) return false;
        const int ti = (int)(j / nN), pn = (int)(j % nN);
        const int ln = (int)__builtin_amdgcn_mbcnt_hi(~0u, __builtin_amdgcn_mbcnt_lo(~0u, 0u));
        const int tv = tstart[ln & 31];
        const int e = __builtin_popcountll(__ballot(ln >= 1 && ln < 32 && tv <= ti));
        u.pm = ti; u.pn = pn; u.pb = e * nN + pn; u.ex = e; return true;
    }
};

template <class Epi, class Sched, bool ALIGN_EPI, bool GATHER = false, int QMODE = 0>
__device__ __forceinline__ void gemm_phase(LAS unsigned char* lds, const Gemm g, const Sched& S, const Epi& E) {
    const int lane = lane_fresh(), wid = __builtin_amdgcn_readfirstlane((int)threadIdx.x >> 6), tid = wid * 64 + lane, wr = wid >> 2, wc = wid & 3, fr = lane & 15, fq = lane >> 4;
    const int K = g.K, nt = K / BK;
    int RA[2], CA[2]; unsigned voffB[2];
#pragma unroll
    for (int i = 0; i < 2; ++i) { int R, C; stage_rc(tid * 16 + i * 8192, R, C); const int Rb = Epi::PERM ? ((R & ~31) + perm32(R & 31)) : R;
        RA[i] = R; CA[i] = C; voffB[i] = (unsigned)(Rb * K + C) * 2u; }
    const size_t kstep = (size_t)(BK * 2);
    const size_t hstep = (size_t)HALF * K * 2;
    const size_t tstep = 2 * hstep;
    const unsigned ldsw = (unsigned)wid * 1024u;
    const int aoff = lds_byte(wr * 64 + fr, fq * 8), boff = lds_byte(wc * 32 + fr, fq * 8);
#define PG8_SA(b, h) (((b) * 2 + (h)) * HTB)
#define PG8_SB(b, h) ((4 + (b) * 2 + (h)) * HTB)
#define PG8_STAGEB(bufoff, gbase) do { _Pragma("unroll") for (int _i = 0; _i < 2; ++_i) \
        __builtin_amdgcn_global_load_lds((const unsigned*)((const char*)(gbase) + voffB[_i]), (LAS unsigned*)(lds + (bufoff) + ldsw + _i * 8192), 16, 0, 0); } while (0)
#define PG8_STAGEA(bufoff, gbase, vo, h) do { _Pragma("unroll") for (int _i = 0; _i < 2; ++_i) \
        __builtin_amdgcn_global_load_lds((const unsigned*)((const char*)(gbase) + (vo)[h][_i]), (LAS unsigned*)(lds + (bufoff) + ldsw + _i * 8192), 16, 0, 0); } while (0)
#define PG8_LDA(dst, b, h) do { _Pragma("unroll") for (int m = 0; m < 4; ++m) _Pragma("unroll") for (int k = 0; k < 2; ++k) dst[m][k] = *(const LAS bf16x8*)(lds + PG8_SA(b, h) + aoff + m * 2048 + k * 1024); } while (0)
#define PG8_LDB(dst, b, h) do { _Pragma("unroll") for (int n = 0; n < 2; ++n) _Pragma("unroll") for (int k = 0; k < 2; ++k) dst[n][k] = *(const LAS bf16x8*)(lds + PG8_SB(b, h) + boff + n * 2048 + k * 1024); } while (0)
#define PG8_CAT(x0, x1) __builtin_shufflevector(__builtin_bit_cast(i32x4, x0), __builtin_bit_cast(i32x4, x1), 0, 1, 2, 3, 4, 5, 6, 7)
#define PG8_MMA(ai, bj, At, Bt) do { __builtin_amdgcn_s_setprio(1); _Pragma("unroll") for (int m = 0; m < 4; ++m) _Pragma("unroll") for (int n = 0; n < 2; ++n) { \
        if constexpr (QMODE == 1) asm volatile("v_mfma_scale_f32_16x16x128_f8f6f4 %0, %1, %2, %0, %3, %3 op_sel_hi:[0,0,0]" : "+v"(acc[ai][bj][m][n]) : "v"(PG8_CAT(Bt[n][0], Bt[n][1])), "v"(PG8_CAT(At[m][0], At[m][1])), "v"(sc1)); \
        else if constexpr (QMODE == 2) { _Pragma("unroll") for (int k = 0; k < 2; ++k) acc[ai][bj][m][n] = __builtin_bit_cast(f32x4, __builtin_amdgcn_mfma_i32_16x16x64_i8(__builtin_bit_cast(i32x4, Bt[n][k]), __builtin_bit_cast(i32x4, At[m][k]), __builtin_bit_cast(i32x4, acc[ai][bj][m][n]), 0, 0, 0)); } \
        else { _Pragma("unroll") for (int k = 0; k < 2; ++k) acc[ai][bj][m][n] = __builtin_amdgcn_mfma_f32_16x16x32_bf16(Bt[n][k], At[m][k], acc[ai][bj][m][n], 0, 0, 0); } } __builtin_amdgcn_s_setprio(0); } while (0)
#define PG8_WAIT_V(n) asm volatile("s_waitcnt vmcnt(" #n ")" ::: "memory")
#define PG8_WAIT_L(n) asm volatile("s_waitcnt lgkmcnt(" #n ")" ::: "memory")
#define PG8_BAR __builtin_amdgcn_s_barrier()
#define PG8_SCHED __builtin_amdgcn_sched_barrier(0)
#define PG8_AOFF(vo, u) do { _Pragma("unroll") for (int _h = 0; _h < 2; ++_h) _Pragma("unroll") for (int _i = 0; _i < 2; ++_i) { \
        const int _r = (GATHER ? (u).pm * BM : 0) + _h * HALF + RA[_i]; const int _row = GATHER ? g.rowidx[_r] : _r; (vo)[_h][_i] = (unsigned)(_row * g.lda + CA[_i]) * 2u; } } while (0)
    Unit cur, nxt; int ui = 0;
    if (!S.next(0, cur)) return;
    int sc1 = 0x7f7f7f7f; asm volatile("" : "+v"(sc1));
    f32x4 acc[2][2][4][2];
#pragma unroll
    for (int a = 0; a < 2; ++a)
#pragma unroll
        for (int b = 0; b < 2; ++b)
#pragma unroll
            for (int m = 0; m < 4; ++m)
#pragma unroll
                for (int n = 0; n < 2; ++n) acc[a][b][m][n] = (f32x4){0.f, 0.f, 0.f, 0.f};
    bf16x8 At[4][2], B0[2][2], B1[2][2];
    unsigned voC[2][2], voN[2][2];
    PG8_AOFF(voC, cur);
    const size_t tstepA = (size_t)BM * g.lda * 2;
    const char* cA = (const char*)g.A + (GATHER ? 0 : (size_t)cur.pm * tstepA); const char* cA1 = (const char*)g.A1 - (size_t)g.ksplit * kstep + (GATHER ? 0 : (size_t)cur.pm * tstepA);
#define PG8_AP(t_) (((t_) < g.ksplit ? cA : cA1) + (size_t)(t_) * kstep)
    const char* cB = (const char*)g.Bt + (size_t)cur.pb * tstep;
    PG8_STAGEB(PG8_SB(0, 0), cB); PG8_STAGEB(PG8_SB(0, 1), cB + hstep); PG8_STAGEA(PG8_SA(0, 0), cA, voC, 0); PG8_STAGEA(PG8_SA(0, 1), cA, voC, 1);
    if (wr == 1) PG8_BAR;
    PG8_WAIT_V(2); PG8_BAR;
    PG8_STAGEB(PG8_SB(1, 0), cB + kstep); PG8_STAGEA(PG8_SA(1, 0), PG8_AP(1), voC, 0); PG8_STAGEB(PG8_SB(1, 1), cB + hstep + kstep);
    PG8_WAIT_V(6); PG8_BAR;
    for (;;) {
        const bool has_next = S.next(ui + 1, nxt);
        if constexpr (GATHER) { if (has_next) { PG8_AOFF(voN, nxt); } else {
#pragma unroll
            for (int _h = 0; _h < 2; ++_h)
#pragma unroll
                for (int _i = 0; _i < 2; ++_i) voN[_h][_i] = voC[_h][_i]; } }
        const char* nB = has_next ? (const char*)g.Bt + (size_t)nxt.pb * tstep : cB;
        const char* nA = (GATHER || !has_next) ? cA : (const char*)g.A + (size_t)nxt.pm * tstepA;
        const char* nA1 = (GATHER || !has_next) ? cA1 : (const char*)g.A1 - (size_t)g.ksplit * kstep + (size_t)nxt.pm * tstepA;
        for (int t = 0; t < nt; t += 2) {
            const bool last = (t == nt - 2);
            const char* a1 = PG8_AP(t + 1);
            const char* a2 = last ? nA : PG8_AP(t + 2); const char* b2 = last ? nB : cB + (size_t)(t + 2) * kstep;
            const char* a3 = last ? nA + kstep : PG8_AP(t + 3); const char* b3 = b2 + kstep;
            if constexpr (Epi::MIDHOOK) { if (t == g.ksplit) E.mid(acc, cur, wr, wc, fr, fq); }
            unsigned vo2[2][2];
#pragma unroll
            for (int _h = 0; _h < 2; ++_h)
#pragma unroll
                for (int _i = 0; _i < 2; ++_i) { if constexpr (GATHER) vo2[_h][_i] = last ? voN[_h][_i] : voC[_h][_i]; else vo2[_h][_i] = voC[_h][_i]; }
            PG8_LDB(B0, 0, 0); PG8_LDB(B1, 0, 1); PG8_SCHED; PG8_LDA(At, 0, 0); PG8_STAGEA(PG8_SA(1, 1), a1, voC, 1);
            PG8_WAIT_V(8); PG8_WAIT_L(0); PG8_BAR; PG8_MMA(0, 0, At, B0); PG8_MMA(0, 1, At, B1); PG8_BAR; PG8_SCHED;
            PG8_LDA(At, 0, 1); PG8_STAGEB(PG8_SB(0, 0), b2); PG8_STAGEB(PG8_SB(0, 1), b2 + hstep); PG8_STAGEA(PG8_SA(0, 0), a2, vo2, 0);
            PG8_WAIT_V(8); PG8_WAIT_L(0); PG8_BAR; PG8_MMA(1, 0, At, B0); PG8_MMA(1, 1, At, B1); PG8_BAR; PG8_SCHED;
            PG8_LDB(B0, 1, 0); PG8_LDB(B1, 1, 1); PG8_SCHED; PG8_LDA(At, 1, 0); PG8_STAGEA(PG8_SA(0, 1), a2, vo2, 1);
            PG8_WAIT_V(8); PG8_WAIT_L(0); PG8_BAR; PG8_MMA(0, 0, At, B0); PG8_MMA(0, 1, At, B1); PG8_BAR; PG8_SCHED;
            PG8_LDA(At, 1, 1); PG8_STAGEB(PG8_SB(1, 0), b3); PG8_STAGEB(PG8_SB(1, 1), b3 + hstep); PG8_STAGEA(PG8_SA(1, 0), a3, vo2, 0);
            PG8_WAIT_V(8); PG8_WAIT_L(0); PG8_BAR; PG8_MMA(1, 0, At, B0); PG8_MMA(1, 1, At, B1); PG8_BAR; PG8_SCHED;
        }
        if constexpr (ALIGN_EPI) { if (wr == 0) PG8_BAR; }
        if constexpr (QMODE == 1) asm volatile("s_nop 15\n\ts_nop 15\n\ts_nop 15\n\ts_nop 15\n\ts_nop 15" ::: "memory");
        if constexpr (QMODE == 2) {
#pragma unroll
            for (int a = 0; a < 2; ++a)
#pragma unroll
                for (int b = 0; b < 2; ++b)
#pragma unroll
                    for (int m = 0; m < 4; ++m)
#pragma unroll
                        for (int n = 0; n < 2; ++n) acc[a][b][m][n] = __builtin_convertvector(__builtin_bit_cast(i32x4, acc[a][b][m][n]), f32x4); }
        E(acc, cur, wr, wc, fr, fq);
        if (!has_next) break;
#pragma unroll
        for (int a = 0; a < 2; ++a)
#pragma unroll
            for (int b = 0; b < 2; ++b)
#pragma unroll
                for (int m = 0; m < 4; ++m)
#pragma unroll
                    for (int n = 0; n < 2; ++n) acc[a][b][m][n] = (f32x4){0.f, 0.f, 0.f, 0.f};
        cur = nxt; cB = nB; cA = nA; cA1 = nA1; ++ui;
        if constexpr (GATHER) {
#pragma unroll
            for (int _h = 0; _h < 2; ++_h)
#pragma unroll
                for (int _i = 0; _i < 2; ++_i) voC[_h][_i] = voN[_h][_i]; }
        if constexpr (ALIGN_EPI) { if (wr == 1) PG8_BAR; }
    }
    PG8_WAIT_V(0);
    if constexpr (!ALIGN_EPI) { if (wr == 0) PG8_BAR; }
    PG8_BAR;
#undef PG8_SA
#undef PG8_SB
#undef PG8_STAGEA
#undef PG8_STAGEB
#undef PG8_LDA
#undef PG8_LDB
#undef PG8_MMA
#undef PG8_WAIT_V
#undef PG8_WAIT_L
#undef PG8_BAR
#undef PG8_SCHED
#undef PG8_AOFF
#undef PG8_AP
#undef PG8_CAT
}

#define EPI_LOOP_BEGIN _Pragma("unroll") for (int ai = 0; ai < 2; ++ai) _Pragma("unroll") for (int m = 0; m < 4; ++m) { const int row = u.pm * BM + ai * HALF + wr * 64 + m * 16 + fr; _Pragma("unroll") for (int bj = 0; bj < 2; ++bj) { const int colt = bj * HALF + wc * 32 + 8 * fq;
#define EPI_LOOP_END } }
__device__ __forceinline__ int opaque0() { int z = 0; asm volatile("" : "+v"(z)); return z; }
__device__ __forceinline__ u32x4 pack8(f32x4 v0, f32x4 v1) { u32x4 w; w.x = cvt_pk_bf16(v0[0], v0[1]); w.y = cvt_pk_bf16(v0[2], v0[3]); w.z = cvt_pk_bf16(v1[0], v1[1]); w.w = cvt_pk_bf16(v1[2], v1[3]); return w; }
__device__ __forceinline__ void unpack8(u32x4 w, f32x4& a, f32x4& b) { a = (f32x4){bf_lo(w.x), bf_hi(w.x), bf_lo(w.y), bf_hi(w.y)}; b = (f32x4){bf_lo(w.z), bf_hi(w.z), bf_lo(w.w), bf_hi(w.w)}; }

struct EpiQKV {
    static constexpr bool PERM = true, MIDHOOK = false;
    bf16* O; int pn0; const float* rsc; const float* csc;
    float* kmean;
    __device__ __forceinline__ void operator()(const f32x4 (&acc)[2][2][4][2], const Unit& u, int wr, int wc, int fr_, int fq_) const {
        const int fr = fr_ + opaque0(), fq = fq_ + opaque0();
        const int pn = u.pn + pn0;
        bf16* base = O + (size_t)(pn >> 2) * ((size_t)NTOK * WQ) + (pn & 3) * 256;
        float rs8[2][4];
#pragma unroll
        for (int ai = 0; ai < 2; ++ai)
#pragma unroll
            for (int m = 0; m < 4; ++m) rs8[ai][m] = rsc ? rsc[u.pm * BM + ai * HALF + wr * 64 + m * 16 + fr] : 1.f;
        f32x4 cs[2][2];
#pragma unroll
        for (int bj = 0; bj < 2; ++bj) { const int c = u.pn * BM + bj * HALF + wc * 32 + 8 * fq; cs[bj][0] = rsc ? *(const f32x4*)(csc + c) : (f32x4){1.f, 1.f, 1.f, 1.f}; cs[bj][1] = rsc ? *(const f32x4*)(csc + c + 4) : (f32x4){1.f, 1.f, 1.f, 1.f}; }
        EPI_LOOP_BEGIN
            const f32x4 v0 = acc[ai][bj][m][0] * rs8[ai][m] * cs[bj][0], v1 = acc[ai][bj][m][1] * rs8[ai][m] * cs[bj][1];
            *(u32x4*)(base + (size_t)row * WQ + colt) = pack8(v0, v1);
        EPI_LOOP_END
        if (kmean != nullptr && (pn >> 2) == 1) {
#pragma unroll
            for (int bj = 0; bj < 2; ++bj)
#pragma unroll
                for (int n = 0; n < 2; ++n) { f32x4 sm = (f32x4){0.f, 0.f, 0.f, 0.f};
#pragma unroll
                    for (int ai = 0; ai < 2; ++ai)
#pragma unroll
                        for (int m = 0; m < 4; ++m) sm += acc[ai][bj][m][n] * rs8[ai][m];
                    if (rsc) sm = sm * *(const f32x4*)(csc + u.pn * BM + bj * HALF + wc * 32 + 8 * fq + 4 * n);
#pragma unroll
                    for (int e = 0; e < 4; ++e) { float v = sm[e]; v += __shfl_xor(v, 1); v += __shfl_xor(v, 2); v += __shfl_xor(v, 4); v += __shfl_xor(v, 8); sm[e] = v; }
                    if ((fr_ & 15) == 0) { float* dst = kmean + ((size_t)((u.pm >> 5) * NH + (pn & 3) * 2 + bj) * 32 + (u.pm & 31)) * HD + wc * 32 + 8 * fq + 4 * n;
#pragma unroll
                        for (int e = 0; e < 4; ++e) atomicAdd(dst + e, sm[e] * (1.f / 256.f)); } }
        }
    }
};
struct EpiGates {
    static constexpr bool PERM = true, MIDHOOK = false;
    bf16* GD; bf16* R; const float* bias; const float* rsc; const float* csc;
    __device__ __forceinline__ void operator()(const f32x4 (&acc)[2][2][4][2], const Unit& u, int wr, int wc, int fr_, int fq_) const {
        const int fr = fr_ + opaque0(), fq = fq_ + opaque0();
        const int cl = wc * 32 + 8 * fq, col = u.pn * HALF + cl;
        const f32x4 cm0 = *(const f32x4*)(csc + u.pn * BM + cl), cm1 = *(const f32x4*)(csc + u.pn * BM + cl + 4), cd0 = *(const f32x4*)(csc + u.pn * BM + HALF + cl), cd1 = *(const f32x4*)(csc + u.pn * BM + HALF + cl + 4);
        const f32x4 bm0 = *(const f32x4*)(bias + col), bm1 = *(const f32x4*)(bias + col + 4), bd0 = *(const f32x4*)(bias + DM + col), bd1 = *(const f32x4*)(bias + DM + col + 4);
#pragma unroll
        for (int ai = 0; ai < 2; ++ai)
#pragma unroll
            for (int m = 0; m < 4; ++m) { const int row = u.pm * BM + ai * HALF + wr * 64 + m * 16 + fr; const float r = rsc[row];
                f32x4 am0 = acc[ai][0][m][0] * r * cm0 + bm0, am1 = acc[ai][0][m][1] * r * cm1 + bm1, ad0 = acc[ai][1][m][0] * r * cd0 + bd0, ad1 = acc[ai][1][m][1] * r * cd1 + bd1;
                f32x4 gd0, gd1, rr0, rr1;
#pragma unroll
                for (int e = 0; e < 4; ++e) { const float im0 = 1.f + __builtin_amdgcn_exp2f(-LOG2E * am0[e]), im1 = 1.f + __builtin_amdgcn_exp2f(-LOG2E * am1[e]);
                    const float id0 = 1.f + __builtin_amdgcn_exp2f(-LOG2E * ad0[e]), id1 = 1.f + __builtin_amdgcn_exp2f(-LOG2E * ad1[e]);
                    gd0[e] = __builtin_amdgcn_rcpf(id0); gd1[e] = __builtin_amdgcn_rcpf(id1); rr0[e] = id0 * __builtin_amdgcn_rcpf(im0); rr1[e] = id1 * __builtin_amdgcn_rcpf(im1); }
                *(u32x4*)(GD + (size_t)row * DM + col) = pack8(gd0, gd1); *(u32x4*)(R + (size_t)row * DM + col) = pack8(rr0, rr1); }
    }
};
template <bool ADD> struct EpiMix {
    static constexpr bool PERM = true, MIDHOOK = false;
    bf16* MIX; const bf16* G; int goff;
    __device__ __forceinline__ void operator()(const f32x4 (&acc)[2][2][4][2], const Unit& u, int wr, int wc, int fr_, int fq_) const {
        const int fr = fr_ + opaque0(), fq = fq_ + opaque0();
        EPI_LOOP_BEGIN
            const int col = u.pn * BM + colt;
            f32x4 g0, g1; unpack8(*(const u32x4*)(G + (size_t)row * NGATE + goff + col), g0, g1);
            f32x4 v0 = acc[ai][bj][m][0] * g0, v1 = acc[ai][bj][m][1] * g1;
            if (ADD) { f32x4 t0, t1; unpack8(*(const u32x4*)(MIX + (size_t)row * DM + col), t0, t1); v0 += t0; v1 += t1; }
            *(u32x4*)(MIX + (size_t)row * DM + col) = pack8(v0, v1);
        EPI_LOOP_END
    }
};
struct EpiMix2 {
    static constexpr bool PERM = true, MIDHOOK = true;
    bf16* MIX; const bf16* GD; const bf16* R; unsigned* mmax;
    __device__ __forceinline__ void mid(f32x4 (&acc)[2][2][4][2], const Unit& u, int wr, int wc, int fr_, int fq_) const {
        const int fr = fr_ + opaque0(), fq = fq_ + opaque0();
#pragma unroll
        for (int ai = 0; ai < 2; ++ai) {
            u32x4 rw[4][2];
#pragma unroll
            for (int m = 0; m < 4; ++m) { const int row = u.pm * BM + ai * HALF + wr * 64 + m * 16 + fr;
#pragma unroll
                for (int bj = 0; bj < 2; ++bj) rw[m][bj] = *(const u32x4*)(R + (size_t)row * DM + u.pn * BM + bj * HALF + wc * 32 + 8 * fq); }
#pragma unroll
            for (int m = 0; m < 4; ++m)
#pragma unroll
                for (int bj = 0; bj < 2; ++bj) { f32x4 r0, r1; unpack8(rw[m][bj], r0, r1); acc[ai][bj][m][0] *= r0; acc[ai][bj][m][1] *= r1; }
#pragma unroll
            for (int m = 0; m < 4; ++m) asm volatile("" : "+v"(acc[ai][0][m][0]), "+v"(acc[ai][0][m][1]), "+v"(acc[ai][1][m][0]), "+v"(acc[ai][1][m][1]) :: "memory");
        }
    }
    __device__ __forceinline__ void operator()(const f32x4 (&acc)[2][2][4][2], const Unit& u, int wr, int wc, int fr_, int fq_) const {
        const int fr = fr_ + opaque0(), fq = fq_ + opaque0();
#pragma unroll
        for (int ai = 0; ai < 2; ++ai) {
            u32x4 gw8[4][2];
#pragma unroll
            for (int m = 0; m < 4; ++m)
#pragma unroll
                for (int bj = 0; bj < 2; ++bj) gw8[m][bj] = *(const u32x4*)(GD + (size_t)(u.pm * BM + ai * HALF + wr * 64 + m * 16 + fr) * DM + u.pn * BM + bj * HALF + wc * 32 + 8 * fq);
#pragma unroll
            for (int m = 0; m < 4; ++m) { const int row = u.pm * BM + ai * HALF + wr * 64 + m * 16 + fr; float mx = 0.f;
#pragma unroll
                for (int bj = 0; bj < 2; ++bj) { const int col = u.pn * BM + bj * HALF + wc * 32 + 8 * fq;
                    f32x4 g0, g1; unpack8(gw8[m][bj], g0, g1);
                    const f32x4 v0 = acc[ai][bj][m][0] * g0, v1 = acc[ai][bj][m][1] * g1;
                    *(u32x4*)(MIX + (size_t)row * DM + col) = pack8(v0, v1);
#pragma unroll
                    for (int e = 0; e < 4; ++e) mx = fmaxf(mx, fmaxf(fabsf(v0[e]), fabsf(v1[e]))); }
                mx = fmaxf(mx, __shfl_xor(mx, 16)); mx = fmaxf(mx, __shfl_xor(mx, 32));
                if (fq == 0) __hip_atomic_fetch_max(mmax + row, __float_as_uint(mx), RLX_AGENT); }
        }
    }
};
struct EpiResid {
    static constexpr bool PERM = true, MIDHOOK = false;
    const float* X; bf16* X1H; bf16* X1L; const float* g2; unsigned* umax;
    const float* rsc; const float* csc;
    __device__ __forceinline__ void operator()(const f32x4 (&acc)[2][2][4][2], const Unit& u, int wr, int wc, int fr_, int fq_) const {
        const int fr = fr_ + opaque0(), fq = fq_ + opaque0();
        f32x4 gg[2][2];
#pragma unroll
        for (int bj = 0; bj < 2; ++bj) { const int c = u.pn * BM + bj * HALF + wc * 32 + 8 * fq; gg[bj][0] = *(const f32x4*)(g2 + c); gg[bj][1] = *(const f32x4*)(g2 + c + 4); }
        float rs8[2][4];
#pragma unroll
        for (int ai = 0; ai < 2; ++ai)
#pragma unroll
            for (int m = 0; m < 4; ++m) rs8[ai][m] = rsc[u.pm * BM + ai * HALF + wr * 64 + m * 16 + fr];
        f32x4 cs[2][2];
#pragma unroll
        for (int bj = 0; bj < 2; ++bj) { const int c = u.pn * BM + bj * HALF + wc * 32 + 8 * fq; cs[bj][0] = *(const f32x4*)(csc + c); cs[bj][1] = *(const f32x4*)(csc + c + 4); }
#pragma unroll
        for (int ai = 0; ai < 2; ++ai)
#pragma unroll
          for (int mh = 0; mh < 2; ++mh) {
            f32x4 xr8[2][2][2];
#pragma unroll
            for (int ml = 0; ml < 2; ++ml)
#pragma unroll
                for (int bj = 0; bj < 2; ++bj) { const size_t o = (size_t)(u.pm * BM + ai * HALF + wr * 64 + (2 * mh + ml) * 16 + fr) * DM + u.pn * BM + bj * HALF + wc * 32 + 8 * fq;
                    xr8[ml][bj][0] = *(const f32x4*)(X + o); xr8[ml][bj][1] = *(const f32x4*)(X + o + 4); }
#pragma unroll
            for (int ml = 0; ml < 2; ++ml) { const int m = 2 * mh + ml; const int row = u.pm * BM + ai * HALF + wr * 64 + m * 16 + fr; float mx = 0.f;
#pragma unroll
                for (int bj = 0; bj < 2; ++bj) { const size_t o = (size_t)row * DM + u.pn * BM + bj * HALF + wc * 32 + 8 * fq;
                    const float rs_ = rs8[ai][m];
                    const f32x4 v0 = xr8[ml][bj][0] + acc[ai][bj][m][0] * rs_ * cs[bj][0], v1 = xr8[ml][bj][1] + acc[ai][bj][m][1] * rs_ * cs[bj][1];
                    u32x4 hw, lw;
                    hw.x = cvt_pk_bf16(v0[0], v0[1]); lw.x = cvt_pk_bf16(v0[0] - bf_lo(hw.x), v0[1] - bf_hi(hw.x));
                    hw.y = cvt_pk_bf16(v0[2], v0[3]); lw.y = cvt_pk_bf16(v0[2] - bf_lo(hw.y), v0[3] - bf_hi(hw.y));
                    hw.z = cvt_pk_bf16(v1[0], v1[1]); lw.z = cvt_pk_bf16(v1[0] - bf_lo(hw.z), v1[1] - bf_hi(hw.z));
                    hw.w = cvt_pk_bf16(v1[2], v1[3]); lw.w = cvt_pk_bf16(v1[2] - bf_lo(hw.w), v1[3] - bf_hi(hw.w));
                    *(u32x4*)(X1H + o) = hw; *(u32x4*)(X1L + o) = lw;
                    const f32x4 a0 = v0 * gg[bj][0], a1 = v1 * gg[bj][1];
#pragma unroll
                    for (int e = 0; e < 4; ++e) mx = fmaxf(mx, fmaxf(fabsf(a0[e]), fabsf(a1[e]))); }
                mx = fmaxf(mx, __shfl_xor(mx, 16)); mx = fmaxf(mx, __shfl_xor(mx, 32));
                if (fq == 0) __hip_atomic_fetch_max(umax + row, __float_as_uint(mx), RLX_AGENT); }
          }
    }
};
struct EpiMoe1 {
    static constexpr bool PERM = true, MIDHOOK = false;
    bf16* H; const float* rms; const int* rowtok; const float* rsu; const float* csgu;
    __device__ __forceinline__ void operator()(const f32x4 (&acc)[2][2][4][2], const Unit& u, int wr, int wc, int fr_, int fq_) const {
        const int fr = fr_ + opaque0(), fq = fq_ + opaque0();
        const float* cg = csgu + (size_t)u.ex * 1024 + u.pn * BM + wc * 32 + 8 * fq;
        const f32x4 cg0 = *(const f32x4*)cg, cg1 = *(const f32x4*)(cg + 4), cu0 = *(const f32x4*)(cg + HALF), cu1 = *(const f32x4*)(cg + HALF + 4);
        int tk8[2][4];
#pragma unroll
        for (int ai = 0; ai < 2; ++ai)
#pragma unroll
            for (int m = 0; m < 4; ++m) tk8[ai][m] = rowtok[u.pm * BM + ai * HALF + wr * 64 + m * 16 + fr];
        float rs8[2][4];
#pragma unroll
        for (int ai = 0; ai < 2; ++ai)
#pragma unroll
            for (int m = 0; m < 4; ++m) rs8[ai][m] = rms[tk8[ai][m]] * rsu[tk8[ai][m]];
#pragma unroll
        for (int ai = 0; ai < 2; ++ai)
#pragma unroll
            for (int m = 0; m < 4; ++m) { const int row = u.pm * BM + ai * HALF + wr * 64 + m * 16 + fr; const float rs = rs8[ai][m];
                f32x4 o[2];
#pragma unroll
                for (int n = 0; n < 2; ++n)
#pragma unroll
                    for (int e = 0; e < 4; ++e) { const float gt = acc[ai][0][m][n][e] * rs * (n ? cg1[e] : cg0[e]), up = acc[ai][1][m][n][e] * rs * (n ? cu1[e] : cu0[e]);
                        o[n][e] = gt * __builtin_amdgcn_rcpf(1.f + __builtin_amdgcn_exp2f(-LOG2E * gt)) * up; }
                u32x2 h8; h8.x = pk_fp8x4(o[0][0] * H8_SCALE, o[0][1] * H8_SCALE, o[0][2] * H8_SCALE, o[0][3] * H8_SCALE); h8.y = pk_fp8x4(o[1][0] * H8_SCALE, o[1][1] * H8_SCALE, o[1][2] * H8_SCALE, o[1][3] * H8_SCALE);
                *(u32x2*)((unsigned char*)H + (size_t)row * DEXP + u.pn * HALF + wc * 32 + 8 * fq) = h8; }
    }
};
struct EpiMoe2 {
    static constexpr bool PERM = true, MIDHOOK = false;
    unsigned char* Y; float* YS; const float* roww;
    __device__ __forceinline__ void operator()(const f32x4 (&acc)[2][2][4][2], const Unit& u, int wr, int wc, int fr_, int fq_) const {
        const int fr = fr_ + opaque0(), fq = fq_ + opaque0();
        float rs8[2][4];
#pragma unroll
        for (int ai = 0; ai < 2; ++ai)
#pragma unroll
            for (int m = 0; m < 4; ++m) rs8[ai][m] = roww[u.pm * BM + ai * HALF + wr * 64 + m * 16 + fr] * (1.f / (H8_SCALE * WD8_SCALE));
        EPI_LOOP_BEGIN
            const float w = rs8[ai][m];
            const f32x4 v0 = acc[ai][bj][m][0] * w, v1 = acc[ai][bj][m][1] * w;
            float mx = fmaxf(fmaxf(fmaxf(fabsf(v0[0]), fabsf(v0[1])), fmaxf(fabsf(v0[2]), fabsf(v0[3]))), fmaxf(fmaxf(fabsf(v1[0]), fabsf(v1[1])), fmaxf(fabsf(v1[2]), fabsf(v1[3]))));
            mx = fmaxf(mx, __shfl_xor(mx, 16)); mx = fmaxf(mx, __shfl_xor(mx, 32));
            const float qs = mx > 0.f ? 127.f / mx : 0.f; const int col = u.pn * BM + colt;
            u32x2 q; q.x = pk_i8x4(v0[0] * qs, v0[1] * qs, v0[2] * qs, v0[3] * qs); q.y = pk_i8x4(v1[0] * qs, v1[1] * qs, v1[2] * qs, v1[3] * qs);
            *(u32x2*)(Y + (size_t)row * DM + col) = q;
            if (fq == 0) YS[(size_t)row * 64 + (col >> 5)] = mx * (1.f / 127.f);
        EPI_LOOP_END
    }
};
}

namespace att {
constexpr int SHM_K = 16384, SHM_V = 16384;
constexpr int L_V = 0, L_K = 2 * SHM_V;
constexpr int OST_STRIDE = 68, OST_WAVE = 32 * OST_STRIDE * 4;
constexpr int L_OST = 65536;
constexpr int L_TAB = 136 * 1024;
constexpr int L_SELPFX = 148 * 1024;
#define KSWZ(row, colB) ((row) * 256 + ((colB) ^ (((row) & 7) << 4)))
#define SBAR() __builtin_amdgcn_sched_barrier(0)
__device__ __forceinline__ int v_st(int k, int c) { const int kk = (k & ~0xC) | ((k & 4) << 1) | ((k & 8) >> 1); return ((kk >> 3) * 4 + (c >> 5)) * 512 + ((kk & 7) * 32 + (c & 31)) * 2; }
__device__ __forceinline__ int v_rd_base(int lane) { return ((lane & 3) << 3) | (((lane >> 2) & 3) << 6) | (((lane >> 4) & 1) << 5) | (((lane >> 5) & 1) << 8); }
constexpr int v_rd_off(int d0, int ks, int half) { return d0 * 512 + ks * 4096 + half * 2048; }
__device__ __forceinline__ int crow(int r, int hi) { return (r & 3) + 8 * (r >> 2) + 4 * hi; }

template <int KB>
__device__ __forceinline__ void qkt(f32x16& p0, f32x16& p1, const LAS char* K_lds, int r32, int hi, const bf16x8* qr, float bkc) {
#pragma unroll
    for (int r = 0; r < 16; ++r) { const float c_ = (float)((r & 3) + 8 * (r >> 2)); p0[r] = c_ * bkc; p1[r] = c_ * bkc; }
    const LAS char* kb[4];
#pragma unroll
    for (int dd = 0; dd < 4; ++dd) kb[dd] = K_lds + KB * SHM_K + KSWZ(r32, (dd * 16 + hi * 8) * 2);
#pragma unroll
    for (int d0 = 0; d0 < 8; ++d0) { const LAS char* a = kb[d0 & 3] + (d0 >> 2) * 128;
        bf16x8 b0 = *reinterpret_cast<const LAS bf16x8*>(a);
        bf16x8 b1 = *reinterpret_cast<const LAS bf16x8*>(a + 32 * 256);
        p0 = __builtin_amdgcn_mfma_f32_32x32x16_bf16(b0, qr[d0], p0, 0, 0, 0);
        p1 = __builtin_amdgcn_mfma_f32_32x32x16_bf16(b1, qr[d0], p1, 0, 0, 0); }
}
template <int VB>
__device__ __forceinline__ void pv_tile(f32x16* o, int vb0, bf16x8 pa0, bf16x8 pa1, bf16x8 pa2, bf16x8 pa3) {
#define TRRD(dst, off) asm volatile("ds_read_b64_tr_b16 %0, %1 offset:%2" : "=&v"(dst) : "v"(vb0), "i"(off) : "memory")
#define PV_D0(d0) do { s16x4 l0, l1, l2, l3, h0, h1, h2, h3; constexpr int b_ = VB * SHM_V + v_rd_off(d0, 0, 0); \
        TRRD(l0, b_); TRRD(h0, b_ + 2048); TRRD(l1, b_ + 4096); TRRD(h1, b_ + 6144); TRRD(l2, b_ + 8192); TRRD(h2, b_ + 10240); TRRD(l3, b_ + 12288); TRRD(h3, b_ + 14336); \
        asm volatile("s_waitcnt lgkmcnt(0)" ::: "memory"); SBAR(); \
        o[d0] = __builtin_amdgcn_mfma_f32_32x32x16_bf16((bf16x8){l0[0], l0[1], l0[2], l0[3], h0[0], h0[1], h0[2], h0[3]}, pa0, o[d0], 0, 0, 0); \
        o[d0] = __builtin_amdgcn_mfma_f32_32x32x16_bf16((bf16x8){l1[0], l1[1], l1[2], l1[3], h1[0], h1[1], h1[2], h1[3]}, pa1, o[d0], 0, 0, 0); \
        o[d0] = __builtin_amdgcn_mfma_f32_32x32x16_bf16((bf16x8){l2[0], l2[1], l2[2], l2[3], h2[0], h2[1], h2[2], h2[3]}, pa2, o[d0], 0, 0, 0); \
        o[d0] = __builtin_amdgcn_mfma_f32_32x32x16_bf16((bf16x8){l3[0], l3[1], l3[2], l3[3], h3[0], h3[1], h3[2], h3[3]}, pa3, o[d0], 0, 0, 0); } while (0)
    PV_D0(0); PV_D0(1); PV_D0(2); PV_D0(3);
#undef PV_D0
#undef TRRD
}

struct Parts { const bf16* pbase[3]; const float* plse[3]; const float* psc[3]; };
template <int NMERGE>
__device__ __forceinline__ void row_epilogue(f32x16 (&o)[4], float m_reg, float l_reg, int hi, bf16* dstb, long ro, float* lseb, float* scb, int li, int nparts, const Parts& P) {
    const bool ok = ro >= 0; const long rr = ok ? ro : 0; const int lj = ok ? li : 0;
    float M = (l_reg > 0.f) ? m_reg : -__builtin_inff();
    float L[3] = {-__builtin_inff(), -__builtin_inff(), -__builtin_inff()};
    if constexpr (NMERGE > 0) {
#pragma unroll
        for (int s = 0; s < NMERGE; ++s) if (s < nparts) { L[s] = P.plse[s][lj]; M = fmaxf(M, L[s]); }
    }
    const float f_own = (l_reg > 0.f) ? __builtin_amdgcn_exp2f(m_reg - M) : 0.f;
    float tot = l_reg * f_own; float fs[3] = {0.f, 0.f, 0.f};
    if constexpr (NMERGE > 0) {
#pragma unroll
        for (int s = 0; s < NMERGE; ++s) if (s < nparts) { fs[s] = (L[s] > -__builtin_inff()) ? __builtin_amdgcn_exp2f(L[s] - M) : 0.f; tot += fs[s]; }
    }
    const float inv = tot > 0.f ? 1.f / tot : 0.f, sc = f_own * inv;
    if (lseb != nullptr && ok && hi == 0) lseb[li] = (l_reg > 0.f) ? (m_reg + __builtin_log2f(l_reg)) : -__builtin_inff();
    if constexpr (NMERGE > 0) {
#pragma unroll
        for (int s = 0; s < NMERGE; ++s) fs[s] = (s < nparts) ? fs[s] * inv * P.psc[s][lj] : 0.f;
#pragma unroll
        for (int d0 = 0; d0 < 4; ++d0) {
#pragma unroll
            for (int r = 0; r < 16; ++r) o[d0][r] *= sc;
#pragma unroll
            for (int s = 0; s < NMERGE; ++s) if (s < nparts) { const float f = fs[s];
#pragma unroll
                for (int p = 0; p < 2; ++p) { const u32x2 w = *(const u32x2*)((const unsigned char*)P.pbase[s] + rr + 32 * d0 + 16 * p + 8 * hi);
                    auto q2 = __builtin_amdgcn_permlane32_swap(w.x, w.y, false, false);
#pragma unroll
                    for (int e = 0; e < 4; ++e) { o[d0][8 * p + e] += f * (float)(int)(signed char)((q2[0] >> (8 * e)) & 255u); o[d0][8 * p + 4 + e] += f * (float)(int)(signed char)((q2[1] >> (8 * e)) & 255u); } } }
#pragma unroll
            for (int p = 0; p < 2; ++p) {
                const unsigned ax = cvt_pk_bf16(o[d0][8 * p + 0], o[d0][8 * p + 1]), ay = cvt_pk_bf16(o[d0][8 * p + 2], o[d0][8 * p + 3]);
                const unsigned bx_ = cvt_pk_bf16(o[d0][8 * p + 4], o[d0][8 * p + 5]), by = cvt_pk_bf16(o[d0][8 * p + 6], o[d0][8 * p + 7]);
                auto r0 = __builtin_amdgcn_permlane32_swap(ax, bx_, false, false); auto r1 = __builtin_amdgcn_permlane32_swap(ay, by, false, false);
                const u32x4 w = {r0[0], r1[0], r0[1], r1[1]};
                if (ok) *(u32x4*)(dstb + rr + 32 * d0 + 16 * p + 8 * hi) = w;
            }
        }
    } else {
        float mx = 0.f;
#pragma unroll
        for (int d0 = 0; d0 < 4; ++d0)
#pragma unroll
            for (int r = 0; r < 16; ++r) { o[d0][r] *= sc; mx = fmaxf(mx, fabsf(o[d0][r])); }
        { auto rx = __builtin_amdgcn_permlane32_swap(__float_as_uint(mx), __float_as_uint(mx), false, false); mx = fmaxf(__uint_as_float(rx[0]), __uint_as_float(rx[1])); }
        const float qs = mx > 0.f ? 127.f / mx : 0.f;
        if (ok && hi == 0) scb[li] = mx * (1.f / 127.f);
#pragma unroll
        for (int d0 = 0; d0 < 4; ++d0)
#pragma unroll
            for (int p = 0; p < 2; ++p) {
                const unsigned a = pk_i8x4(o[d0][8 * p + 0] * qs, o[d0][8 * p + 1] * qs, o[d0][8 * p + 2] * qs, o[d0][8 * p + 3] * qs);
                const unsigned b = pk_i8x4(o[d0][8 * p + 4] * qs, o[d0][8 * p + 5] * qs, o[d0][8 * p + 6] * qs, o[d0][8 * p + 7] * qs);
                auto q2 = __builtin_amdgcn_permlane32_swap(a, b, false, false);
                const u32x2 w = {q2[0], q2[1]};
                if (ok) *(u32x2*)((unsigned char*)dstb + rr + 32 * d0 + 16 * p + 8 * hi) = w;
            }
    }
}
struct UD { const bf16* Q; const bf16* K; const bf16* V; int qoff, qpos, kp0, kst, t_lo, t_hi, w_lo, w_hi, W; float sl2; int ro, li, nparts; };
struct ND { const bf16* Q; const bf16* K; const bf16* V; int qoff, kp0, kst, t_lo; };
struct PF { bf16x8 qr[8]; bf16x8 k0, k1, v0, v1; };
__device__ __forceinline__ void attn_prefetch(const ND& d, PF& pf) {
    const int hi = lane_fresh() >> 5;
#pragma unroll
    for (int d0 = 0; d0 < 8; ++d0) pf.qr[d0] = *(const bf16x8*)(d.Q + d.qoff + d0 * 16 + hi * 8);
}
__device__ __forceinline__ void attn_prime(LAS char* lds, const ND& d, PF& pf) {
    const int tid = __builtin_amdgcn_readfirstlane((int)threadIdx.x >> 6) * 64 + lane_fresh(), sr = tid >> 4, sc = (tid & 15) * 8;
    const int p0_ = (d.kp0 + (64 * d.t_lo + sr) * d.kst) * WQ + sc, p1_ = p0_ + 32 * d.kst * WQ, p2_ = p0_ + 64 * d.kst * WQ, p3_ = p0_ + 96 * d.kst * WQ;
    const bf16x8 k0 = *(const bf16x8*)(d.K + p0_), k1 = *(const bf16x8*)(d.K + p1_), v0 = *(const bf16x8*)(d.V + p0_), v1 = *(const bf16x8*)(d.V + p1_);

    pf.k0 = *(const bf16x8*)(d.K + p2_); pf.k1 = *(const bf16x8*)(d.K + p3_); pf.v0 = *(const bf16x8*)(d.V + p2_); pf.v1 = *(const bf16x8*)(d.V + p3_);
    __syncthreads();
    *(LAS bf16x8*)(lds + L_K + KSWZ(sr, sc * 2)) = k0; *(LAS bf16x8*)(lds + L_K + KSWZ(sr, sc * 2) + 32 * 256) = k1;
    *(LAS bf16x8*)(lds + L_V + v_st(sr, sc)) = v0; *(LAS bf16x8*)(lds + L_V + v_st(32 + sr, sc)) = v1;
    __syncthreads();
}
template <int NMERGE, int MASKMODE>
__device__ __forceinline__ void attn_unit(LAS char* lds, const UD& d, bf16* dstb, float* lseb, float* scb, const Parts& P, PF& pf, bool has_next, const ND& nd) {
    const int lane = lane_fresh(), wid = __builtin_amdgcn_readfirstlane((int)threadIdx.x >> 6), tid = wid * 64 + lane, r32 = lane & 31, hi = lane >> 5;
    LAS char* V_lds = lds + L_V; LAS char* K_lds = lds + L_K;
    LAS float* tab = (LAS float*)(lds + L_TAB + wid * 1024);
    LAS float* al_l = tab; LAS float* li_l = tab + 32; LAS float* fac = tab + 96;
    const bf16* Kh = d.K; const bf16* Vh = d.V;
    const int kp0 = d.kp0, kst = d.kst, t_lo = d.t_lo, t_hi = d.t_hi, w_lo = d.w_lo, w_hi = d.w_hi, W = d.W, qpos = d.qpos, li = d.li, nparts = d.nparts;
    const float sl2 = d.sl2; const long ro = (long)d.ro;
    bf16x8 (&qr)[8] = pf.qr;
    float m_reg = -1e30f, l_reg = 0.f; f32x16 o[4] = {};
    const float qposf = (float)qpos, kstf = (float)kst;
    const float bk = sl2 * kstf, bkc = bk * (1.f / SM_C2), Wf = (float)W;
    const int qlo = __builtin_amdgcn_readfirstlane(qpos), qhi = qlo + 31 * kst;
    const int sr = tid >> 4, sc = (tid & 15) * 8, vst0 = v_st(sr, sc), vst1 = v_st(32 + sr, sc), kws = KSWZ(sr, sc * 2);
    const int vb0 = (int)(uintptr_t)V_lds + v_rd_base(lane);
    bf16x8 s0_k0, s0_k1, s0_v0, s0_v1;
    bf16x8 &s1_k0 = pf.k0, &s1_k1 = pf.k1, &s1_v0 = pf.v0, &s1_v1 = pf.v1;
#define A_LOAD2(SET, tt) do { const bool own_ = (tt) < t_hi; const bf16* Kp_ = own_ ? Kh : nd.K; const bf16* Vp_ = own_ ? Vh : nd.V; \
        const int kp_ = own_ ? kp0 : nd.kp0, ks_ = own_ ? kst : nd.kst, ti_ = own_ ? (tt) : (tt) - t_hi + nd.t_lo; \
        const int p0_ = (kp_ + (64 * ti_ + sr) * ks_) * WQ + sc, p1_ = p0_ + 32 * ks_ * WQ; \
        s##SET##_k0 = *(const bf16x8*)(Kp_ + p0_); s##SET##_k1 = *(const bf16x8*)(Kp_ + p1_); s##SET##_v0 = *(const bf16x8*)(Vp_ + p0_); s##SET##_v1 = *(const bf16x8*)(Vp_ + p1_); } while (0)
#define A_WRITE2(SET) do { *(LAS bf16x8*)(K_lds + (SET) * SHM_K + kws) = s##SET##_k0; *(LAS bf16x8*)(K_lds + (SET) * SHM_K + kws + 32 * 256) = s##SET##_k1; \
        *(LAS bf16x8*)(V_lds + (SET) * SHM_V + vst0) = s##SET##_v0; *(LAS bf16x8*)(V_lds + (SET) * SHM_V + vst1) = s##SET##_v1; } while (0)
#define A_STEP(KB, t) do { \
        if (KB == 0) A_LOAD2(0, (t) + 2); else A_LOAD2(1, (t) + 2);     \
        if ((t) >= w_lo && (t) <= w_hi) { \
            float bk_ = bk, bkc_ = bkc, kst_ = kstf; asm volatile("" : "+v"(bk_), "+v"(bkc_), "+v"(kst_));     \
            f32x16 p0, p1; SBAR(); qkt<KB>(p0, p1, K_lds, r32, hi, qr, bkc_); \
              \
            const float d0f = qposf - (float)(kp0 + (64 * (t) + 4 * hi) * kst); const float t0 = -sl2 * d0f, t1 = fmaf(32.f, bk_, t0); \
            bool needm = false; \
            if (MASKMODE != 0) { const int kfirst = kp0 + 64 * (t) * kst, klast = kfirst + 63 * kst; needm = !((qlo - klast >= 0) && (MASKMODE == 1 || qhi - kfirst <= W)); } \
            float pmax = -__builtin_inff(); \
            if (needm) { \
                _Pragma("unroll") for (int r = 0; r < 16; ++r) { const float c_ = (float)((r & 3) + 8 * (r >> 2)); \
                    const float a0 = fmaf(-c_, kst_, d0f), a1 = a0 - 32.f * kst_;        \
                    float z0 = fmaf(p0[r], SM_C2, t0), z1 = fmaf(p1[r], SM_C2, t1); \
                    const bool v0_ = (MASKMODE == 1) ? (a0 >= 0.f) : (__builtin_amdgcn_fmed3f(a0, 0.f, Wf) == a0), v1_ = (MASKMODE == 1) ? (a1 >= 0.f) : (__builtin_amdgcn_fmed3f(a1, 0.f, Wf) == a1); \
                    z0 = v0_ ? z0 : -__builtin_inff(); z1 = v1_ ? z1 : -__builtin_inff(); \
                    p0[r] = z0; p1[r] = z1; pmax = fmaxf(pmax, fmaxf(z0, z1)); } \
            } else { \
                _Pragma("unroll") for (int r = 0; r < 16; ++r) { const float z0 = fmaf(p0[r], SM_C2, t0), z1 = fmaf(p1[r], SM_C2, t1); p0[r] = z0; p1[r] = z1; pmax = fmaxf(pmax, fmaxf(z0, z1)); } \
            } \
            { auto rr = __builtin_amdgcn_permlane32_swap(__float_as_uint(pmax), __float_as_uint(pmax), false, false); pmax = fmaxf(__uint_as_float(rr[0]), __uint_as_float(rr[1])); } \
            float mn, alpha; \
            if (__all(pmax - m_reg <= 11.5f)) { mn = m_reg; alpha = 1.f; } \
            else { mn = fmaxf(m_reg, pmax); alpha = __builtin_amdgcn_exp2f(m_reg - mn); m_reg = mn; } \
            float ps = 0.f; \
            _Pragma("unroll") for (int r = 0; r < 16; ++r) { p0[r] = __builtin_amdgcn_exp2f(p0[r] - mn); p1[r] = __builtin_amdgcn_exp2f(p1[r] - mn); ps += p0[r] + p1[r]; } \
            { auto rr = __builtin_amdgcn_permlane32_swap(__float_as_uint(ps), __float_as_uint(ps), false, false); ps = __uint_as_float(rr[0]) + __uint_as_float(rr[1]); } \
            l_reg = l_reg * alpha + ps; \
            bf16x8 pa0, pa1, pa2, pa3; \
            A_PK4(p0, 0, pa0); A_PK4(p0, 8, pa1); A_PK4(p1, 0, pa2); A_PK4(p1, 8, pa3); \
            if (__any(alpha < 1.f)) { _Pragma("unroll") for (int d_ = 0; d_ < 4; ++d_) _Pragma("unroll") for (int r = 0; r < 16; ++r) o[d_][r] *= alpha; }     \
            SBAR(); pv_tile<KB>(o, vb0, pa0, pa1, pa2, pa3); \
        } \
        if (KB == 0) A_WRITE2(1); else A_WRITE2(0); \
        __syncthreads(); } while (0)
#define A_PK4(Pv, B_, OUT) do { unsigned a0 = cvt_pk_bf16(Pv[B_ + 0], Pv[B_ + 1]), a1 = cvt_pk_bf16(Pv[B_ + 2], Pv[B_ + 3]); \
        unsigned b0 = cvt_pk_bf16(Pv[B_ + 4], Pv[B_ + 5]), b1 = cvt_pk_bf16(Pv[B_ + 6], Pv[B_ + 7]); \
        auto r0 = __builtin_amdgcn_permlane32_swap(a0, b0, false, false); auto r1 = __builtin_amdgcn_permlane32_swap(a1, b1, false, false); \
        u32x4 w_ = {r0[0], r1[0], r0[1], r1[1]}; OUT = __builtin_bit_cast(bf16x8, w_); } while (0)
    for (int t = t_lo; t < t_hi; t += 2) {
        A_STEP(0, t);
        if (t + 1 < t_hi) A_STEP(1, t + 1);
    }
#undef A_STEP
#undef A_PK4
#undef A_LOAD2
#undef A_WRITE2
    if (has_next) attn_prefetch(nd, pf);
    row_epilogue<NMERGE>(o, m_reg, l_reg, hi, dstb, ro, lseb, scb, li, nparts, P);
}

__device__ __forceinline__ void attn_sel_chunks(LAS char* lds, int c0, int c1, const LAS int* pfx, const unsigned* cnts  , const unsigned* buck,
                                                const bf16* QM, const bf16* KM, const bf16* VM, bf16* PM, float* LM, float* SM) {
    const int lane = lane_fresh(), wid = __builtin_amdgcn_readfirstlane((int)threadIdx.x >> 6), tid = wid * 64 + lane, r32 = lane & 31, hi = lane >> 5;
    LAS char* V_lds = lds; LAS char* K_lds = lds + 65536;
    LAS float* tab = (LAS float*)(lds + L_TAB + wid * 1024);
    LAS float* al_l = tab; LAS float* fc_l = tab + 32; LAS int* ro_l = (LAS int*)(tab + 64);
    const int sr = tid >> 4, sc = (tid & 15) * 8, vst0 = v_st(sr, sc), vst1 = v_st(32 + sr, sc), kws = KSWZ(sr, sc * 2);
    const int vb0 = (int)(uintptr_t)V_lds + v_rd_base(lane);
    if (c0 >= c1) return;
    int bk = 0; { int klo = 0, khi = 1024; while (khi - klo > 1) { const int mid = (klo + khi) >> 1; if (pfx[mid] <= c0) klo = mid; else khi = mid; } bk = klo; }
    int cur_bk = -1;
#define S_QUERY(ch_, BK, E, QP, VALID, QF) do { int bk_ = (BK); while (pfx[bk_ + 1] <= (ch_)) ++bk_; (BK) = bk_; \
        const int chunk_ = (ch_) - pfx[bk_], bh_ = bk_ >> 5, j_ = bk_ & 31; \
        const int cnt_ = (int)__hip_atomic_load(cnts + 64 * bk_, RLX_AGENT); const int idx_ = chunk_ * 256 + wid * 32 + r32; \
        VALID = idx_ < cnt_; E = 0; if (VALID) E = buck[(size_t)bh_ * BUCK_PER_BH + buck_off(j_) + idx_]; \
        QP = VALID ? (int)(E & 0xffffu) : (j_ + 1) * 256; \
        const bf16* qrow_ = QM + ((bh_ >> 3) * SEQ) * WQ + (bh_ & 7) * HD + QP * WQ; \
        _Pragma("unroll") for (int d0 = 0; d0 < 8; ++d0) QF[d0] = *(const bf16x8*)(qrow_ + d0 * 16 + hi * 8); } while (0)
    bf16x8 qr[8], qn[8]; unsigned e = 0, en = 0; int qpos = 0, qposn = 0, bkn = bk; bool valid = false, validn = false;
    S_QUERY(c0, bkn, en, qposn, validn, qn);
#pragma unroll 1
    for (int ch = c0; ch < c1; ++ch) {
        while (pfx[bk + 1] <= ch) ++bk;
        const int bh = bk >> 5, j = bk & 31, b = bh >> 3, h = bh & 7;
        const int hb = (b * SEQ) * WQ + h * HD;
        e = en; qpos = qposn; valid = validn;
#pragma unroll
        for (int d0 = 0; d0 < 8; ++d0) qr[d0] = qn[d0];
        if (ch + 1 < c1) S_QUERY(ch + 1, bkn, en, qposn, validn, qn);
        if (bk != cur_bk) {
            cur_bk = bk;
            __syncthreads();
#pragma unroll
            for (int half = 0; half < 2; ++half) {
                bf16x8 k0[2], k1[2], v0[2], v1[2];
#pragma unroll
                for (int tt = 0; tt < 2; ++tt) { const int p0_ = hb + (j * 256 + 64 * (2 * half + tt) + sr) * WQ + sc, p1_ = p0_ + 32 * WQ;
                    k0[tt] = *(const bf16x8*)(KM + p0_); k1[tt] = *(const bf16x8*)(KM + p1_); v0[tt] = *(const bf16x8*)(VM + p0_); v1[tt] = *(const bf16x8*)(VM + p1_); }
#pragma unroll
                for (int tt = 0; tt < 2; ++tt) { const int T = 2 * half + tt;
                    *(LAS bf16x8*)(K_lds + T * SHM_K + kws) = k0[tt]; *(LAS bf16x8*)(K_lds + T * SHM_K + kws + 32 * 256) = k1[tt];
                    *(LAS bf16x8*)(V_lds + T * SHM_V + vst0) = v0[tt]; *(LAS bf16x8*)(V_lds + T * SHM_V + vst1) = v1[tt]; }
            }
            __syncthreads();
        }
        if (!__any(valid)) continue;
        const int slot = (int)(e >> 16);
        const float sl2 = __builtin_amdgcn_exp2f(-0.5f * (float)(2 * h + 1)) * LOG2E;
        const float bkc = sl2 * (1.f / SM_C2), qposf = (float)qpos;
        float m_reg = -1e30f, l_reg = 0.f; f32x16 o[4] = {};
#define S_TILE(KB) do { \
            float bkc_ = bkc; asm volatile("" : "+v"(bkc_)); \
            f32x16 p0, p1; SBAR(); qkt<KB>(p0, p1, K_lds, r32, hi, qr, bkc_); \
            const float t0 = -sl2 * (qposf - (float)(j * 256 + 64 * (KB) + 4 * hi)), t1 = fmaf(32.f, sl2, t0); \
            float pmax = -__builtin_inff(); \
            _Pragma("unroll") for (int r = 0; r < 16; ++r) { const float z0 = fmaf(p0[r], SM_C2, t0), z1 = fmaf(p1[r], SM_C2, t1); p0[r] = z0; p1[r] = z1; pmax = fmaxf(pmax, fmaxf(z0, z1)); } \
            { auto rr = __builtin_amdgcn_permlane32_swap(__float_as_uint(pmax), __float_as_uint(pmax), false, false); pmax = fmaxf(__uint_as_float(rr[0]), __uint_as_float(rr[1])); } \
              \
            const bool upd_ = (pmax - m_reg > 11.5f); \
            float mn = m_reg, alpha = 1.f; \
            if (__any(upd_)) { const float mx_ = fmaxf(m_reg, pmax); if (upd_) { alpha = __builtin_amdgcn_exp2f(m_reg - mx_); mn = mx_; m_reg = mx_; } } \
            float ps = 0.f; \
            _Pragma("unroll") for (int r = 0; r < 16; ++r) { p0[r] = __builtin_amdgcn_exp2f(p0[r] - mn); p1[r] = __builtin_amdgcn_exp2f(p1[r] - mn); ps += p0[r] + p1[r]; } \
            { auto rr = __builtin_amdgcn_permlane32_swap(__float_as_uint(ps), __float_as_uint(ps), false, false); ps = __uint_as_float(rr[0]) + __uint_as_float(rr[1]); } \
            l_reg = l_reg * alpha + ps; \
            bf16x8 pa0, pa1, pa2, pa3; \
            S_PK4(p0, 0, pa0); S_PK4(p0, 8, pa1); S_PK4(p1, 0, pa2); S_PK4(p1, 8, pa3); \
            if (__any(alpha < 1.f)) { _Pragma("unroll") for (int d_ = 0; d_ < 4; ++d_) _Pragma("unroll") for (int r = 0; r < 16; ++r) o[d_][r] *= alpha; } \
            SBAR(); pv_tile<KB>(o, vb0, pa0, pa1, pa2, pa3); } while (0)
#define S_PK4(Pv, B_, OUT) do { unsigned a0 = cvt_pk_bf16(Pv[B_ + 0], Pv[B_ + 1]), a1 = cvt_pk_bf16(Pv[B_ + 2], Pv[B_ + 3]); \
        unsigned b0 = cvt_pk_bf16(Pv[B_ + 4], Pv[B_ + 5]), b1 = cvt_pk_bf16(Pv[B_ + 6], Pv[B_ + 7]); \
        auto r0 = __builtin_amdgcn_permlane32_swap(a0, b0, false, false); auto r1 = __builtin_amdgcn_permlane32_swap(a1, b1, false, false); \
        u32x4 w_ = {r0[0], r1[0], r0[1], r1[1]}; OUT = __builtin_bit_cast(bf16x8, w_); } while (0)
        S_TILE(0); S_TILE(1); S_TILE(2); S_TILE(3);
#undef S_TILE
#undef S_PK4
        { const Parts nop{};
          row_epilogue<0>(o, m_reg, l_reg, hi, PM, valid ? (long)(slot * (NTOK * WQ) + hb + qpos * WQ) : -1L, LM, SM, slot * (NTOK * 8) + (b * SEQ + qpos) * 8 + h, 0, nop); }
    }
#undef S_QUERY
}
#undef SBAR
}

struct Args { const float* in[16]; float* out; unsigned char* ws; int ph_lo, ph_hi, dry, pad; };

__device__ __forceinline__ void transpose_item(const float* W, int N, int k0, int n0, bf16* WT, int ldk, long orow0, LAS float* scr, int lane) {
#pragma unroll
    for (int i = 0; i < 32; ++i) { const int kk = 2 * i + (lane >> 5); scr[kk * 33 + (lane & 31)] = W[(size_t)(k0 + kk) * N + n0 + (lane & 31)]; }
    LDS_WAIT(); asm volatile("" ::: "memory");
    const int c = lane & 7;
#pragma unroll
    for (int j = 0; j < 4; ++j) { const int n = (lane >> 3) + 8 * j; const LAS float* s = scr + (8 * c) * 33 + n;
        u32x4 o; o.x = cvt_pk_bf16(s[0 * 33], s[1 * 33]); o.y = cvt_pk_bf16(s[2 * 33], s[3 * 33]); o.z = cvt_pk_bf16(s[4 * 33], s[5 * 33]); o.w = cvt_pk_bf16(s[6 * 33], s[7 * 33]);
        *(u32x4*)(WT + (size_t)(orow0 + n) * ldk + k0 + 8 * c) = o; }
    LDS_WAIT(); asm volatile("" ::: "memory");
}

__device__ __forceinline__ void transpose_item_i8(const float* W, int N, int k0, int n0, unsigned char* WT, int ldk, long orow0, float cscale, LAS float* scr, int lane) {
#pragma unroll 8
    for (int i = 0; i < 32; ++i) { const int kk = 2 * i + (lane >> 5); scr[kk * 33 + (lane & 31)] = W[(size_t)(k0 + kk) * N + n0 + (lane & 31)] * cscale; }
    LDS_WAIT(); asm volatile("" ::: "memory");
    const int c = lane & 7;
#pragma unroll
    for (int j = 0; j < 4; ++j) { const int n = (lane >> 3) + 8 * j; const LAS float* s = scr + (8 * c) * 33 + n;
        u32x2 o; o.x = pk_i8x4(s[0 * 33], s[1 * 33], s[2 * 33], s[3 * 33]); o.y = pk_i8x4(s[4 * 33], s[5 * 33], s[6 * 33], s[7 * 33]);
        *(u32x2*)(WT + (size_t)(orow0 + n) * ldk + k0 + 8 * c) = o; }
    LDS_WAIT(); asm volatile("" ::: "memory");
}
__device__ __forceinline__ void transpose_regs_i8(const float (&v)[32], int k0, unsigned char* WT, int ldk, long orow0, float cscale, LAS float* scr, int lane) {
#pragma unroll
    for (int i = 0; i < 32; ++i) scr[(2 * i + (lane >> 5)) * 33 + (lane & 31)] = v[i] * cscale;
    LDS_WAIT(); asm volatile("" ::: "memory");
    const int c = lane & 7;
#pragma unroll
    for (int j = 0; j < 4; ++j) { const int n = (lane >> 3) + 8 * j; const LAS float* s = scr + (8 * c) * 33 + n;
        u32x2 o; o.x = pk_i8x4(s[0 * 33], s[1 * 33], s[2 * 33], s[3 * 33]); o.y = pk_i8x4(s[4 * 33], s[5 * 33], s[6 * 33], s[7 * 33]);
        *(u32x2*)(WT + (size_t)(orow0 + n) * ldk + k0 + 8 * c) = o; }
    LDS_WAIT(); asm volatile("" ::: "memory");
}
__device__ __forceinline__ void transpose_item_fp8(const float* W, int N, int k0, int n0, unsigned char* WT, int ldk, long orow0, float scale, LAS float* scr, int lane) {
#pragma unroll
    for (int i = 0; i < 32; ++i) { const int kk = 2 * i + (lane >> 5); scr[kk * 33 + (lane & 31)] = W[(size_t)(k0 + kk) * N + n0 + (lane & 31)] * scale; }
    LDS_WAIT(); asm volatile("" ::: "memory");
    const int c = lane & 7;
#pragma unroll
    for (int j = 0; j < 4; ++j) { const int n = (lane >> 3) + 8 * j; const LAS float* s = scr + (8 * c) * 33 + n;
        u32x2 o; o.x = pk_fp8x4(s[0 * 33], s[1 * 33], s[2 * 33], s[3 * 33]); o.y = pk_fp8x4(s[4 * 33], s[5 * 33], s[6 * 33], s[7 * 33]);
        *(u32x2*)(WT + (size_t)(orow0 + n) * ldk + k0 + 8 * c) = o; }
    LDS_WAIT(); asm volatile("" ::: "memory");
}

__global__ void __launch_bounds__(NWAVES * 64, 2) mk_fwd(Args args) {
    extern __shared__ __attribute__((aligned(16))) unsigned char lds_raw[];
    LAS unsigned char* lds = (LAS unsigned char*)lds_raw;
    volatile LAS unsigned* MISC = (volatile LAS unsigned*)(lds + MISC_OFF);
    const int wave = __builtin_amdgcn_readfirstlane((int)threadIdx.x >> 6);
#define PHASE_IDS const int lane = lane_fresh(), tid = wave * 64 + lane; (void)tid; (void)lane
    PHASE_IDS;
    const int G = gridDim.x, bx = blockIdx.x;
    const int vcu = (G % 8 == 0) ? (bx % 8) * (G / 8) + bx / 8 : bx;
    unsigned char* ws = args.ws;
    gu32* ctl = (gu32*)(ws + WS_CTL);
    for (int u = tid; u < (LDS_BYTES - RING_BYTES) / 4; u += NWAVES * 64) ((LAS unsigned*)(lds + RING_BYTES))[u] = 0u;
    __syncthreads();
    XcdBarrier bar; bar.bar = (unsigned*)ctl + CW_BAR; bar.x = 0; bar.st = nullptr;
    if (MK_N_LAUNCHES == 1 && !MK_DEBUG) bar = xcd_barrier_post((unsigned*)ctl + CW_BAR, MISC + 8);
    const int lo = args.ph_lo, hi_ph = args.ph_hi;
#define IN(k) (lo <= (k) && (k) < hi_ph)
#define SEAM(k) do { if (IN(k) && IN((k) + 1)) xcd_barrier(bar); } while (0)
    const int gw = vcu * NWAVES + wave, NGW = G * NWAVES;

    const float* x = args.in[0];
    bf16* Hb = (bf16*)(ws + WS_H);
    bf16* QM = (bf16*)(ws + WS_QM); bf16* KM = (bf16*)(ws + WS_KM); bf16* VM = (bf16*)(ws + WS_VM);
    bf16* QD = (bf16*)(ws + WS_QD); bf16* KD = (bf16*)(ws + WS_KD); bf16* VD = (bf16*)(ws + WS_VD);
    bf16* PM = (bf16*)(ws + WS_PM); bf16* PD = (bf16*)(ws + WS_PD);
    float* LM = (float*)(ws + WS_LM); float* LD = (float*)(ws + WS_LD); float* SM = (float*)(ws + WS_SM); float* SD = (float*)(ws + WS_SD);
    float* kmean = (float*)(ws + WS_KMEAN);
    unsigned* buck = (unsigned*)(ws + WS_BUCK);
    bf16* GATES = (bf16*)(ws + WS_GATES); bf16* MIX = (bf16*)(ws + WS_MIX); bf16* GINV = (bf16*)(ws + WS_GINV);
    bf16* X1H = (bf16*)(ws + WS_X1); bf16* X1L = X1H + (size_t)NTOK * DM;
    int* EID = (int*)(ws + WS_EID); float* EW = (float*)(ws + WS_EW); float* RMS = (float*)(ws + WS_RMS); int* POS = (int*)(ws + WS_POS);
    int* ROWTOK = (int*)(ws + WS_ROWTOK); float* ROWW = (float*)(ws + WS_ROWW);
    bf16* WR = (bf16*)(ws + WS_WR);

    if (IN(0)) {
        PHASE_IDS;
        LAS float* scr = (LAS float*)(lds + wave * 16384);
        constexpr int I_IN = 32 * 320, I_OM = 16 * 64, I_O = 32 * 64;
        constexpr int NIT = I_IN + 2 * I_OM; (void)I_O;
        for (int it = gw; it < NIT; it += NGW) {
            int r = it;
            if (r < I_IN) { const int kb = r / 320, nb = r % 320;
                if (32 * nb < NBF) transpose_item(args.in[2], 10240, 64 * kb, 32 * nb, (bf16*)(ws + WS_WIN), 2048, 32 * nb, scr, lane);
                continue; } r -= I_IN;
            if (r < I_OM) { const int kb = r / 64, nb = r % 64; transpose_item(args.in[4], 2048, 64 * kb, 32 * nb, (bf16*)(ws + WS_WOM), 2048, 32 * nb, scr, lane); continue; } r -= I_OM;
            if (r < I_OM) { const int kb = r / 64, nb = r % 64; transpose_item(args.in[5], 2048, 64 * kb, 32 * nb, (bf16*)(ws + WS_WOM) + 1024, 2048, 32 * nb, scr, lane); continue; } r -= I_OM;
            (void)r;
        }
        {
            LAS float* cmax = (LAS float*)(lds + 136 * 1024);
            float* colsc = (float*)(ws + WS_CS8);
            constexpr int NG_IN = (10240 - NBF) / 32, NG_WO = 2048 / 32;
            for (int grp = vcu; grp < NG_IN + NG_WO; grp += G) {
                const bool is_wo = grp >= NG_IN;
                const int lane = lane_fresh();
                const float* Wsrc = is_wo ? args.in[6] : args.in[2]; const int Nsrc = is_wo ? 2048 : 10240;
                const int n0 = is_wo ? 32 * (grp - NG_IN) : NBF + 32 * grp;
                float mx = 0.f;
                float vv[4][32];
#pragma unroll
                for (int q4 = 0; q4 < 4; ++q4) { const int kb = wave * 4 + q4;
#pragma unroll
                    for (int i = 0; i < 32; ++i) vv[q4][i] = Wsrc[(size_t)(64 * kb + 2 * i + (lane >> 5)) * Nsrc + n0 + (lane & 31)]; }
#pragma unroll
                for (int q4 = 0; q4 < 4; ++q4)
#pragma unroll
                    for (int i = 0; i < 32; ++i) mx = fmaxf(mx, fabsf(vv[q4][i]));
                mx = fmaxf(mx, __shfl_xor(mx, 32));
                __syncthreads();
                if (lane < 32) cmax[wave * 32 + lane] = mx;
                __syncthreads();
                float cm = 0.f;
#pragma unroll
                for (int w8 = 0; w8 < 8; ++w8) cm = fmaxf(cm, cmax[w8 * 32 + (lane & 31)]);
                int drow = is_wo ? n0 : n0 - NBF;
                if (!is_wo && n0 >= NQKV) { const int c = n0 - NQKV, which = c >> 11, cc = c & 2047; drow = (NQKV - NBF) + (cc >> 7) * 256 + which * 128 + (cc & 127); }
                if (wave == 0 && lane < 32) (is_wo ? (float*)(ws + WS_CSWO) : colsc)[drow + lane] = cm * (1.f / 127.f);
                const float cscale = cm > 0.f ? 127.f / cm : 0.f;
#pragma unroll
                for (int q4 = 0; q4 < 4; ++q4) transpose_regs_i8(vv[q4], 64 * (wave * 4 + q4), is_wo ? ws + WS_WO : ws + WS_WIN8, 2048, drow, cscale, scr, lane);
            }
        }
        for (int i = (bx * NWAVES * 64 + tid); i < 64 * 2048; i += G * NWAVES * 64) {
            const int row = i >> 11, k = i & 2047;
            float w = 0.f;
            if (row < 32) w = args.in[10][(size_t)k * 32 + row]; else if (row < 36) w = args.in[8][(size_t)k * 4 + (row - 32)];
            const unsigned h = cvt_pk_bf16(w, 0.f) & 0xffffu; const float lo_f = w - bf_lo(h);
            WR[i] = (bf16)h; WR[64 * 2048 + i] = (bf16)(cvt_pk_bf16(lo_f, 0.f) & 0xffffu);
        }
        const float* g1 = args.in[1];
        f32x4 g1v[8];
#pragma unroll
        for (int j = 0; j < 4; ++j) { g1v[2 * j] = *(const f32x4*)(g1 + j * 512 + lane * 8); g1v[2 * j + 1] = *(const f32x4*)(g1 + j * 512 + lane * 8 + 4); }
        for (int m = gw; m < NTOK; m += NGW) {
            const float* xr = x + (size_t)m * DM;
            f32x4 v[8]; float s = 0.f;
#pragma unroll
            for (int j = 0; j < 4; ++j) { v[2 * j] = *(const f32x4*)(xr + j * 512 + lane * 8); v[2 * j + 1] = *(const f32x4*)(xr + j * 512 + lane * 8 + 4); }
#pragma unroll
            for (int j = 0; j < 8; ++j) s += (v[j].x * v[j].x + v[j].y * v[j].y) + (v[j].z * v[j].z + v[j].w * v[j].w);
            const float rs = 1.0f / sqrtf(wave_sum(s) * (1.f / DM) + RMS_EPS);
            float amax = 0.f;
#pragma unroll
            for (int j = 0; j < 4; ++j) { const f32x4 ga = g1v[2 * j], gb = g1v[2 * j + 1];
                v[2 * j] = v[2 * j] * rs * ga; v[2 * j + 1] = v[2 * j + 1] * rs * gb;
                if (NBF > 0) *(u32x4*)(Hb + (size_t)m * DM + j * 512 + lane * 8) = pg8::pack8(v[2 * j], v[2 * j + 1]);
#pragma unroll
                for (int e = 0; e < 4; ++e) amax = fmaxf(amax, fmaxf(fabsf(v[2 * j][e]), fabsf(v[2 * j + 1][e]))); }
#pragma unroll
            for (int o = 1; o < 64; o <<= 1) amax = fmaxf(amax, __shfl_xor(amax, o));
            const float qs = amax > 0.f ? 127.f / amax : 0.f;
            if (lane == 0) ((float*)(ws + WS_RS8))[m] = amax * (1.f / 127.f);
#pragma unroll
            for (int j = 0; j < 4; ++j) { const f32x4 ha = v[2 * j] * qs, hb4 = v[2 * j + 1] * qs;
                u32x2 h8; h8.x = pk_i8x4(ha.x, ha.y, ha.z, ha.w); h8.y = pk_i8x4(hb4.x, hb4.y, hb4.z, hb4.w);
                *(u32x2*)(ws + WS_H8 + (size_t)m * DM + j * 512 + lane * 8) = h8; }
        }
    }
    if (IN(0) && IN(1)) xcd_barrier(bar);

    if (IN(1)) {
        { pg8::Gemm g{Hb, (const bf16*)(ws + WS_WIN), DM, nullptr, DM, Hb, 1 << 30}; pg8::StaticOrder S; S.init(NTOK, NBF, G, bx);
          pg8::EpiQKV E{QM, 0, nullptr, nullptr, nullptr};
          pg8::gemm_phase<pg8::EpiQKV, pg8::StaticOrder, true>(lds, g, S, E); }
        { pg8::Gemm g{(const bf16*)(ws + WS_H8), (const bf16*)(ws + WS_WIN8), DM / 2, nullptr, DM / 2, (const bf16*)(ws + WS_H8), 1 << 30}; pg8::StaticOrder S; S.init(NTOK, NQKV - NBF, G, bx);
          pg8::EpiQKV E{QM, NBF / 256, (const float*)(ws + WS_RS8), (const float*)(ws + WS_CS8), kmean};
          pg8::gemm_phase<pg8::EpiQKV, pg8::StaticOrder, true, false, QIN>(lds, g, S, E); }
    }
    if (IN(1) && IN(3)) xcd_barrier(bar);


    if (IN(3)) {
        PHASE_IDS;
        LAS int* hist = (LAS int*)lds;
        const int r32 = lane & 31, hi = lane >> 5;
        for (int u = bx; u < NB * NH * 32; u += G) {
            const int b = u >> 8, h = (u >> 5) & 7, qb = u & 31;
            if (qb == 0) continue;
            __syncthreads();
            if (tid < 64) hist[tid] = 0;
            __syncthreads();
            const int tq = qb * 256 + wave * 32 + r32;
            const bf16* qrow = QM + (size_t)(b * SEQ + tq) * WQ + h * HD;
            const float* km = kmean + (size_t)((b * NH + h) * 32 + r32) * HD;
            f32x16 acc = {};
#pragma unroll
            for (int s = 0; s < 8; ++s) {
                const bf16x8 qf = *(const bf16x8*)(qrow + s * 16 + hi * 8);
                const f32x4 ka = *(const f32x4*)(km + s * 16 + hi * 8), kb2 = *(const f32x4*)(km + s * 16 + hi * 8 + 4);
                const u32x4 kh = pg8::pack8(ka, kb2);
                f32x4 ha, hb; pg8::unpack8(kh, ha, hb);
                const u32x4 kl = pg8::pack8(ka - ha, kb2 - hb);
                acc = __builtin_amdgcn_mfma_f32_32x32x16_bf16(__builtin_bit_cast(bf16x8, kh), qf, acc, 0, 0, 0);
                acc = __builtin_amdgcn_mfma_f32_32x32x16_bf16(__builtin_bit_cast(bf16x8, kl), qf, acc, 0, 0, 0);
            }
            float t0 = -__builtin_inff(), t1 = t0, t2 = t0; int i0 = 64, i1 = 64, i2 = 64;
#define INS3(v_, j_) do { const float _iv = (v_); const int _ij = (j_); \
                if (_iv > t0 || (_iv == t0 && _ij < i0)) { t2 = t1; i2 = i1; t1 = t0; i1 = i0; t0 = _iv; i0 = _ij; } \
                else if (_iv > t1 || (_iv == t1 && _ij < i1)) { t2 = t1; i2 = i1; t1 = _iv; i1 = _ij; } \
                else if (_iv > t2 || (_iv == t2 && _ij < i2)) { t2 = _iv; i2 = _ij; } } while (0)
#pragma unroll
            for (int r = 0; r < 16; ++r) { const int j = att::crow(r, hi); const float v = (j < qb) ? acc[r] : -__builtin_inff(); INS3(v, j); }
            { const float o0 = __shfl_xor(t0, 32), o1 = __shfl_xor(t1, 32), o2 = __shfl_xor(t2, 32); const int j0 = __shfl_xor(i0, 32), j1 = __shfl_xor(i1, 32), j2 = __shfl_xor(i2, 32);
              INS3(o0, j0); INS3(o1, j1); INS3(o2, j2); }
#undef INS3
            int rk0 = 0, rk1 = 0, rk2 = 0;
            const bool v0 = t0 > -__builtin_inff() && i0 < qb, v1 = t1 > -__builtin_inff() && i1 < qb, v2 = t2 > -__builtin_inff() && i2 < qb;
            if (hi == 0) {
                if (v0) rk0 = __hip_atomic_fetch_add(&hist[i0], 1, __ATOMIC_RELAXED, __HIP_MEMORY_SCOPE_WORKGROUP);
                if (v1) rk1 = __hip_atomic_fetch_add(&hist[i1], 1, __ATOMIC_RELAXED, __HIP_MEMORY_SCOPE_WORKGROUP);
                if (v2) rk2 = __hip_atomic_fetch_add(&hist[i2], 1, __ATOMIC_RELAXED, __HIP_MEMORY_SCOPE_WORKGROUP);
            }
            __syncthreads();
            if (tid < 32 && hist[tid] > 0) hist[32 + tid] = (int)__hip_atomic_fetch_add((unsigned*)ctl + CW_BCNT + 64 * (((b * NH + h) << 5) + tid), (unsigned)hist[tid], RLX_AGENT);
            __syncthreads();
            if (hi == 0) {
                unsigned* bb = buck + (size_t)(b * NH + h) * BUCK_PER_BH;
                if (v0) bb[buck_off(i0) + hist[32 + i0] + rk0] = (unsigned)tq | (0u << 16);
                if (v1) bb[buck_off(i1) + hist[32 + i1] + rk1] = (unsigned)tq | (1u << 16);
                if (v2) bb[buck_off(i2) + hist[32 + i2] + rk2] = (unsigned)tq | (2u << 16);
            }
        }
    }
    SEAM(3);

    if (IN(4)) {
        PHASE_IDS;
        LAS int* pfx = (LAS int*)(lds + att::L_SELPFX);
        __syncthreads();
        for (int k = tid; k < 1024; k += NWAVES * 64) { const unsigned c = __hip_atomic_load((unsigned*)ctl + CW_BCNT + 64 * k, RLX_AGENT); pfx[k + 1] = (int)((c + 255u) >> 8); }
        if (tid == 0) pfx[0] = 0;
        __syncthreads();
        if (tid == 0) { int s = 0; for (int k = 1; k <= 1024; ++k) { s += pfx[k]; pfx[k] = s; } }
        __syncthreads();
        const int nsel = pfx[1024];
        constexpr int NDIL = 2 * 1024;
        const int total = nsel + NDIL;
        att::Parts noparts{};
        const int r32 = lane & 31;
#define DECODE4(u_, D) do { const int uu = (u_); \
            if (uu < NDIL) {     \
                const int p = uu >> 10, v = uu & 1023, bh = v >> 5, w5 = v & 31; \
                const int dd = p ? 4 : 1, res = p ? (w5 >> 3) : 0, l0 = p ? (w5 & 7) * 256 : w5 * 256, b = bh >> 3, h = bh & 7; \
                const int hb = (b * SEQ) * WQ + h * HD; \
                D.Q = QD + hb; D.K = KD + hb; D.V = VD + hb; D.qpos = (l0 + wave * 32 + r32) * dd + res; D.qoff = D.qpos * WQ; \
                D.kp0 = (l0 - 128) * dd + res; D.kst = dd; D.t_lo = l0 == 0 ? 2 : 0; D.t_hi = 6; D.w_lo = wave >> 1; D.w_hi = (wave >> 1) + 2; D.W = 128 * dd; \
                D.sl2 = __builtin_amdgcn_exp2f(-(float)(h + 1)) * LOG2E; \
                D.ro = p * (NTOK * WQ) + hb + D.qpos * WQ; D.li = p * (NTOK * 8) + (b * SEQ + D.qpos) * 8 + h; D.nparts = 0; \
            } else {             \
                const int su = uu - NDIL; int klo = 0, khi = 1024; \
                while (khi - klo > 1) { const int mid = (klo + khi) >> 1; if (pfx[mid] <= su) klo = mid; else khi = mid; } \
                const int bk = klo, chunk = su - pfx[bk], bh = bk >> 5, j = bk & 31, b = bh >> 3, h = bh & 7; \
                const int cnt = (int)__hip_atomic_load((unsigned*)ctl + CW_BCNT + 64 * bk, RLX_AGENT); \
                const int idx = chunk * 256 + wave * 32 + r32; const bool valid = idx < cnt; \
                unsigned e = 0; if (valid) e = buck[(size_t)bh * BUCK_PER_BH + buck_off(j) + idx]; \
                const int slot = (int)(e >> 16), hb = (b * SEQ) * WQ + h * HD; \
                D.Q = QM + hb; D.K = KM + hb; D.V = VM + hb; D.qpos = valid ? (int)(e & 0xffffu) : (j + 1) * 256; D.qoff = D.qpos * WQ; \
                D.kp0 = j * 256; D.kst = 1; D.t_lo = 0; D.t_hi = 4; D.w_lo = 0; D.w_hi = 3; D.W = 1 << 20; \
                D.sl2 = __builtin_amdgcn_exp2f(-0.5f * (float)(2 * h + 1)) * LOG2E; \
                D.ro = valid ? slot * (NTOK * WQ) + hb + D.qpos * WQ : -1; D.li = slot * (NTOK * 8) + (b * SEQ + D.qpos) * 8 + h; D.nparts = 0; \
            } } while (0)
        att::UD cur; att::ND nd; att::PF pf;
#define TO_ND(D, N) do { N.Q = D.Q; N.K = D.K; N.V = D.V; N.qoff = D.qoff; N.kp0 = D.kp0; N.kst = D.kst; N.t_lo = D.t_lo; } while (0)
        if (bx < NDIL) { DECODE4(bx, cur); TO_ND(cur, nd); att::attn_prefetch(nd, pf); att::attn_prime((LAS char*)lds, nd, pf); }
        for (int u = bx; u < NDIL; u += G) {
            const bool has_next = u + G < NDIL;
            { att::UD tmp; DECODE4(has_next ? u + G : u, tmp); TO_ND(tmp, nd); }
            DECODE4(u, cur);
            att::attn_unit<0, 2>((LAS char*)lds, cur, PD, LD, SD, noparts, pf, has_next, nd);
        }
#undef DECODE4
        { const int c0 = (int)(((long)nsel * bx) / G), c1 = (int)(((long)nsel * (bx + 1)) / G);
          att::attn_sel_chunks((LAS char*)lds, c0, c1, pfx, (const unsigned*)ctl + CW_BCNT, buck, QM, KM, VM, PM, LM, SM); }
    }
    SEAM(4);
    if (IN(5)) {
        PHASE_IDS;
        const int r32 = lane & 31;
        att::Parts PMp, PDp;
#pragma unroll
        for (int s3 = 0; s3 < 3; ++s3) { PMp.pbase[s3] = (const bf16*)((const unsigned char*)PM + (size_t)s3 * NTOK * WQ); PMp.plse[s3] = LM + (size_t)s3 * NTOK * 8; PMp.psc[s3] = SM + (size_t)s3 * NTOK * 8;
            PDp.pbase[s3] = (const bf16*)((const unsigned char*)PD + (size_t)(s3 < 2 ? s3 : 0) * NTOK * WQ); PDp.plse[s3] = LD + (size_t)(s3 < 2 ? s3 : 0) * NTOK * 8; PDp.psc[s3] = SD + (size_t)(s3 < 2 ? s3 : 0) * NTOK * 8; }
#define DECODE5(u_, D) do { const int uu = (u_); \
            if (uu < 1024) {     \
                const int bh = uu >> 5, qb = uu & 31, b = bh >> 3, h = bh & 7, hb = (b * SEQ) * WQ + h * HD; \
                D.Q = QM + hb; D.K = KM + hb; D.V = VM + hb; D.qpos = qb * 256 + wave * 32 + r32; D.qoff = D.qpos * WQ; \
                D.kp0 = qb * 256; D.kst = 1; D.t_lo = 0; D.t_hi = 4; D.w_lo = 0; D.w_hi = wave >> 1; D.W = 1 << 20; \
                D.sl2 = __builtin_amdgcn_exp2f(-0.5f * (float)(2 * h + 1)) * LOG2E; \
                D.ro = hb + D.qpos * WQ; D.li = (b * SEQ + D.qpos) * 8 + h; D.nparts = qb < 3 ? qb : 3; \
            } else {             \
                const int v = uu - 1024, bh = v >> 5, w5 = v & 31, res = w5 >> 1, l0 = (w5 & 1) * 256, b = bh >> 3, h = bh & 7, hb = (b * SEQ) * WQ + h * HD; \
                D.Q = QD + hb; D.K = KD + hb; D.V = VD + hb; D.qpos = (l0 + wave * 32 + r32) * 16 + res; D.qoff = D.qpos * WQ; \
                D.kp0 = (l0 - 128) * 16 + res; D.kst = 16; D.t_lo = l0 == 0 ? 2 : 0; D.t_hi = 6; D.w_lo = wave >> 1; D.w_hi = (wave >> 1) + 2; D.W = 128 * 16; \
                D.sl2 = __builtin_amdgcn_exp2f(-(float)(h + 1)) * LOG2E; \
                D.ro = hb + D.qpos * WQ; D.li = (b * SEQ + D.qpos) * 8 + h; D.nparts = 2; \
            } } while (0)
        att::UD cur; att::ND nd; att::PF pf;
        if (bx < 2048) { DECODE5(bx, cur); TO_ND(cur, nd); att::attn_prefetch(nd, pf); att::attn_prime((LAS char*)lds, nd, pf); }
        for (int u = bx; u < 2048; u += G) {
            const bool has_next = u + G < 2048;
            { att::UD tmp; DECODE5(has_next ? u + G : u, tmp); TO_ND(tmp, nd); }
            DECODE5(u, cur);
            if (u < 1024) att::attn_unit<3, 1>((LAS char*)lds, cur, MK_DEBUG ? Hb : QM, nullptr, nullptr, PMp, pf, has_next, nd);
            else att::attn_unit<2, 2>((LAS char*)lds, cur, MK_DEBUG ? Hb + (size_t)NTOK * WQ : QD, nullptr, nullptr, PDp, pf, has_next, nd);
        }
#undef DECODE5
#undef TO_ND
    }
    SEAM(5);

    if (IN(6)) {
        pg8::Gemm g{(const bf16*)(ws + WS_H8), (const bf16*)(ws + WS_WIN8 + (size_t)(NQKV - NBF) * DM), DM / 2, nullptr, DM / 2, (const bf16*)(ws + WS_H8), 1 << 30}; pg8::StaticOrder S; S.init(NTOK, NGATE, G, bx);
        pg8::EpiGates E{GATES, GATES + (size_t)NTOK * DM, args.in[3], (const float*)(ws + WS_RS8), (const float*)(ws + WS_CS8) + (NQKV - NBF)};
        pg8::gemm_phase<pg8::EpiGates, pg8::StaticOrder, true, false, QIN>(lds, g, S, E);
    }
    SEAM(6);
    if (IN(7)) {
        pg8::Gemm g{QM, (const bf16*)(ws + WS_WOM), DM, nullptr, WQ, QD, 16}; pg8::StaticOrder S; S.init(NTOK, DM, G, bx);
        pg8::EpiMix2 E{MIX, GATES, GATES + (size_t)NTOK * DM, (unsigned*)ctl + CW_MMAX};
        pg8::gemm_phase<pg8::EpiMix2, pg8::StaticOrder, true>(lds, g, S, E);
    }
    SEAM(7);
    if (IN(8)) {
        PHASE_IDS;
        unsigned char* M8 = ws + WS_MIX8; float* rsm = (float*)(ws + WS_RSM);
        u32x4 rw[4]; float mxn = 0.f;
#define P8_LOAD(m_) do { mxn = __uint_as_float(__hip_atomic_load((unsigned*)ctl + CW_MMAX + (m_), RLX_AGENT)); _Pragma("unroll") for (int j = 0; j < 4; ++j) rw[j] = *(const u32x4*)(MIX + (size_t)(m_) * DM + j * 512 + lane * 8); } while (0)
        if (gw < NTOK) P8_LOAD(gw);
        for (int m = gw; m < NTOK; m += NGW) {
            const float mx = mxn; u32x4 cw[4];
#pragma unroll
            for (int j = 0; j < 4; ++j) cw[j] = rw[j];
            if (m + NGW < NTOK) P8_LOAD(m + NGW);
            const float qs = mx > 0.f ? 127.f / mx : 0.f;
            if (lane == 0) rsm[m] = mx * (1.f / 127.f);
#pragma unroll
            for (int j = 0; j < 4; ++j) { f32x4 a, b; pg8::unpack8(cw[j], a, b);
                u32x2 q; q.x = pk_i8x4(a.x * qs, a.y * qs, a.z * qs, a.w * qs); q.y = pk_i8x4(b.x * qs, b.y * qs, b.z * qs, b.w * qs);
                *(u32x2*)(M8 + (size_t)m * DM + j * 512 + lane * 8) = q; }
        }
#undef P8_LOAD
    }
    SEAM(8);
    if (IN(9)) {
        pg8::Gemm g{(const bf16*)(ws + WS_MIX8), (const bf16*)(ws + WS_WO), DM / 2, nullptr, DM / 2, (const bf16*)(ws + WS_MIX8), 1 << 30}; pg8::StaticOrder S; S.init(NTOK, DM, G, bx);
        pg8::EpiResid E{x, X1H, X1L, args.in[7], (unsigned*)ctl + CW_UMAX, (const float*)(ws + WS_RSM), (const float*)(ws + WS_CSWO)};
        pg8::gemm_phase<pg8::EpiResid, pg8::StaticOrder, true, false, 2>(lds, g, S, E);
    }
    SEAM(9);

    if (IN(10)) {
        PHASE_IDS;
        const int r32 = lane & 31, hi = lane >> 5;
        constexpr int RSTR = 1040;
        LAS unsigned char* UH = lds; LAS unsigned char* UL = lds + 32 * RSTR;
        LAS float* part = (LAS float*)(lds + 2 * 32 * RSTR);
        LAS float* ssl = (LAS float*)(lds + 2 * 32 * RSTR + 40960);
        LAS int* ecnt = (LAS int*)(lds + 2 * 32 * RSTR + 40960 + 256);
        LAS f32x4* gsum = (LAS f32x4*)(lds + 2 * 32 * RSTR + 40960 + 512);
        LAS f32x4* G2L = (LAS f32x4*)(lds + 2 * 32 * RSTR + 40960 + 1024);
        LAS unsigned char* WGL = lds + 2 * 32 * RSTR + 40960 + 1024 + 8192;
        if (tid < 32) ecnt[tid] = 0;
        { const float* wgrp = args.in[8];
          for (int i = tid; i < DM; i += 512) *(LAS f32x4*)(WGL + i * 16 + (i >> 5) * 16) = *(const f32x4*)(wgrp + 4 * i);
          G2L[tid] = *(const f32x4*)(args.in[7] + 4 * tid); }
        __syncthreads();
        const float* bgrp = args.in[9]; const float* bexp = args.in[11];
        const int tok = tid >> 4, part16 = tid & 15;
        LAS float* scr = (LAS float*)(lds + wave * 8704);
        LAS float* cmax = (LAS float*)(lds + 152 * 1024);
        LAS int* qslot = (LAS int*)(lds + 156 * 1024);
        float* csgu = (float*)(ws + WS_CSGU);
        unsigned* qctr = (unsigned*)ctl + CW_Q10 + (args.dry ? 64 : 0);
        constexpr int NTILE = NTOK / 32, NJOB = 1024, NSLOT = NTILE + NJOB;
        for (;;) {
            __syncthreads();
            if (tid == 0) *qslot = (int)__hip_atomic_fetch_add(qctr, 1u, RLX_AGENT);
            __syncthreads();
            const int slot = *qslot;
            if (slot >= NSLOT) break;
            if (slot >= 2 * NTILE || (slot & 1)) {
                const int gg = slot >= 2 * NTILE ? slot - NTILE : slot >> 1;
{
                const int which = gg & 1, r = gg >> 1, e = r >> 4, nb = r & 15, n0 = 32 * nb;
                const int lane = lane_fresh();
                const float* W = args.in[12 + which] + (size_t)e * DM * DEXP;
                float mx = 0.f;
                float vv[4][32];
#pragma unroll
                for (int q4 = 0; q4 < 4; ++q4) { const int kb = wave * 4 + q4;
#pragma unroll
                    for (int i = 0; i < 32; ++i) vv[q4][i] = W[(size_t)(64 * kb + 2 * i + (lane >> 5)) * DEXP + n0 + (lane & 31)]; }
#pragma unroll
                for (int q4 = 0; q4 < 4; ++q4)
#pragma unroll
                    for (int i = 0; i < 32; ++i) mx = fmaxf(mx, fabsf(vv[q4][i]));
                mx = fmaxf(mx, __shfl_xor(mx, 32));
                __syncthreads();
                if (lane < 32) cmax[wave * 32 + lane] = mx;
                __syncthreads();
                float cm = 0.f;
#pragma unroll
                for (int w8 = 0; w8 < 8; ++w8) cm = fmaxf(cm, cmax[w8 * 32 + (lane & 31)]);
                const long orow0 = (long)e * 1024 + (n0 >> 7) * 256 + which * 128 + (n0 & 127);
                if (wave == 0 && lane < 32) csgu[orow0 + lane] = cm * (1.f / 127.f);
                const float cscale = cm > 0.f ? 127.f / cm : 0.f;
#pragma unroll
                for (int q4 = 0; q4 < 4; ++q4) transpose_regs_i8(vv[q4], 64 * (wave * 4 + q4), ws + WS_WGU, DM, orow0, cscale, scr, lane);
#pragma unroll 1
                for (int r2 = 0; r2 < 2; ++r2) { const int it = gg * 16 + wave * 2 + r2; const int e2 = it >> 9, kb = (it >> 6) & 7, nb2 = it & 63;
                    transpose_item_fp8(args.in[14] + (size_t)e2 * DEXP * DM, DM, 64 * kb, 32 * nb2, ws + WS_WDN, DEXP, (long)e2 * 2048 + 32 * nb2, WD8_SCALE, scr, lane); }
                }
                continue;
            }
            const int tile = slot >> 1;
            const int t0 = tile * 32;
            f32x16 accE = {};
            float ss = 0.f; f32x4 gacc = {0.f, 0.f, 0.f, 0.f};
            u32x4 xh[4], xl[4];
            const bf16* xrh = X1H + (size_t)(t0 + tok) * DM + part16 * 32; const bf16* xrl = X1L + (size_t)(t0 + tok) * DM + part16 * 32;
            const float umx = __uint_as_float(__hip_atomic_load((unsigned*)ctl + CW_UMAX + t0 + tok, RLX_AGENT));
            const float uq = umx > 0.f ? 127.f / umx : 0.f;
            if (part16 == 0) ((float*)(ws + WS_RSU))[t0 + tok] = umx * (1.f / 127.f);
#pragma unroll
            for (int i = 0; i < 4; ++i) { xh[i] = *(const u32x4*)(xrh + 8 * i); xl[i] = *(const u32x4*)(xrl + 8 * i); }
#pragma unroll 1
            for (int c = 0; c < 4; ++c) {
                const int kc = c * 512 + part16 * 32;
                bf16x8 wEh[4], wEl[4];
#pragma unroll
                for (int s4 = 0; s4 < 4; ++s4) { const int k = c * 512 + (wave * 4 + s4) * 16 + hi * 8; wEh[s4] = *(const bf16x8*)(WR + (size_t)r32 * DM + k); wEl[s4] = *(const bf16x8*)(WR + (size_t)(64 + r32) * DM + k); }
                u32x4 uh[4], ul[4]; u32x2 u8[4];
#pragma unroll
                for (int i = 0; i < 4; ++i) {
                    const f32x4 ga = G2L[(kc >> 2) + 2 * i], gb = G2L[(kc >> 2) + 2 * i + 1];
                    f32x4 xa, xb; { f32x4 la, lb; pg8::unpack8(xh[i], xa, xb); pg8::unpack8(xl[i], la, lb); xa += la; xb += lb; }
                    ss += (xa.x * xa.x + xa.y * xa.y) + (xa.z * xa.z + xa.w * xa.w) + (xb.x * xb.x + xb.y * xb.y) + (xb.z * xb.z + xb.w * xb.w);
                    const f32x4 ua = xa * ga, ub = xb * gb;
                    { LAS const unsigned char* wg = WGL + (kc + 8 * i) * 16 + (kc >> 5) * 16;
                      gacc += ua.x * *(LAS const f32x4*)(wg) + ua.y * *(LAS const f32x4*)(wg + 16) + ua.z * *(LAS const f32x4*)(wg + 32) + ua.w * *(LAS const f32x4*)(wg + 48);
                      asm volatile("" : "+v"(gacc) :: "memory");
                      gacc += ub.x * *(LAS const f32x4*)(wg + 64) + ub.y * *(LAS const f32x4*)(wg + 80) + ub.z * *(LAS const f32x4*)(wg + 96) + ub.w * *(LAS const f32x4*)(wg + 112);
                      asm volatile("" : "+v"(gacc) :: "memory"); }
                    uh[i] = pg8::pack8(ua, ub);
                    f32x4 ha, hb2; pg8::unpack8(uh[i], ha, hb2);
                    ul[i] = pg8::pack8(ua - ha, ub - hb2);
                    const f32x4 qa = ua * uq, qb = ub * uq;
                    u8[i].x = pk_i8x4(qa.x, qa.y, qa.z, qa.w); u8[i].y = pk_i8x4(qb.x, qb.y, qb.z, qb.w);
                    *(u32x2*)((unsigned char*)Hb + (size_t)(t0 + tok) * DM + kc + 8 * i) = u8[i];
                }
                if (c < 3) {
#pragma unroll
                    for (int i = 0; i < 4; ++i) { xh[i] = *(const u32x4*)(xrh + (c + 1) * 512 + 8 * i); xl[i] = *(const u32x4*)(xrl + (c + 1) * 512 + 8 * i); }
                }
                __syncthreads();
#pragma unroll
                for (int i = 0; i < 4; ++i) {
                    *(LAS u32x4*)(UH + tok * RSTR + part16 * 64 + 16 * i) = uh[i];
                    *(LAS u32x4*)(UL + tok * RSTR + part16 * 64 + 16 * i) = ul[i];
                }
                __syncthreads();
#pragma unroll
                for (int s = 0; s < 4; ++s) {
                    const int kl = (wave * 4 + s) * 16 + hi * 8;
                    const bf16x8 uhv = *(const LAS bf16x8*)(UH + r32 * RSTR + kl * 2), ulv = *(const LAS bf16x8*)(UL + r32 * RSTR + kl * 2);
                    accE = __builtin_amdgcn_mfma_f32_32x32x16_bf16(wEh[s], uhv, accE, 0, 0, 0);
                    accE = __builtin_amdgcn_mfma_f32_32x32x16_bf16(wEh[s], ulv, accE, 0, 0, 0);
                    accE = __builtin_amdgcn_mfma_f32_32x32x16_bf16(wEl[s], uhv, accE, 0, 0, 0);
                }
            }
            ss += __shfl_xor(ss, 1); ss += __shfl_xor(ss, 2); ss += __shfl_xor(ss, 4); ss += __shfl_xor(ss, 8);
#pragma unroll
            for (int g = 0; g < 4; ++g) { float v = gacc[g]; v += __shfl_xor(v, 1); v += __shfl_xor(v, 2); v += __shfl_xor(v, 4); v += __shfl_xor(v, 8); gacc[g] = v; }
            __syncthreads();
            if (part16 == 0) { ssl[tok] = ss; gsum[tok] = gacc; }
            LAS float* pw = part + wave * (32 * 40);
#pragma unroll
            for (int r = 0; r < 16; ++r) pw[r32 * 40 + att::crow(r, hi)] = accE[r];
            __syncthreads();
            if (tid < 32) {
                const int t = t0 + tid;
                const float rs = 1.0f / sqrtf(ssl[tid] * (1.f / DM) + RMS_EPS);
                float gl[4];
#pragma unroll
                for (int g = 0; g < 4; ++g) gl[g] = gsum[tid][g] * rs + bgrp[g];
                float gm = gl[0]; int gi = 0;
#pragma unroll
                for (int g = 1; g < 4; ++g) if (gl[g] > gm) { gm = gl[g]; gi = g; }
                float gs = 0.f;
#pragma unroll
                for (int g = 0; g < 4; ++g) gs += __expf(gl[g] - gm);
                const float gp = 1.0f / gs;
                float le[8];
#pragma unroll
                for (int e = 0; e < 8; ++e) { float a = 0.f;
#pragma unroll
                    for (int w8 = 0; w8 < 8; ++w8) a += part[w8 * (32 * 40) + tid * 40 + gi * 8 + e];
                    le[e] = a * rs + bexp[gi * 8 + e]; }
                float m0 = le[0]; int i0 = 0;
#pragma unroll
                for (int e = 1; e < 8; ++e) if (le[e] > m0) { m0 = le[e]; i0 = e; }
                float m1 = -__builtin_inff(); int i1 = 0;
#pragma unroll
                for (int e = 0; e < 8; ++e) if (e != i0 && le[e] > m1) { m1 = le[e]; i1 = e; }
                const float p1 = __expf(m1 - m0);
                const int e0 = gi * 8 + i0, e1 = gi * 8 + i1;
                EID[t * 2] = e0; EID[t * 2 + 1] = e1;
                EW[t * 2] = gp / (1.f + p1); EW[t * 2 + 1] = gp * p1 / (1.f + p1);
                RMS[t] = rs;
                __hip_atomic_fetch_add(&ecnt[e0], 1, __ATOMIC_RELAXED, __HIP_MEMORY_SCOPE_WORKGROUP); __hip_atomic_fetch_add(&ecnt[e1], 1, __ATOMIC_RELAXED, __HIP_MEMORY_SCOPE_WORKGROUP);
            }
        }
        __syncthreads();
        if (tid < 32 && ecnt[tid] > 0 && !args.dry) __hip_atomic_fetch_add((unsigned*)ctl + CW_ECNT + 64 * tid, (unsigned)ecnt[tid], RLX_AGENT);
    }
    SEAM(10);

    if (IN(11)) {
        PHASE_IDS;
        LAS int* pst = (LAS int*)(lds + 131072 - 1024);
        LAS int* ehist = pst + 64; LAS int* ebase = pst + 96;
        __syncthreads();
        if (tid == 0) { int s = 0; for (int e = 0; e < 32; ++e) { pst[e] = s; const int c = (int)__hip_atomic_load((unsigned*)ctl + CW_ECNT + 64 * e, RLX_AGENT); s += ((c + 255) >> 8) << 8; } pst[32] = s; }
        if (tid < 32) ehist[tid] = 0;
        __syncthreads();
        for (int t0 = bx * 128; t0 < NTOK && !args.dry; t0 += G * 128) {
            int e = 0, rk = 0;
            if (tid < 256) { e = EID[t0 * 2 + tid]; rk = __hip_atomic_fetch_add(&ehist[e], 1, __ATOMIC_RELAXED, __HIP_MEMORY_SCOPE_WORKGROUP); }
            __syncthreads();
            if (tid < 32) { const int c = ehist[tid]; ebase[tid] = c > 0 ? (int)__hip_atomic_fetch_add((unsigned*)ctl + CW_EFILL + 64 * tid, (unsigned)c, RLX_AGENT) : 0; }
            __syncthreads();
            if (tid < 256) { const int pos = pst[e] + ebase[e] + rk; ROWTOK[pos] = t0 + (tid >> 1); ROWW[pos] = EW[t0 * 2 + tid]; POS[t0 * 2 + tid] = pos; }
            __syncthreads();
            if (tid < 32) ehist[tid] = 0;
            __syncthreads();
        }
        if (bx < 32 && !args.dry) { const int c = (int)__hip_atomic_load((unsigned*)ctl + CW_ECNT + 64 * bx, RLX_AGENT); for (int r = pst[bx] + c + tid; r < pst[bx + 1]; r += NWAVES * 64) { ROWTOK[r] = 0; ROWW[r] = 0.f; } }
    }
    SEAM(11);

    if (IN(12) || IN(13) || IN(14)) {
        PHASE_IDS;
        LAS int* tst = (LAS int*)(lds + RING_BYTES + 64);
        __syncthreads();
        if (tid == 0) { int s = 0; for (int e = 0; e < 32; ++e) { tst[e] = s; const int c = (int)__hip_atomic_load((unsigned*)ctl + CW_ECNT + 64 * e, RLX_AGENT); s += (c + 255) >> 8; } tst[32] = s; }
        __syncthreads();
        const int ntiles = tst[32];
        const long U1 = (long)ntiles * 4, n1 = U1 / G; const int A = (int)(U1 % G); const long tfull = (n1 * G) / 4;
        const pg8::Gemm g1{Hb, (const bf16*)(ws + WS_WGU), DM / 2, ROWTOK, DM / 2, Hb, 1 << 30};
        const pg8::EpiMoe1 E1{(bf16*)(ws + WS_HMOE), RMS, ROWTOK, (const float*)(ws + WS_RSU), (const float*)(ws + WS_CSGU)};
        const pg8::Gemm g2{(const bf16*)(ws + WS_HMOE), (const bf16*)(ws + WS_WDN), DEXP / 2, nullptr, DEXP / 2, (const bf16*)(ws + WS_HMOE), 1 << 30};
        const pg8::EpiMoe2 E2{ws + WS_YMOE, (float*)(ws + WS_YS), ROWW};
        if (IN(12)) {
            pg8::MoeOrder S{tst, 4, G, bx, 0, n1 * G, 0, 0};
            pg8::gemm_phase<pg8::EpiMoe1, pg8::MoeOrder, true, true, 2>(lds, g1, S, E1);
        }
        SEAM(12);
        if (IN(13)) {
            { pg8::MoeOrder S{tst, 4, G, bx, n1 * G, U1, 0, 0};
              pg8::gemm_phase<pg8::EpiMoe1, pg8::MoeOrder, true, true, 2>(lds, g1, S, E1); }
            { pg8::MoeOrder S{tst, 8, G, bx, 0, tfull * 8, A, 3};
              pg8::gemm_phase<pg8::EpiMoe2, pg8::MoeOrder, true, false, 1>(lds, g2, S, E2); }
        }
        SEAM(13);
        if (IN(14)) {
            pg8::MoeOrder S{tst, 8, G, bx, tfull * 8, (long)ntiles * 8, 0, 0};
            pg8::gemm_phase<pg8::EpiMoe2, pg8::MoeOrder, true, false, 1>(lds, g2, S, E2);
        }
    }
    SEAM(14);

    if (IN(15)) {
        PHASE_IDS;
        const float* gf = args.in[15]; const unsigned char* Y = ws + WS_YMOE; const float* YS = (const float*)(ws + WS_YS);
        const unsigned tmo = __hip_atomic_load((unsigned*)ctl + CW_BAR + XB_TMO, RLX_AGENT);
        u32x4 xa[4]; u32x2 ya[4], yb[4]; float sa[4], sb[4];
        f32x4 gfv[8];
#pragma unroll
        for (int j = 0; j < 4; ++j) { gfv[2 * j] = *(const f32x4*)(gf + j * 512 + lane * 8); gfv[2 * j + 1] = *(const f32x4*)(gf + j * 512 + lane * 8 + 4); }
#define P15_LOAD(m_, p0_, p1_) do { const bf16* xr_ = X1H + (size_t)(m_) * DM; _Pragma("unroll") for (int j = 0; j < 4; ++j) { const int c = j * 512 + lane * 8; \
            xa[j] = *(const u32x4*)(xr_ + c); ya[j] = *(const u32x2*)(Y + (size_t)(p0_) * DM + c); yb[j] = *(const u32x2*)(Y + (size_t)(p1_) * DM + c); sa[j] = YS[(size_t)(p0_) * 64 + (c >> 5)]; sb[j] = YS[(size_t)(p1_) * 64 + (c >> 5)]; } } while (0)
        int p0n = 0, p1n = 0;
        if (gw < NTOK) { const int p0 = POS[gw * 2], p1 = POS[gw * 2 + 1]; P15_LOAD(gw, p0, p1); }
        if (gw + NGW < NTOK) { p0n = POS[(gw + NGW) * 2]; p1n = POS[(gw + NGW) * 2 + 1]; }
        for (int m = gw; m < NTOK; m += NGW) {
            f32x4 v[8]; float s = 0.f;
#pragma unroll
            for (int j = 0; j < 4; ++j) { f32x4 x0, x1v; pg8::unpack8(xa[j], x0, x1v);
#pragma unroll
                for (int e = 0; e < 4; ++e) {
                    v[2 * j][e] = x0[e] + sa[j] * (float)(int)(signed char)((ya[j].x >> (8 * e)) & 255u) + sb[j] * (float)(int)(signed char)((yb[j].x >> (8 * e)) & 255u);
                    v[2 * j + 1][e] = x1v[e] + sa[j] * (float)(int)(signed char)((ya[j].y >> (8 * e)) & 255u) + sb[j] * (float)(int)(signed char)((yb[j].y >> (8 * e)) & 255u); } }
            const int p0c = p0n, p1c = p1n;
            if (m + NGW < NTOK) P15_LOAD(m + NGW, p0c, p1c);
            if (m + 2 * NGW < NTOK) { p0n = POS[(m + 2 * NGW) * 2]; p1n = POS[(m + 2 * NGW) * 2 + 1]; }
#pragma unroll
            for (int j = 0; j < 8; ++j) s += (v[j].x * v[j].x + v[j].y * v[j].y) + (v[j].z * v[j].z + v[j].w * v[j].w);
            float rs = 1.0f / sqrtf(wave_sum(s) * (1.f / DM) + RMS_EPS);
            if (tmo) rs = __builtin_nanf("");
#pragma unroll
            for (int j = 0; j < 4; ++j) { const int c = j * 512 + lane * 8;
                *(f32x4*)(args.out + (size_t)m * DM + c) = v[2 * j] * rs * gfv[2 * j];
                *(f32x4*)(args.out + (size_t)m * DM + c + 4) = v[2 * j + 1] * rs * gfv[2 * j + 1]; }
        }
#undef P15_LOAD
    }
#undef IN
#undef SEAM
}

#if MK_DEBUG
namespace dbg {
__device__ __forceinline__ float b2f(bf16 v) { return __uint_as_float((unsigned)v << 16); }
__device__ __forceinline__ float wmax(float v) {
#pragma unroll
    for (int o = 1; o < 64; o <<= 1) v = fmaxf(v, __shfl_xor(v, o));
    return v;
}
__device__ __forceinline__ void wave_attend(const bf16* Q, const bf16* K, const bf16* V, int b, int h, int t, float slope, const int* kpos, int nk, float* qs, float* sc, float& o0, float& o1) {
    const int lane = threadIdx.x & 63;
    const size_t hb = (size_t)b * SEQ * WQ + h * HD;
    qs[lane] = b2f(Q[hb + (size_t)t * WQ + lane]); qs[lane + 64] = b2f(Q[hb + (size_t)t * WQ + lane + 64]);
    __builtin_amdgcn_s_waitcnt(0); __builtin_amdgcn_wave_barrier();
    float m = -INFINITY;
    for (int n = lane; n < nk; n += 64) { const int kp = kpos[n]; const bf16* kr = K + hb + (size_t)kp * WQ; float s = 0.f;
        for (int d = 0; d < HD; ++d) s = fmaf(qs[d], b2f(kr[d]), s);
        s = s * 0.08838834764831845f - slope * (float)(t - kp); sc[n] = s; m = fmaxf(m, s); }
    m = wmax(m);
    float l = 0.f;
    for (int n = lane; n < nk; n += 64) { const float p = expf(sc[n] - m); sc[n] = p; l += p; }
    l = wave_sum(l);
    __builtin_amdgcn_s_waitcnt(0); __builtin_amdgcn_wave_barrier();
    o0 = 0.f; o1 = 0.f;
    for (int n = 0; n < nk; ++n) { const float p = sc[n]; const bf16* vr = V + hb + (size_t)kpos[n] * WQ; o0 = fmaf(p, b2f(vr[lane]), o0); o1 = fmaf(p, b2f(vr[lane + 64]), o1); }
    o0 /= l; o1 /= l;
    __builtin_amdgcn_wave_barrier();
}
__global__ void __launch_bounds__(256) k_check(unsigned char* ws, int mode) {
    __shared__ int kpos_s[4][1024];
    __shared__ float sc_s[4][1024];
    __shared__ float qs_s[4][128];
    const int w = threadIdx.x >> 6, lane = threadIdx.x & 63;
    const unsigned sidx = blockIdx.x * 4 + w;
    const unsigned hsh = sidx * 2654435761u;
    const int b = (hsh >> 28) & 3, h = (hsh >> 24) & 7; int t = (hsh >> 8) & 8191;
    if ((sidx & 7) == 0) t = (sidx >> 3) & 511;
    const bf16* QM = (const bf16*)(ws + WS_QM); const bf16* KM = (const bf16*)(ws + WS_KM); const bf16* VM = (const bf16*)(ws + WS_VM);
    const bf16* QD = (const bf16*)(ws + WS_QD); const bf16* KD = (const bf16*)(ws + WS_KD); const bf16* VD = (const bf16*)(ws + WS_VD);
    const float* kmean = (const float*)(ws + WS_KMEAN);
    const bf16* OM = (const bf16*)(ws + WS_H); const bf16* OD = OM + (size_t)NTOK * WQ;
    float* accum = (float*)(ws + WS_CTL) + 200000;
    int* kp = kpos_s[w]; int nk = 0; float o0, o1; const bf16* O;
    const size_t hb = (size_t)b * SEQ * WQ + h * HD;
    if (mode == 1) {
        const int qblk = t >> 8;
        float g = -INFINITY;
        if (lane < qblk) { float s = 0.f; for (int d = 0; d < HD; ++d) s = fmaf(b2f(QM[hb + (size_t)t * WQ + d]), kmean[(size_t)((b * NH + h) * 32 + lane) * HD + d], s); g = s; }
        int s0 = -1, s1 = -1, s2 = -1; float g3 = 0.f, g4 = -INFINITY;
        { float mx = wmax(g);
          if (mx != -INFINITY) { s0 = __ffsll((long long)__ballot(g == mx)) - 1; if (lane == s0) g = -INFINITY; }
          mx = wmax(g);
          if (s0 >= 0 && mx != -INFINITY) { s1 = __ffsll((long long)__ballot(g == mx)) - 1; if (lane == s1) g = -INFINITY; }
          mx = wmax(g);
          if (s1 >= 0 && mx != -INFINITY) { s2 = __ffsll((long long)__ballot(g == mx)) - 1; g3 = mx; if (lane == s2) g = -INFINITY; }
          g4 = wmax(g); }
        if (s2 >= 0 && g4 != -INFINITY && g3 - g4 < 2e-3f) return;
        if (s0 >= 0) { for (int i = lane; i < 256; i += 64) kp[nk + i] = s0 * 256 + i; nk += 256; }
        if (s1 >= 0) { for (int i = lane; i < 256; i += 64) kp[nk + i] = s1 * 256 + i; nk += 256; }
        if (s2 >= 0) { for (int i = lane; i < 256; i += 64) kp[nk + i] = s2 * 256 + i; nk += 256; }
        const int own = t - qblk * 256 + 1;
        for (int i = lane; i < own; i += 64) kp[nk + i] = qblk * 256 + i;
        nk += own;
        __builtin_amdgcn_s_waitcnt(0); __builtin_amdgcn_wave_barrier();
        wave_attend(QM, KM, VM, b, h, t, exp2f(-0.5f * (float)(2 * h + 1)), kp, nk, qs_s[w], sc_s[w], o0, o1); O = OM;
    } else {
#pragma unroll
        for (int p = 0; p < 3; ++p) { const int d = (p == 0) ? 1 : (p == 1 ? 4 : 16); int cnt = t / d + 1; if (cnt > 129) cnt = 129;
            for (int i = lane; i < cnt; i += 64) kp[nk + i] = t - i * d; nk += cnt; }
        __builtin_amdgcn_s_waitcnt(0); __builtin_amdgcn_wave_barrier();
        wave_attend(QD, KD, VD, b, h, t, exp2f(-(float)(h + 1)), kp, nk, qs_s[w], sc_s[w], o0, o1); O = OD;
    }
    const float a0 = b2f(O[hb + (size_t)t * WQ + lane]), a1 = b2f(O[hb + (size_t)t * WQ + lane + 64]);
    float d2 = (a0 - o0) * (a0 - o0) + (a1 - o1) * (a1 - o1), r2 = o0 * o0 + o1 * o1;
    d2 = wave_sum(d2); r2 = wave_sum(r2);
    if (lane == 0) { atomicAdd(&accum[0], d2); atomicAdd(&accum[64], r2); }
}
__global__ void __launch_bounds__(256) k_report(unsigned char* ws, float* out, int n) {
    const int i = blockIdx.x * 256 + threadIdx.x;
    const float* accum = (const float*)(ws + WS_CTL) + 200000;
    if (i < n) out[i] = (i == 0) ? 1e4f * sqrtf(accum[0] / accum[64]) : 0.f;
}
}
#endif

extern "C" void kernel_launch(void* const* d_in, const int* in_sizes, int n_in, void* d_out, int out_size, void* d_ws, size_t ws_size, hipStream_t stream) {
    static int grid = 0;
    if (grid == 0) {
        if (n_in != 16 || ws_size < WS_END) { fprintf(stderr, "kernel_launch: need 16 inputs and %zu B of workspace (got %d, %zu)\n", (size_t)WS_END, n_in, ws_size); grid = -1; return; }
        int dev = 0, cus = 0, per_cu = 0;
        if (hipGetDevice(&dev) != hipSuccess || hipDeviceGetAttribute(&cus, hipDeviceAttributeMultiprocessorCount, dev) != hipSuccess) { grid = -1; return; }
        if (hipFuncSetAttribute((const void*)mk_fwd, hipFuncAttributeMaxDynamicSharedMemorySize, LDS_BYTES) != hipSuccess) { fprintf(stderr, "kernel_launch: hipFuncSetAttribute failed\n"); grid = -1; return; }
        if (hipOccupancyMaxActiveBlocksPerMultiprocessor(&per_cu, (const void*)mk_fwd, NWAVES * 64, LDS_BYTES) != hipSuccess || per_cu < 1) fprintf(stderr, "kernel_launch: occupancy query says %d\n", per_cu);
        (void)hipGetLastError();
        grid = cus;
    }
    if (grid < 0) return;
    (void)hipMemsetAsync((char*)d_ws + WS_CTL, 0, CTL_ZERO_BYTES, stream);
    (void)hipMemsetAsync((char*)d_ws + WS_KMEAN, 0, (size_t)NB * NH * 32 * HD * 4, stream);
    Args a{};
    for (int i = 0; i < 16; ++i) a.in[i] = (const float*)d_in[i];
    a.out = (float*)d_out; a.ws = (unsigned char*)d_ws;
    constexpr int NPH = 16;
#if MK_DEBUG
    for (int p = 0; p < 6; ++p) { a.ph_lo = p; a.ph_hi = p + 1; hipLaunchKernelGGL(mk_fwd, dim3(grid), dim3(NWAVES * 64), LDS_BYTES, stream, a); }
    hipLaunchKernelGGL(dbg::k_check, dim3(4096), dim3(256), 0, stream, (unsigned char*)d_ws, (int)MK_DEBUG);
    hipLaunchKernelGGL(dbg::k_report, dim3((out_size + 255) / 256), dim3(256), 0, stream, (unsigned char*)d_ws, (float*)d_out, out_size);
    return;
#endif
    if (MK_N_LAUNCHES == 1) { a.ph_lo = 0; a.ph_hi = NPH; hipLaunchKernelGGL(mk_fwd, dim3(grid), dim3(NWAVES * 64), LDS_BYTES, stream, a); }
    else { for (int p = 0; p < NPH; ++p) { const int reps = ((MK_REP_MASK >> p) & 1) ? 2 : 1; if (p == 2) continue;
            for (int r = 0; r < reps; ++r) { a.ph_lo = p; a.ph_hi = p + 1; a.dry = ((p == 10 || p == 11) && reps == 2 && r == 0) ? 1 : ((p == 4 && reps == 2 && r == 0) ? MK_DRY4 : 0); hipLaunchKernelGGL(mk_fwd, dim3(grid), dim3(NWAVES * 64), LDS_BYTES, stream, a);
            } } }
}
```
